# Optimizing an MI355X kernel written in HIP

```python
import math
import jax, jax.numpy as jnp
from jax import lax
import numpy as np

D_MODEL = 4096
BATCH = 2
SEQ = 4096
DEPTH = 1

D_MIX = D_MODEL
MLA_HEADS = 16
QK_NOPE_DIM = 128
QK_ROPE_DIM = 64
QK_HEAD_DIM = QK_NOPE_DIM + QK_ROPE_DIM
V_HEAD_DIM = 128
Q_LORA_RANK = 1024
KV_LORA_RANK = 512
ROPE_BASE = 10000.0
ATTN_BLOCK = 128
MLA_WIDTH = MLA_HEADS * V_HEAD_DIM
GMLP_HEADS = 16
GMLP_CHUNK = 128
GMLP_WIDTH = D_MIX - MLA_WIDTH
GMLP_HEAD_DIM = GMLP_WIDTH // GMLP_HEADS
IN_WIDTH = Q_LORA_RANK + KV_LORA_RANK + QK_ROPE_DIM + 2 * GMLP_WIDTH
PEER_HEADS = 8
PEER_NKEYS = 128
PEER_N_EXPERTS = PEER_NKEYS * PEER_NKEYS
PEER_QUERY_DIM = 256
PEER_HALF = PEER_QUERY_DIM // 2
PEER_TOPK = 16
PEER_BLOCK = 128
NORM_EPS = 1e-6

kernel_name = "hybrid_mla_gmlp_peer_adaln_block"


def rms_norm(x, g):
    xf = x.astype(jnp.float32)
    y = xf * lax.rsqrt(jnp.mean(xf * xf, axis=-1, keepdims=True) + NORM_EPS)
    return (y * g.astype(jnp.float32)).astype(x.dtype)


def layer_norm(x, g):
    xf = x.astype(jnp.float32)
    mu = jnp.mean(xf, axis=-1, keepdims=True)
    var = jnp.mean(jnp.square(xf - mu), axis=-1, keepdims=True)
    return ((xf - mu) * lax.rsqrt(var + NORM_EPS) * g.astype(jnp.float32)).astype(x.dtype)


def modulate(h, shift, scale):
    return h * (1.0 + scale[:, None, :]) + shift[:, None, :]


def rope(x, cos, sin):
    x1, x2 = jnp.split(x, 2, axis=-1)
    return jnp.concatenate([x1 * cos - x2 * sin, x2 * cos + x1 * sin], axis=-1)


def mla_attention(q_lat, kv_lat, k_pe_raw, g_q, w_uq, g_kv, w_ukv, cos, sin):
    B, S, _ = q_lat.shape
    q = (rms_norm(q_lat, g_q) @ w_uq).reshape(B, S, MLA_HEADS, QK_HEAD_DIM)
    q_nope = q[..., :QK_NOPE_DIM]
    q_pe = rope(q[..., QK_NOPE_DIM:], cos[:, :, None, :], sin[:, :, None, :])
    kv = (rms_norm(kv_lat, g_kv) @ w_ukv).reshape(B, S, MLA_HEADS, QK_NOPE_DIM + V_HEAD_DIM)
    k_nope = kv[..., :QK_NOPE_DIM]
    v = kv[..., QK_NOPE_DIM:]
    k_pe = rope(k_pe_raw, cos, sin)
    nb = S // ATTN_BLOCK
    scale = 1.0 / math.sqrt(QK_HEAD_DIM)
    k_idx = jnp.arange(S)

    def to_blocks(t):
        return jnp.moveaxis(t.reshape(B, nb, ATTN_BLOCK, *t.shape[2:]), 1, 0)

    def block(args):
        qn, qp, i = args
        s = (jnp.einsum('bqhd,bkhd->bhqk', qn, k_nope)
             + jnp.einsum('bqhd,bkd->bhqk', qp, k_pe)).astype(jnp.float32) * scale
        q_idx = i * ATTN_BLOCK + jnp.arange(ATTN_BLOCK)
        causal = q_idx[:, None] >= k_idx[None, :]
        p = jax.nn.softmax(jnp.where(causal, s, -jnp.inf), axis=-1)
        return jnp.einsum('bhqk,bkhd->bqhd', p.astype(v.dtype), v)

    o = lax.map(block, (to_blocks(q_nope), to_blocks(q_pe), jnp.arange(nb)))
    return jnp.moveaxis(o, 0, 1).reshape(B, S, MLA_WIDTH)


def gmlp_sgu(z, g_sgu, w_sgu, b_sgu):
    B, S, _ = z.shape
    u, v = jnp.split(z, 2, axis=-1)
    v = layer_norm(v, g_sgu).reshape(B, S // GMLP_CHUNK, GMLP_CHUNK, GMLP_HEADS, GMLP_HEAD_DIM)
    causal = jnp.tril(jnp.ones((GMLP_CHUNK, GMLP_CHUNK), dtype=w_sgu.dtype))
    w = w_sgu * causal[None]
    sv = jnp.einsum('hts,bnshd->bnthd', w, v) + jnp.transpose(b_sgu)[None, None, :, :, None]
    return u * sv.reshape(B, S, GMLP_WIDTH)


def peer(xf, w_pq, keys, expert_u, expert_v):
    T, D = xf.shape
    blocks = xf.reshape(T // PEER_BLOCK, PEER_BLOCK, D)

    def block(xb):
        q = (xb @ w_pq).reshape(PEER_BLOCK, PEER_HEADS, 2, PEER_HALF)
        s = jnp.einsum('thpk,hpnk->thpn', q, keys).astype(jnp.float32)
        sv, si = lax.top_k(s, PEER_TOPK)
        cand = (sv[:, :, 0, :, None] + sv[:, :, 1, None, :]).reshape(PEER_BLOCK, PEER_HEADS, PEER_TOPK * PEER_TOPK)
        cidx = (si[:, :, 0, :, None] * PEER_NKEYS + si[:, :, 1, None, :]).reshape(PEER_BLOCK, PEER_HEADS, PEER_TOPK * PEER_TOPK)
        top_s, top_p = lax.top_k(cand, PEER_TOPK)
        eidx = jnp.take_along_axis(cidx, top_p, axis=-1)
        g = jax.nn.softmax(top_s, axis=-1).astype(xb.dtype)
        u = expert_u[eidx]
        a = jax.nn.gelu(jnp.einsum('thkd,td->thk', u, xb), approximate=False)
        vv = expert_v[eidx]
        return jnp.einsum('thk,thkd->td', g * a, vv)

    return lax.map(block, blocks).reshape(T, D)


def setup_inputs(seed: int = 0) -> dict:
    key = jax.random.key(seed)
    ks = jax.random.split(key, 32)
    f32 = jnp.float32
    nrm = lambda k, shape, s: jax.random.normal(k, shape, f32) * s
    gain = lambda k, shape: 1.0 + 0.1 * jax.random.normal(k, shape, f32)
    L = DEPTH
    x = jax.random.normal(ks[0], (BATCH, SEQ, D_MODEL), f32)
    c = jax.random.normal(ks[1], (BATCH, D_MODEL), f32)
    offsets = jax.random.randint(ks[2], (BATCH, 1), 0, 1024, dtype=jnp.int32)
    positions = (offsets + jnp.arange(SEQ, dtype=jnp.int32)[None, :]).astype(jnp.int32)
    return {
        "x": x,
        "c": c,
        "positions": positions,
        "w_ada": nrm(ks[3], (L, D_MODEL, 6 * D_MODEL), 0.5 * D_MODEL ** -0.5),
        "b_ada": nrm(ks[4], (L, 6 * D_MODEL), 0.02),
        "g_norm_mix": gain(ks[5], (L, D_MODEL)),
        "w_in": nrm(ks[6], (L, D_MODEL, IN_WIDTH), D_MODEL ** -0.5),
        "g_q": gain(ks[7], (L, Q_LORA_RANK)),
        "w_uq": nrm(ks[8], (L, Q_LORA_RANK, MLA_HEADS * QK_HEAD_DIM), Q_LORA_RANK ** -0.5),
        "g_kv": gain(ks[9], (L, KV_LORA_RANK)),
        "w_ukv": nrm(ks[10], (L, KV_LORA_RANK, MLA_HEADS * (QK_NOPE_DIM + V_HEAD_DIM)), KV_LORA_RANK ** -0.5),
        "g_sgu": gain(ks[11], (L, GMLP_WIDTH)),
        "w_sgu": nrm(ks[12], (L, GMLP_HEADS, GMLP_CHUNK, GMLP_CHUNK), GMLP_CHUNK ** -0.5),
        "b_sgu": gain(ks[13], (L, GMLP_HEADS, GMLP_CHUNK)),
        "beta_mla": gain(ks[14], (L, MLA_WIDTH)),
        "beta_gmlp": gain(ks[15], (L, GMLP_WIDTH)),
        "w_out": nrm(ks[16], (L, D_MIX, D_MODEL), D_MIX ** -0.5),
        "g_norm_ffn": gain(ks[17], (L, D_MODEL)),
        "w_pq": nrm(ks[18], (L, D_MODEL, PEER_HEADS * PEER_QUERY_DIM), D_MODEL ** -0.5),
        "peer_keys": nrm(ks[19], (L, PEER_HEADS, 2, PEER_NKEYS, PEER_HALF), PEER_HALF ** -0.5),
        "expert_u": nrm(ks[20], (L, PEER_N_EXPERTS, D_MODEL), D_MODEL ** -0.5),
        "expert_v": nrm(ks[21], (L, PEER_N_EXPERTS, D_MODEL), PEER_TOPK ** -0.5),
        "w_ada_f": nrm(ks[22], (D_MODEL, 2 * D_MODEL), 0.5 * D_MODEL ** -0.5),
        "b_ada_f": nrm(ks[23], (2 * D_MODEL,), 0.02),
        "g_norm_f": gain(ks[24], (D_MODEL,)),
    }


def reference(x, c, positions, w_ada, b_ada, g_norm_mix, w_in, g_q, w_uq, g_kv, w_ukv,
              g_sgu, w_sgu, b_sgu, beta_mla, beta_gmlp, w_out, g_norm_ffn, w_pq, peer_keys,
              expert_u, expert_v, w_ada_f, b_ada_f, g_norm_f):
    B, S, D = x.shape
    inv_freq = ROPE_BASE ** (-jnp.arange(0, QK_ROPE_DIM, 2, dtype=jnp.float32) / QK_ROPE_DIM)
    ang = positions.astype(jnp.float32)[..., None] * inv_freq
    cos = jnp.cos(ang).astype(x.dtype)
    sin = jnp.sin(ang).astype(x.dtype)
    c_act = jax.nn.silu(c)
    splits = [Q_LORA_RANK, Q_LORA_RANK + KV_LORA_RANK, Q_LORA_RANK + KV_LORA_RANK + QK_ROPE_DIM]
    for l in range(DEPTH):
        mod = c_act @ w_ada[l] + b_ada[l]
        sh_a, sc_a, gt_a, sh_f, sc_f, gt_f = jnp.split(mod, 6, axis=-1)
        h = modulate(rms_norm(x, g_norm_mix[l]), sh_a, sc_a)
        z = h @ w_in[l]
        q_lat, kv_lat, k_pe_raw, z_g = jnp.split(z, splits, axis=-1)
        y_mla = mla_attention(q_lat, kv_lat, k_pe_raw, g_q[l], w_uq[l], g_kv[l], w_ukv[l], cos, sin)
        y_g = gmlp_sgu(jax.nn.gelu(z_g, approximate=False), g_sgu[l], w_sgu[l], b_sgu[l])
        y = jnp.concatenate([rms_norm(y_mla, beta_mla[l]), rms_norm(y_g, beta_gmlp[l])], axis=-1)
        x = x + gt_a[:, None, :] * (y @ w_out[l])
        h = modulate(rms_norm(x, g_norm_ffn[l]), sh_f, sc_f)
        f = peer(h.reshape(B * S, D), w_pq[l], peer_keys[l], expert_u[l], expert_v[l]).reshape(B, S, D)
        x = x + gt_f[:, None, :] * f
    sh, sc = jnp.split(c_act @ w_ada_f + b_ada_f, 2, axis=-1)
    return modulate(rms_norm(x, g_norm_f), sh, sc)
```

```cpp
#include <hip/hip_runtime.h>
#include <cstdio>
#include <cstdint>

#ifndef MK_ONE_LAUNCH
#define MK_ONE_LAUNCH 1
#endif

#define LAS __attribute__((address_space(3)))
#define GAS __attribute__((address_space(1)))
typedef unsigned short bf16;
typedef short bf16x8 __attribute__((ext_vector_type(8)));
typedef float f32x4 __attribute__((ext_vector_type(4)));
typedef float f32x2 __attribute__((ext_vector_type(2)));
typedef float f32x16 __attribute__((ext_vector_type(16)));
typedef unsigned u32x4 __attribute__((ext_vector_type(4)));
typedef unsigned u32x2 __attribute__((ext_vector_type(2)));

constexpr int D = 4096, SEQ = 4096, NB = 2, M = NB * SEQ;
constexpr int QLR = 1024, KVLR = 512, ROPE = 64, NOPE = 128, QKD = 192, VD = 128, NH = 16;
constexpr int GW = 2048, GH = 16, GC = 128;
constexpr int INW = QLR + KVLR + ROPE + 2 * GW;
constexpr int INWP = 5888;
constexpr int PH = 8, PNK = 128, PQD = 256, PHALF = 128, PK = 16, PNE = PNK * PNK;
constexpr int PQW = PH * PQD;
constexpr float EPS = 1e-6f;
constexpr int NWAVES = 8, NTHR = 512;

constexpr size_t MiB = 1u << 20;
constexpr size_t WS_CTL = 0, CTL_ZERO_BYTES = 1 * MiB;
constexpr size_t WS_MOD = 1 * MiB;
constexpr size_t WS_ROPE = 2 * MiB;
constexpr size_t WS_KEYS = 4 * MiB;
constexpr size_t WS_WSGU = 5 * MiB;
constexpr size_t WS_STQ = 6 * MiB;
constexpr size_t WS_STKV = 7 * MiB;
constexpr size_t WS_STVS = 8 * MiB;
constexpr size_t WS_STVQ = 9 * MiB;
constexpr size_t WS_STM = 10 * MiB;
constexpr size_t WS_STG = 11 * MiB;
constexpr size_t WS_LIDX = 13 * MiB;
constexpr size_t WS_LG = 17 * MiB;
constexpr size_t WS_NA = 21 * MiB;
constexpr size_t WS_W1T = 32 * MiB;
constexpr size_t WS_WUQT = 80 * MiB;
constexpr size_t WS_WUKVT = 88 * MiB;
constexpr size_t WS_WOUTT = 96 * MiB;
constexpr size_t WS_WPQT = 128 * MiB;
constexpr size_t WS_H = 160 * MiB;
constexpr size_t WS_QLAT = 224 * MiB;
constexpr size_t WS_KVLAT = 240 * MiB;
constexpr size_t WS_KPE = 248 * MiB;
constexpr size_t WS_U = 256 * MiB;
constexpr size_t WS_VT = 288 * MiB;
constexpr size_t WS_Q = 320 * MiB;
constexpr size_t WS_KN = 368 * MiB;
constexpr size_t WS_VTA = 400 * MiB;
constexpr size_t WS_Y = 432 * MiB;
constexpr size_t WS_X1 = 496 * MiB;
constexpr size_t WS_QP = 624 * MiB;
constexpr size_t WS_E8 = 704 * MiB;
constexpr size_t WS_ESC = 832 * MiB;
constexpr size_t WS_PART = 840 * MiB;
constexpr size_t WS_ATR = 844 * MiB;
constexpr size_t WS_AT = 904 * MiB;
constexpr size_t WS_FT = 912 * MiB;
constexpr size_t WS_H8 = 1040 * MiB;
constexpr size_t WS_SH = 1072 * MiB;
constexpr size_t WS_END = 1073 * MiB;
constexpr int CW_BAR = 4096;

constexpr int RING_BYTES = 131072;
constexpr int LDS_BYTES = 147456;
constexpr int LDSCTL_OFF = LDS_BYTES - 1024;

#define RLX_AGENT __ATOMIC_RELAXED, __HIP_MEMORY_SCOPE_AGENT
#define LDS_WAIT() asm volatile("s_waitcnt lgkmcnt(0)" ::: "memory")
#define LDS_BARRIER() do { asm volatile("s_waitcnt lgkmcnt(0)" ::: "memory"); __builtin_amdgcn_s_barrier(); asm volatile("" ::: "memory"); } while (0)
#define VM_WAIT() asm volatile("s_waitcnt vmcnt(0)" ::: "memory")

__device__ __forceinline__ unsigned f2bf(float f) { unsigned u = __builtin_bit_cast(unsigned, f); return (u + 0x7fffu + ((u >> 16) & 1u)) >> 16; }
__device__ __forceinline__ unsigned pk2(float lo, float hi) { unsigned r; asm("v_cvt_pk_bf16_f32 %0, %1, %2" : "=v"(r) : "v"(lo), "v"(hi)); return r; }
__device__ __forceinline__ float bf2f(unsigned b) { return __builtin_bit_cast(float, b << 16); }
__device__ __forceinline__ float wave_sum(float v) {
    v += __builtin_bit_cast(float, __builtin_amdgcn_update_dpp(0, __builtin_bit_cast(int, v), 0xB1, 0xF, 0xF, true));
    v += __builtin_bit_cast(float, __builtin_amdgcn_update_dpp(0, __builtin_bit_cast(int, v), 0x4E, 0xF, 0xF, true));
    v += __builtin_bit_cast(float, __builtin_amdgcn_update_dpp(0, __builtin_bit_cast(int, v), 0x141, 0xF, 0xF, true));
    v += __builtin_bit_cast(float, __builtin_amdgcn_update_dpp(0, __builtin_bit_cast(int, v), 0x140, 0xF, 0xF, true));
    v += __builtin_bit_cast(float, __builtin_amdgcn_update_dpp(0, __builtin_bit_cast(int, v), 0x142, 0xA, 0xF, true));
    v += __builtin_bit_cast(float, __builtin_amdgcn_update_dpp(0, __builtin_bit_cast(int, v), 0x143, 0xC, 0xF, true));
    return __builtin_bit_cast(float, __builtin_amdgcn_readlane(__builtin_bit_cast(int, v), 63));
}
__device__ __forceinline__ float gelu_f(float v) {
    const float av = fabsf(v), t = __builtin_amdgcn_rcpf(av * 0.2316418882f + 1.0f);
    float q = t * 0.5307027145f + (-0.7265760135f); q = q * t + 0.7107068705f; q = q * t + (-0.142248368f); q = q * t + 0.127414796f; q = q * t;
    const float e = __builtin_amdgcn_exp2f((v * v) * (-0.72134752044f));
    const float m = v * (q * e);
    return v < 0.f ? m : v - m;
}

#define XB_TMO      128
#define XB_XCNT(j)  (256  + 64 * (j))
#define XB_XSUB(j)  (1280 + 64 * (j))
#define XB_XGEN(j)  (2304 + 64 * (j))
#define XB_TOP      3328
#define XB_TOPGEN   3392
#define XCD_BAR_WORDS 3456
#define XB_SPIN_CAP (1u << 20)

__device__ __forceinline__ unsigned xb_ld(unsigned* p)              { return __hip_atomic_load(p, __ATOMIC_RELAXED, __HIP_MEMORY_SCOPE_AGENT); }
__device__ __forceinline__ unsigned xb_add(unsigned* p, unsigned v) { return __hip_atomic_fetch_add(p, v, __ATOMIC_RELAXED, __HIP_MEMORY_SCOPE_AGENT); }
__device__ __forceinline__ unsigned xb_xcc_id() { return (unsigned)__builtin_amdgcn_s_getreg((3 << 11) | 20) & 0xFu; }
#define XB_SPIN(cond, bar) do { unsigned _sp = 0; while (cond) { __builtin_amdgcn_s_sleep(1); \
    if ((++_sp & 255u) == 0u) { if (xb_ld(&(bar)[XB_TMO])) break; if (_sp > XB_SPIN_CAP) { atomicAdd(&(bar)[XB_TMO], 1u); break; } } } } while (0)

struct XcdBarrier { unsigned* bar; unsigned x; volatile LAS unsigned* st; };

__device__ __forceinline__ XcdBarrier xcd_barrier_post(unsigned* bar, volatile LAS unsigned* st) {
    XcdBarrier b; b.bar = bar; b.x = xb_xcc_id(); b.st = st;
    if (threadIdx.x == 0) (void)xb_add(&bar[XB_XCNT(b.x)], 1u);
    return b;
}
__device__ __forceinline__ void xcd_barrier_complete(unsigned* bar, unsigned x, unsigned& nloc, unsigned& nx) {
    const unsigned G = gridDim.x * gridDim.y * gridDim.z;
    unsigned sum, cnt, mine, sp = 0u;
    for (;;) {
        sum = 0u; cnt = 0u; mine = 0u;
#pragma unroll
        for (unsigned j = 0; j < 16; ++j) { const unsigned c = xb_ld(&bar[XB_XCNT(j)]); sum += c; cnt += (c > 0u) ? 1u : 0u; mine = (j == x) ? c : mine; }
        if (sum == G) break;
        __builtin_amdgcn_s_sleep(1);
        if ((++sp & 255u) == 0u) { if (xb_ld(&bar[XB_TMO])) break; if (sp > XB_SPIN_CAP) { atomicAdd(&bar[XB_TMO], 1u); break; } }
    }
    nloc = mine > 0u ? mine : 1u; nx = cnt > 0u ? cnt : 1u;
}
__device__ __forceinline__ void xcd_barrier(const XcdBarrier& b) {
    asm volatile("s_waitcnt vmcnt(0)" ::: "memory");
    __syncthreads();
    if (threadIdx.x == 0) {
        unsigned* bar = b.bar;
        __builtin_amdgcn_s_waitcnt(0);
        unsigned nloc = b.st[0], nx = b.st[1];
        if (nloc == 0u) { xcd_barrier_complete(bar, b.x, nloc, nx); b.st[0] = nloc; b.st[1] = nx; }
        const unsigned old = xb_add(&bar[XB_XSUB(b.x)], 1u);
        const unsigned gen = old / nloc;
        if (old + 1u == (gen + 1u) * nloc) {
            __builtin_amdgcn_fence(__ATOMIC_RELEASE, "agent");
            asm volatile("s_waitcnt vmcnt(0)" ::: "memory");
            const unsigned og = xb_add(&bar[XB_TOP], 1u);
            const unsigned tg = og / nx;
            if (og + 1u == (tg + 1u) * nx) xb_add(&bar[XB_TOPGEN], 1u);
            else XB_SPIN(xb_ld(&bar[XB_TOPGEN]) == tg, bar);
            __builtin_amdgcn_fence(__ATOMIC_ACQUIRE, "agent");
            xb_add(&bar[XB_XGEN(b.x)], 1u);
            asm volatile("s_waitcnt vmcnt(0)" ::: "memory");
        } else {
            XB_SPIN(xb_ld(&bar[XB_XGEN(b.x)]) == gen, bar);
            __builtin_amdgcn_fence(__ATOMIC_ACQUIRE, "agent");
            asm volatile("s_waitcnt vmcnt(0)" ::: "memory");
        }
    }
    __syncthreads();
}

namespace pg8 {
constexpr int BM = 256, BK = 64, HALF = 128, HTB = HALF * BK * 2, STAGE_BYTES = 8 * HTB, NXCD = 8, WGM = 8;
__host__ __device__ __forceinline__ int lds_byte(int r, int c) { const int st = (r >> 4) * 2 + (c >> 5), rr = r & 15, cc = c & 31, ob = rr * 64 + cc * 2; return st * 1024 + (ob ^ (((ob >> 9) & 1) << 5)); }
__host__ __device__ __forceinline__ void stage_rc(int b, int& R, int& C) { const int st = b / 1024, sb = b % 1024, swz = sb ^ (((sb >> 9) & 1) << 5); R = (st >> 1) * 16 + swz / 64; C = (st & 1) * 32 + (swz % 64) / 2; }
struct Unit { int pm, pn; };
struct Gemm { const bf16* A; const bf16* Bt; int M, N, K, lda, ldb; };
struct StaticOrder {
    int nM, nN, nwg, G, c;
    __device__ __forceinline__ void init(int M_, int N_, int G_, int c_) { nM = M_ / BM; nN = N_ / BM; nwg = nM * nN; G = G_; c = c_; }
    __device__ __forceinline__ bool next(int i, Unit& u) const {
        const long L = (long)i * G + c; if (L >= nwg) return false;
        int wgid = (int)L; { const int q = nwg / NXCD, r = nwg % NXCD, xcd = wgid % NXCD, off = wgid / NXCD; wgid = (xcd < r ? xcd * (q + 1) : r * (q + 1) + (xcd - r) * q) + off; }
        const int nig = WGM * nN, gid = wgid / nig, fm = gid * WGM, gsz = (nM - fm) < WGM ? (nM - fm) : WGM;
        u.pm = fm + ((wgid % nig) % gsz); u.pn = (wgid % nig) / gsz; return true;
    }
};
template <class Epi>
__device__ __forceinline__ void gemm_phase(LAS unsigned char* lds, const Gemm g, const StaticOrder& S, const Epi& E) {
    const int tid = threadIdx.x, wid = __builtin_amdgcn_readfirstlane(tid >> 6), lane = tid & 63, wr = wid >> 2, wc = wid & 3, fr = lane & 15, fq = lane >> 4;
    const int K = g.K, nt = K / BK;
    unsigned voffA[2], voffB[2];
#pragma unroll
    for (int i = 0; i < 2; ++i) { int R, C; stage_rc(tid * 16 + i * 8192, R, C);
        voffA[i] = (unsigned)(R * g.lda + C) * 2u; voffB[i] = (unsigned)(R * g.ldb + C) * 2u; }
    const size_t kstep = (size_t)(BK * 2);
    const size_t hstepA = (size_t)HALF * g.lda * 2, hstepB = (size_t)HALF * g.ldb * 2;
    const size_t tstepA = 2 * hstepA, tstepB = 2 * hstepB;
    const unsigned ldsw = (unsigned)wid * 1024u;
    const int aoff = lds_byte(wr * 64 + fr, fq * 8), boff = lds_byte(wc * 32 + fr, fq * 8);
#define PG8_SA(b, h) (((b) * 2 + (h)) * HTB)
#define PG8_SB(b, h) ((4 + (b) * 2 + (h)) * HTB)
#define PG8_STAGE(bufoff, gbase, voff) do { _Pragma("unroll") for (int _i = 0; _i < 2; ++_i) \
        __builtin_amdgcn_global_load_lds((const unsigned*)((const char*)(gbase) + (voff)[_i]), (LAS unsigned*)(lds + (bufoff) + ldsw + _i * 8192), 16, 0, 0); } while (0)
#define PG8_LDA(dst, b, h) do { _Pragma("unroll") for (int m = 0; m < 4; ++m) _Pragma("unroll") for (int k = 0; k < 2; ++k) dst[m][k] = *(const LAS bf16x8*)(lds + PG8_SA(b, h) + aoff + m * 2048 + k * 1024); } while (0)
#define PG8_LDB(dst, b, h) do { _Pragma("unroll") for (int n = 0; n < 2; ++n) _Pragma("unroll") for (int k = 0; k < 2; ++k) dst[n][k] = *(const LAS bf16x8*)(lds + PG8_SB(b, h) + boff + n * 2048 + k * 1024); } while (0)
#define PG8_MMA(ai, bj, At, Bt) do { __builtin_amdgcn_s_setprio(1); _Pragma("unroll") for (int m = 0; m < 4; ++m) _Pragma("unroll") for (int n = 0; n < 2; ++n) _Pragma("unroll") for (int k = 0; k < 2; ++k) \
        acc[ai][bj][m][n] = __builtin_amdgcn_mfma_f32_16x16x32_bf16(Bt[n][k], At[m][k], acc[ai][bj][m][n], 0, 0, 0); __builtin_amdgcn_s_setprio(0); } while (0)
#define PG8_WAIT_V(n) asm volatile("s_waitcnt vmcnt(" #n ")" ::: "memory")
#define PG8_WAIT_L(n) asm volatile("s_waitcnt lgkmcnt(" #n ")" ::: "memory")
#define PG8_BAR __builtin_amdgcn_s_barrier()
#define PG8_SCHED __builtin_amdgcn_sched_barrier(0)
    Unit cur, nxt; int ui = 0;
    if (!S.next(0, cur)) return;
    f32x4 acc[2][2][4][2];
#pragma unroll
    for (int a = 0; a < 2; ++a)
#pragma unroll
        for (int b = 0; b < 2; ++b)
#pragma unroll
            for (int m = 0; m < 4; ++m)
#pragma unroll
                for (int n = 0; n < 2; ++n) acc[a][b][m][n] = (f32x4){0.f, 0.f, 0.f, 0.f};
    bf16x8 At[4][2], B0[2][2], B1[2][2];
    const char* cA = (const char*)g.A + (size_t)cur.pm * tstepA; const char* cB = (const char*)g.Bt + (size_t)cur.pn * tstepB;
    PG8_STAGE(PG8_SB(0, 0), cB, voffB); PG8_STAGE(PG8_SB(0, 1), cB + hstepB, voffB); PG8_STAGE(PG8_SA(0, 0), cA, voffA); PG8_STAGE(PG8_SA(0, 1), cA + hstepA, voffA);
    if (wr == 1) PG8_BAR;
    PG8_WAIT_V(2); PG8_BAR;
    PG8_STAGE(PG8_SB(1, 0), cB + kstep, voffB); PG8_STAGE(PG8_SA(1, 0), cA + kstep, voffA); PG8_STAGE(PG8_SB(1, 1), cB + hstepB + kstep, voffB);
    PG8_WAIT_V(6); PG8_BAR;
    for (;;) {
        const bool has_next = S.next(ui + 1, nxt);
        const char* nA = has_next ? (const char*)g.A + (size_t)nxt.pm * tstepA : cA; const char* nB = has_next ? (const char*)g.Bt + (size_t)nxt.pn * tstepB : cB;
        for (int t = 0; t < nt; t += 2) {
            const bool last = (t == nt - 2);
            const char* a1 = cA + (size_t)(t + 1) * kstep;
            const char* a2 = last ? nA : cA + (size_t)(t + 2) * kstep; const char* b2 = last ? nB : cB + (size_t)(t + 2) * kstep;
            const char* a3 = a2 + kstep; const char* b3 = b2 + kstep;
            if constexpr (Epi::MID) { if (t == nt / 2) E.mid(acc, cur, wr, wc, fr, fq); }
            PG8_LDB(B0, 0, 0); PG8_LDB(B1, 0, 1); PG8_SCHED; PG8_LDA(At, 0, 0); PG8_STAGE(PG8_SA(1, 1), a1 + hstepA, voffA);
            PG8_WAIT_V(8); PG8_WAIT_L(0); PG8_BAR; PG8_MMA(0, 0, At, B0); PG8_MMA(0, 1, At, B1); PG8_BAR; PG8_SCHED;
            PG8_LDA(At, 0, 1); PG8_STAGE(PG8_SB(0, 0), b2, voffB); PG8_STAGE(PG8_SB(0, 1), b2 + hstepB, voffB); PG8_STAGE(PG8_SA(0, 0), a2, voffA);
            PG8_WAIT_V(8); PG8_WAIT_L(0); PG8_BAR; PG8_MMA(1, 0, At, B0); PG8_MMA(1, 1, At, B1); PG8_BAR; PG8_SCHED;
            PG8_LDB(B0, 1, 0); PG8_LDB(B1, 1, 1); PG8_SCHED; PG8_LDA(At, 1, 0); PG8_STAGE(PG8_SA(0, 1), a2 + hstepA, voffA);
            PG8_WAIT_V(8); PG8_WAIT_L(0); PG8_BAR; PG8_MMA(0, 0, At, B0); PG8_MMA(0, 1, At, B1); PG8_BAR; PG8_SCHED;
            PG8_LDA(At, 1, 1); PG8_STAGE(PG8_SB(1, 0), b3, voffB); PG8_STAGE(PG8_SB(1, 1), b3 + hstepB, voffB); PG8_STAGE(PG8_SA(1, 0), a3, voffA);
            PG8_WAIT_V(8); PG8_WAIT_L(0); PG8_BAR; PG8_MMA(1, 0, At, B0); PG8_MMA(1, 1, At, B1); PG8_BAR; PG8_SCHED;
        }
        if (wr == 0) PG8_BAR;
        E(acc, cur, wr, wc, fr, fq);
        if (!has_next) break;
#pragma unroll
        for (int a = 0; a < 2; ++a)
#pragma unroll
            for (int b = 0; b < 2; ++b)
#pragma unroll
                for (int m = 0; m < 4; ++m)
#pragma unroll
                    for (int n = 0; n < 2; ++n) acc[a][b][m][n] = (f32x4){0.f, 0.f, 0.f, 0.f};
        cur = nxt; cA = nA; cB = nB; ++ui;
        if (wr == 1) PG8_BAR;
    }
    PG8_WAIT_V(0);
    PG8_BAR;
#undef PG8_SA
#undef PG8_SB
#undef PG8_STAGE
#undef PG8_LDA
#undef PG8_LDB
#undef PG8_MMA
#undef PG8_WAIT_V
#undef PG8_WAIT_L
#undef PG8_BAR
#undef PG8_SCHED
}
}

__device__ __forceinline__ void st_bf16x4(bf16* p, f32x4 v) { u32x2 w; w.x = pk2(v[0], v[1]); w.y = pk2(v[2], v[3]); *(u32x2*)p = w; }
__device__ __forceinline__ float sum_parts(const float* p, int n4) { f32x4 s = {0.f, 0.f, 0.f, 0.f}; for (int i = 0; i < n4; ++i) s += ((const f32x4*)p)[i]; return (s[0] + s[1]) + (s[2] + s[3]); }
__device__ __forceinline__ int sperm16(int s) { const int c = s & 15; return (s & ~15) | (8 * ((c >> 2) & 1) + 4 * (c >> 3) + (c & 3)); }

struct EpiZ {
    static constexpr bool MID = false;
    bf16 *qlat, *kvlat, *kpe, *u, *vt; float *stq, *stkv, *stvs, *stvq; const float* rope;
    __device__ __forceinline__ void operator()(const f32x4 (&acc)[2][2][4][2], const pg8::Unit& un, int wr, int wc, int fr, int fq) const {
        const int pn = un.pn, row0 = un.pm * 256 + wr * 64 + fr, cl0 = wc * 32 + 4 * fq;
        if (pn < 6) {
            const bool isq = pn < 4; bf16* dst = isq ? qlat : kvlat; const int ld = isq ? QLR : KVLR, ct = isq ? pn : pn - 4;
#pragma unroll
            for (int ai = 0; ai < 2; ++ai)
#pragma unroll
                for (int m = 0; m < 4; ++m) { const int row = row0 + ai * 128 + m * 16; float ss = 0.f;
#pragma unroll
                    for (int bj = 0; bj < 2; ++bj)
#pragma unroll
                        for (int n = 0; n < 2; ++n) { const f32x4 v = acc[ai][bj][m][n]; ss += (v[0] * v[0] + v[1] * v[1]) + (v[2] * v[2] + v[3] * v[3]);
                            st_bf16x4(dst + (size_t)row * ld + ct * 256 + bj * 128 + cl0 + n * 16, v); }
                    ss += __shfl_xor(ss, 16); ss += __shfl_xor(ss, 32);
                    if (fq == 0) { if (isq) stq[row * 16 + ct * 4 + wc] = ss; else stkv[row * 8 + ct * 4 + wc] = ss; } }
        } else if (pn == 6) {
            if (wc < 2) {
#pragma unroll
                for (int ai = 0; ai < 2; ++ai)
#pragma unroll
                    for (int m = 0; m < 4; ++m) { const int row = row0 + ai * 128 + m * 16, j0 = 16 * wc + 4 * fq;
                        const f32x4 x1 = acc[ai][0][m][0], x2 = acc[ai][0][m][1];
                        const f32x4 c0 = *(const f32x4*)(rope + (size_t)row * 64 + 2 * j0), c1 = *(const f32x4*)(rope + (size_t)row * 64 + 2 * j0 + 4);
                        const float cs[4] = {c0[0], c0[2], c1[0], c1[2]}, sn[4] = {c0[1], c0[3], c1[1], c1[3]};
                        f32x4 o1, o2;
#pragma unroll
                        for (int e = 0; e < 4; ++e) { o1[e] = x1[e] * cs[e] - x2[e] * sn[e]; o2[e] = x2[e] * cs[e] + x1[e] * sn[e]; }
                        st_bf16x4(kpe + (size_t)row * 64 + j0, o1); st_bf16x4(kpe + (size_t)row * 64 + 32 + j0, o2); }
            }
        } else if (pn < 15) {
#pragma unroll
            for (int ai = 0; ai < 2; ++ai)
#pragma unroll
                for (int m = 0; m < 4; ++m) { const int row = row0 + ai * 128 + m * 16;
#pragma unroll
                    for (int bj = 0; bj < 2; ++bj)
#pragma unroll
                        for (int n = 0; n < 2; ++n) { f32x4 v = acc[ai][bj][m][n];
#pragma unroll
                            for (int e = 0; e < 4; ++e) v[e] = gelu_f(v[e]);
                            st_bf16x4(u + (size_t)row * GW + (pn - 7) * 256 + bj * 128 + cl0 + n * 16, v); } }
        } else {
            const int ct = pn - 15;
#pragma unroll
            for (int ai = 0; ai < 2; ++ai)
#pragma unroll
                for (int m = 0; m < 4; ++m) { const int row = row0 + ai * 128 + m * 16, b = row >> 12, s = row & 4095; float s1 = 0.f, s2 = 0.f;
#pragma unroll
                    for (int bj = 0; bj < 2; ++bj)
#pragma unroll
                        for (int n = 0; n < 2; ++n) { const f32x4 v = acc[ai][bj][m][n]; const int col = ct * 256 + bj * 128 + cl0 + n * 16;
#pragma unroll
                            for (int e = 0; e < 4; ++e) { const float g = gelu_f(v[e]); s1 += g; s2 += g * g; vt[((size_t)b * GW + col + e) * SEQ + s] = (bf16)f2bf(g); } }
                    s1 += __shfl_xor(s1, 16); s1 += __shfl_xor(s1, 32); s2 += __shfl_xor(s2, 16); s2 += __shfl_xor(s2, 32);
                    if (fq == 0) { stvs[row * 32 + ct * 4 + wc] = s1; stvq[row * 32 + ct * 4 + wc] = s2; } }
        }
    }
};

struct EpiQ {
    static constexpr bool MID = false;
    bf16* q; const float* stq; const float* rope;
    __device__ __forceinline__ void operator()(const f32x4 (&acc)[2][2][4][2], const pg8::Unit& un, int wr, int wc, int fr, int fq) const {
        const int pn = un.pn, row0 = un.pm * 256 + wr * 64 + fr;
#pragma unroll
        for (int ai = 0; ai < 2; ++ai)
#pragma unroll
            for (int m = 0; m < 4; ++m) { const int row = row0 + ai * 128 + m * 16;
                const float rs = rsqrtf(sum_parts(stq + row * 16, 4) * (1.0f / QLR) + EPS);
#pragma unroll
                for (int bj = 0; bj < 2; ++bj) { const int blk = 4 * pn + 2 * bj + (wc >> 1), head = blk / 3, part = blk - 3 * head;
                    if (part != 2) {
#pragma unroll
                        for (int n = 0; n < 2; ++n) st_bf16x4(q + (size_t)row * (NH * QKD) + pn * 256 + bj * 128 + wc * 32 + n * 16 + 4 * fq, acc[ai][bj][m][n] * rs);
                    } else {
                        const int j0 = 16 * (wc & 1) + 4 * fq; const f32x4 x1 = acc[ai][bj][m][0] * rs, x2 = acc[ai][bj][m][1] * rs;
                        const f32x4 c0 = *(const f32x4*)(rope + (size_t)row * 64 + 2 * j0), c1 = *(const f32x4*)(rope + (size_t)row * 64 + 2 * j0 + 4);
                        const float cs[4] = {c0[0], c0[2], c1[0], c1[2]}, sn[4] = {c0[1], c0[3], c1[1], c1[3]};
                        f32x4 o1, o2;
#pragma unroll
                        for (int e = 0; e < 4; ++e) { o1[e] = x1[e] * cs[e] - x2[e] * sn[e]; o2[e] = x2[e] * cs[e] + x1[e] * sn[e]; }
                        bf16* base = q + (size_t)row * (NH * QKD) + head * QKD + NOPE;
                        st_bf16x4(base + j0, o1); st_bf16x4(base + 32 + j0, o2);
                    } } }
    }
};

struct EpiKV {
    static constexpr bool MID = false;
    bf16 *kn, *vta; const float* stkv;
    __device__ __forceinline__ void operator()(const f32x4 (&acc)[2][2][4][2], const pg8::Unit& un, int wr, int wc, int fr, int fq) const {
        const int pn = un.pn, row0 = un.pm * 256 + wr * 64 + fr;
#pragma unroll
        for (int ai = 0; ai < 2; ++ai)
#pragma unroll
            for (int m = 0; m < 4; ++m) { const int row = row0 + ai * 128 + m * 16, b = row >> 12, sp = sperm16(row & 4095);
                const float rs = rsqrtf(sum_parts(stkv + row * 8, 2) * (1.0f / KVLR) + EPS);
#pragma unroll
                for (int n = 0; n < 2; ++n) { const int d0 = wc * 32 + n * 16 + 4 * fq;
                    st_bf16x4(kn + (size_t)row * (NH * NOPE) + pn * NOPE + d0, acc[ai][0][m][n] * rs);
                    const f32x4 v = acc[ai][1][m][n] * rs;
#pragma unroll
                    for (int e = 0; e < 4; ++e) vta[(((size_t)b * NH + pn) * VD + d0 + e) * SEQ + sp] = (bf16)f2bf(v[e]); } }
    }
};

struct EpiX1 {
    static constexpr bool MID = true;
    const float* mod; bf16* mix; const LAS f32x2* rs; int pm0;
    __device__ __forceinline__ void mid(f32x4 (&acc)[2][2][4][2], const pg8::Unit& un, int wr, int wc, int fr, int fq) const {
        const LAS f32x2* p = rs + (un.pm == pm0 ? 0 : 256) + wr * 64 + fr;
#pragma unroll
        for (int ai = 0; ai < 2; ++ai)
#pragma unroll
            for (int m = 0; m < 4; ++m) { const float ratio = p[ai * 128 + m * 16].x;
#pragma unroll
                for (int bj = 0; bj < 2; ++bj)
#pragma unroll
                    for (int n = 0; n < 2; ++n) acc[ai][bj][m][n] *= ratio; }
    }
    __device__ __forceinline__ void operator()(const f32x4 (&acc)[2][2][4][2], const pg8::Unit& un, int wr, int wc, int fr_, int fq_) const {
        int fr = fr_, fq = fq_; asm volatile("" : "+v"(fr), "+v"(fq));
        const int pn = un.pn, row0 = un.pm * 256 + wr * 64 + fr, b = (un.pm * 256) >> 12;
        const LAS f32x2* p = rs + (un.pm == pm0 ? 0 : 256) + wr * 64 + fr;
        f32x4 gt[2][2];
#pragma unroll
        for (int bj = 0; bj < 2; ++bj)
#pragma unroll
            for (int n = 0; n < 2; ++n) gt[bj][n] = *(const f32x4*)(mod + (size_t)b * 6 * D + 2 * D + pn * 256 + bj * 128 + wc * 32 + n * 16 + 4 * fq);
#pragma unroll
        for (int ai = 0; ai < 2; ++ai)
#pragma unroll
            for (int m = 0; m < 4; ++m) { const int row = row0 + ai * 128 + m * 16; const size_t ro = (size_t)row * D;
                const float rg = p[ai * 128 + m * 16].y;
#pragma unroll
                for (int bj = 0; bj < 2; ++bj)
#pragma unroll
                    for (int n = 0; n < 2; ++n) { const int col = pn * 256 + bj * 128 + wc * 32 + n * 16 + 4 * fq;
                        st_bf16x4(mix + ro + col, gt[bj][n] * (acc[ai][bj][m][n] * rg)); } }
    }
};

struct EpiQP {
    static constexpr bool MID = false;
    bf16* qp;
    __device__ __forceinline__ void operator()(const f32x4 (&acc)[2][2][4][2], const pg8::Unit& un, int wr, int wc, int fr, int fq) const {
        const int pn = un.pn, row0 = un.pm * 256 + wr * 64 + fr;
#pragma unroll
        for (int ai = 0; ai < 2; ++ai)
#pragma unroll
            for (int m = 0; m < 4; ++m) { const size_t ro = (size_t)(row0 + ai * 128 + m * 16) * PQW;
#pragma unroll
                for (int bj = 0; bj < 2; ++bj)
#pragma unroll
                    for (int n = 0; n < 2; ++n) st_bf16x4(qp + ro + pn * 256 + bj * 128 + wc * 32 + n * 16 + 4 * fq, acc[ai][bj][m][n]); }
    }
};

struct Ctx {
    const float *x, *c; const int* pos; const float *w_ada, *b_ada, *g_mix, *w_in, *g_q, *w_uq, *g_kv, *w_ukv, *g_sgu, *w_sgu, *b_sgu, *beta_mla, *beta_g, *w_out, *g_ffn, *w_pq, *pkeys, *eu, *ev, *w_adaf, *b_adaf, *g_f;
    float* out; unsigned char* ws;
};

__device__ __forceinline__ void ada_unit(const Ctx& C, int unit, LAS float* red, int tid, int wave, int lane) {
    const bool fin = unit >= 192; const float* W = fin ? C.w_adaf : C.w_ada; const int N = fin ? 2 * D : 6 * D, n0 = (fin ? unit - 192 : unit) * 128;
    const int half = lane >> 5, l32 = lane & 31;
    f32x4 a0 = {0.f, 0.f, 0.f, 0.f}, a1 = {0.f, 0.f, 0.f, 0.f};
    const int kbeg = wave * 512;
    LAS float* sil = red + 2048;
#pragma unroll
    for (int j = 0; j < 16; ++j) { const float cv = C.c[tid + 512 * j]; sil[tid + 512 * j] = cv / (1.0f + __expf(-cv)); }
    __syncthreads();
#pragma unroll 8
    for (int i = 0; i < 256; ++i) { const int k = kbeg + 2 * i + half;
        const f32x4 w = *(const f32x4*)(W + (size_t)k * N + n0 + 4 * l32);
        const float s0 = sil[k], s1 = sil[D + k];
        a0 += w * s0; a1 += w * s1; }
#pragma unroll
    for (int e = 0; e < 4; ++e) { a0[e] += __shfl_xor(a0[e], 32); a1[e] += __shfl_xor(a1[e], 32); }
    if (half == 0) { *(LAS f32x4*)(red + (wave * 32 + l32) * 8) = a0; *(LAS f32x4*)(red + (wave * 32 + l32) * 8 + 4) = a1; }
    __syncthreads();
    if (tid < 256) { const int b = tid >> 7, col = tid & 127; float s = 0.f;
#pragma unroll
        for (int w = 0; w < 8; ++w) s += red[(w * 32 + (col >> 2)) * 8 + b * 4 + (col & 3)];
        const float* bias = fin ? C.b_adaf : C.b_ada;
        float* o = (float*)(C.ws + WS_MOD) + (fin ? 2 * 6 * D : 0) + (size_t)b * N + n0 + col;
        *o = s + bias[n0 + col]; }
    __syncthreads();
}

enum { MAP_ID = 0, MAP_W1 = 1, MAP_UQ = 2 };
__device__ __forceinline__ int ropeperm(int p) { return ((p >> 4) & 1) * 32 + 16 * (p >> 5) + (p & 15); }
template <int MAP> __device__ __forceinline__ int colmap(int n) {
    if (MAP == MAP_W1) { if (n < 1536) return n; if (n < 1600) return 1536 + ropeperm(n - 1536); if (n < 1792) return -1; return n - 192; }
    if (MAP == MAP_UQ) { const int blk = n >> 6; if (blk % 3 == 2) return (n & ~63) + ropeperm(n & 63); return n; }
    return n;
}
template <int MAP> __device__ __forceinline__ void transpose_item(const float* W, int K, int N, int NP, bf16* WT, const float* ks, float mul, LAS float* scr, int item, int lane) {
    const int nblk = NP / 32, kb = item / nblk, nb = item % nblk, k0 = 64 * kb, n0 = 32 * nb;
    const int q4 = lane & 7, src = colmap<MAP>(n0 + 4 * q4);
    f32x4 ld[8];
#pragma unroll
    for (int i = 0; i < 8; ++i) { const int kk = (lane >> 3) + 8 * i; ld[i] = (src >= 0) ? *(const f32x4*)(W + (size_t)(k0 + kk) * N + src) : (f32x4){0.f, 0.f, 0.f, 0.f}; }
#pragma unroll
    for (int i = 0; i < 8; ++i) { const int kk = (lane >> 3) + 8 * i;
#pragma unroll
        for (int e = 0; e < 4; ++e) scr[kk * 33 + 4 * q4 + e] = ld[i][e]; }
    LDS_WAIT(); asm volatile("" ::: "memory");
    const int c = lane & 7;
    float sc[8];
#pragma unroll
    for (int e = 0; e < 8; ++e) sc[e] = (ks ? ks[k0 + 8 * c + e] : 1.0f) * mul;
#pragma unroll
    for (int j = 0; j < 4; ++j) { const int n = (lane >> 3) + 8 * j; const LAS float* s = scr + (8 * c) * 33 + n;
        u32x4 o; o.x = pk2(s[0 * 33] * sc[0], s[1 * 33] * sc[1]); o.y = pk2(s[2 * 33] * sc[2], s[3 * 33] * sc[3]); o.z = pk2(s[4 * 33] * sc[4], s[5 * 33] * sc[5]); o.w = pk2(s[6 * 33] * sc[6], s[7 * 33] * sc[7]);
        *(u32x4*)(WT + (size_t)(n0 + n) * K + k0 + 8 * c) = o; }
    LDS_WAIT(); asm volatile("" ::: "memory");
}

__device__ __forceinline__ float wave_max_nonneg(float v) {
    v = fmaxf(v, __builtin_bit_cast(float, __builtin_amdgcn_update_dpp(0, __builtin_bit_cast(int, v), 0xB1, 0xF, 0xF, true)));
    v = fmaxf(v, __builtin_bit_cast(float, __builtin_amdgcn_update_dpp(0, __builtin_bit_cast(int, v), 0x4E, 0xF, 0xF, true)));
    v = fmaxf(v, __builtin_bit_cast(float, __builtin_amdgcn_update_dpp(0, __builtin_bit_cast(int, v), 0x141, 0xF, 0xF, true)));
    v = fmaxf(v, __builtin_bit_cast(float, __builtin_amdgcn_update_dpp(0, __builtin_bit_cast(int, v), 0x140, 0xF, 0xF, true)));
    v = fmaxf(v, __builtin_bit_cast(float, __builtin_amdgcn_update_dpp(0, __builtin_bit_cast(int, v), 0x142, 0xA, 0xF, true)));
    v = fmaxf(v, __builtin_bit_cast(float, __builtin_amdgcn_update_dpp(0, __builtin_bit_cast(int, v), 0x143, 0xC, 0xF, true)));
    return __builtin_bit_cast(float, __builtin_amdgcn_readlane(__builtin_bit_cast(int, v), 63));
}
template <bool Q8> __device__ __forceinline__ void norm_mod_rows(const float* X, const bf16* ADD, const float* g, const float* sh, const float* sc, bf16* O, signed char* O8, float* S8, bf16* X1O, int gw, int NGW, int lane) {
    f32x4 vn[16]; u32x2 an[16];
    if (gw < M) {
#pragma unroll
        for (int j = 0; j < 16; ++j) { vn[j] = ((const f32x4*)(X + (size_t)gw * D))[64 * j + lane]; if (Q8) an[j] = ((const u32x2*)(ADD + (size_t)gw * D))[64 * j + lane]; } }
    for (int m = gw; m < M; m += NGW) { const int b = m >> 12;
        f32x4 v[16]; float ss = 0.f;
#pragma unroll
        for (int j = 0; j < 16; ++j) { v[j] = vn[j];
            if (Q8) v[j] += (f32x4){bf2f(an[j].x & 0xffffu), bf2f(an[j].x >> 16), bf2f(an[j].y & 0xffffu), bf2f(an[j].y >> 16)};
            ss += (v[j][0] * v[j][0] + v[j][1] * v[j][1]) + (v[j][2] * v[j][2] + v[j][3] * v[j][3]); }
        if (m + NGW < M) {
#pragma unroll
            for (int j = 0; j < 16; ++j) { vn[j] = ((const f32x4*)(X + (size_t)(m + NGW) * D))[64 * j + lane]; if (Q8) an[j] = ((const u32x2*)(ADD + (size_t)(m + NGW) * D))[64 * j + lane]; } }
        const float rs = rsqrtf(wave_sum(ss) * (1.0f / D) + EPS);
        const char* gp = (const char*)g; const char* scp = (const char*)(sc + (size_t)b * 6 * D); const char* shp = (const char*)(sh + (size_t)b * 6 * D);
        char* op = (char*)(O + (size_t)m * D); char* o8p = (char*)(O8 + (size_t)m * D); char* x1p = (char*)(X1O + (size_t)m * D);
        int lanev = lane; asm volatile("" : "+v"(lanev));
        float amx = 0.f;
#pragma unroll
        for (int j = 0; j < 16; ++j) { const unsigned cb = (unsigned)(64 * j + lanev) * 16u;
            const f32x4 gg = *(const f32x4*)(gp + cb), s1 = *(const f32x4*)(scp + cb), s0 = *(const f32x4*)(shp + cb);
            const f32x4 y = v[j] * rs * gg * (s1 + 1.0f) + s0;
            u32x2 w; w.x = pk2(y[0], y[1]); w.y = pk2(y[2], y[3]); *(u32x2*)(op + (cb >> 1)) = w;
            if (Q8) { u32x2 w1; w1.x = pk2(v[j][0], v[j][1]); w1.y = pk2(v[j][2], v[j][3]); *(u32x2*)(x1p + (cb >> 1)) = w1;
                v[j] = y; amx = fmaxf(amx, fmaxf(fmaxf(fabsf(y[0]), fabsf(y[1])), fmaxf(fabsf(y[2]), fabsf(y[3])))); }
            if ((j & 1) == 1) __builtin_amdgcn_sched_barrier(0); }
        if (Q8) {
            const float am = wave_max_nonneg(amx), q = am > 0.f ? 127.0f / am : 0.f;
            asm volatile("" : "+v"(lanev));
#pragma unroll
            for (int j = 0; j < 16; ++j) { const unsigned cb = (unsigned)(64 * j + lanev) * 4u;
                const int q0 = (int)rintf(v[j][0] * q), q1 = (int)rintf(v[j][1] * q), q2 = (int)rintf(v[j][2] * q), q3 = (int)rintf(v[j][3] * q);
                *(unsigned*)(o8p + cb) = (unsigned)(q0 & 255) | ((unsigned)(q1 & 255) << 8) | ((unsigned)(q2 & 255) << 16) | ((unsigned)(q3 & 255) << 24); }
            if (lane == 0) S8[m] = am * (1.0f / 127.0f); } }
}

constexpr int SG_ROW = 272;
__device__ __forceinline__ void sgu_units(const Ctx& C, int u0, int uend, int ustep, LAS unsigned char* lds, int tid, int wave, int lane) {
#define SG_LBAR() do { asm volatile("s_waitcnt lgkmcnt(0)" ::: "memory"); __builtin_amdgcn_s_barrier(); asm volatile("" ::: "memory"); } while (0)
    const bf16* VT = (const bf16*)(C.ws + WS_VT); const bf16* U = (const bf16*)(C.ws + WS_U); bf16* Y = (bf16*)(C.ws + WS_Y);
    const float* stvs = (const float*)(C.ws + WS_STVS); const float* stvq = (const float*)(C.ws + WS_STVQ); float* stg = (float*)(C.ws + WS_STG);
    const bf16* WS = (const bf16*)(C.ws + WS_WSGU);
    LAS float* mu = (LAS float*)(lds + 128 * SG_ROW); LAS float* rstd = mu + 128;
    const int r = lane & 31, hi = lane >> 5, db = wave >> 1;
    u32x4 raw[4]; float gq[4]; float ps1 = 0.f, ps2 = 0.f;
#define SG_FETCH(unit_) do { const int hh_ = (unit_) & 15, n_ = ((unit_) >> 4) & 31, b_ = (unit_) >> 9, tok0_ = b_ * SEQ + n_ * GC; int tidv_ = tid; asm volatile("" : "+v"(tidv_)); \
        if (tidv_ < 128) { ps1 = sum_parts(stvs + (size_t)(tok0_ + tidv_) * 32, 8); ps2 = sum_parts(stvq + (size_t)(tok0_ + tidv_) * 32, 8); } \
        _Pragma("unroll") for (int i = 0; i < 4; ++i) { const int idx = tidv_ + 512 * i, d = idx >> 4, ch = idx & 15; \
            raw[i] = *(const u32x4*)(VT + ((size_t)b_ * GW + hh_ * 128 + d) * SEQ + n_ * GC + ch * 8); gq[i] = C.g_sgu[hh_ * 128 + d]; } } while (0)
    __syncthreads();
    if (u0 < uend) SG_FETCH(u0);
    for (int unit = u0; unit < uend; unit += ustep) {
        const int hh = unit & 15, n = (unit >> 4) & 31, b = unit >> 9, tok0 = b * SEQ + n * GC;
        if (tid < 128) { const float mean = ps1 * (1.0f / GW), var = fmaxf(ps2 * (1.0f / GW) - mean * mean, 0.f); mu[tid] = mean; rstd[tid] = rsqrtf(var + EPS); }
        bf16x8 wv[2][8]; u32x2 uu[2][4]; float bias[2];
#pragma unroll
        for (int tt = 0; tt < 2; ++tt) { const int t = 32 * (2 * (wave & 1) + tt) + r;
#pragma unroll
            for (int ks = 0; ks < 8; ++ks) wv[tt][ks] = *(const bf16x8*)(WS + ((size_t)hh * 128 + t) * 128 + 16 * ks + 8 * hi);
#pragma unroll
            for (int g4 = 0; g4 < 4; ++g4) uu[tt][g4] = *(const u32x2*)(U + (size_t)(tok0 + t) * GW + hh * 128 + 32 * db + 8 * g4 + 4 * hi);
            bias[tt] = C.b_sgu[hh * 128 + t]; }
        SG_LBAR();
#pragma unroll
        for (int i = 0; i < 4; ++i) { const int idx = tid + 512 * i, d = idx >> 4, ch = idx & 15;
            const float g = gq[i];
            float f[8];
#pragma unroll
            for (int e = 0; e < 4; ++e) { f[2 * e] = bf2f(raw[i][e] & 0xffffu); f[2 * e + 1] = bf2f(raw[i][e] >> 16); }
#pragma unroll
            for (int e = 0; e < 8; ++e) f[e] = (f[e] - mu[ch * 8 + e]) * rstd[ch * 8 + e] * g;
            u32x4 o; o.x = pk2(f[0], f[1]); o.y = pk2(f[2], f[3]); o.z = pk2(f[4], f[5]); o.w = pk2(f[6], f[7]);
            *(LAS u32x4*)(lds + d * SG_ROW + ch * 16) = o; }
        SG_LBAR();
        if (unit + ustep < uend) SG_FETCH(unit + ustep);
#pragma unroll
        for (int tt = 0; tt < 2; ++tt) { const int tb = 2 * (wave & 1) + tt;
            f32x16 acc; for (int i = 0; i < 16; ++i) acc[i] = 0.f;
#pragma unroll
            for (int ks = 0; ks < 8; ++ks) { if (ks <= 2 * tb + 1) {
                const bf16x8 a = *(const LAS bf16x8*)(lds + (32 * db + r) * SG_ROW + ks * 32 + hi * 16);
                acc = __builtin_amdgcn_mfma_f32_32x32x16_bf16(a, wv[tt][ks], acc, 0, 0, 0); } }
            const int t = 32 * tb + r, tok = tok0 + t; float ss = 0.f;
#pragma unroll
            for (int g4 = 0; g4 < 4; ++g4) { const int d0 = 32 * db + 8 * g4 + 4 * hi; const u32x2 u2 = uu[tt][g4];
                f32x4 y; y[0] = bf2f(u2.x & 0xffffu) * (acc[4 * g4 + 0] + bias[tt]); y[1] = bf2f(u2.x >> 16) * (acc[4 * g4 + 1] + bias[tt]);
                y[2] = bf2f(u2.y & 0xffffu) * (acc[4 * g4 + 2] + bias[tt]); y[3] = bf2f(u2.y >> 16) * (acc[4 * g4 + 3] + bias[tt]);
                ss += (y[0] * y[0] + y[1] * y[1]) + (y[2] * y[2] + y[3] * y[3]);
                st_bf16x4(Y + (size_t)tok * D + GW + hh * 128 + d0, y); }
            ss += __shfl_xor(ss, 32);
            if (hi == 0) ((LAS float*)(lds + 128 * SG_ROW + 1024))[t * 4 + db] = ss; }
        SG_LBAR();
        if (tid < 128) { const f32x4 p4 = *(const LAS f32x4*)(lds + 128 * SG_ROW + 1024 + tid * 16); stg[(size_t)(tok0 + tid) * 16 + hh] = (p4[0] + p4[1]) + (p4[2] + p4[3]); }
    }
    __syncthreads();
#undef SG_FETCH
#undef SG_LBAR
}

constexpr int AK_ROW = 400, AV_ROW = 144, AK_BYTES = 64 * AK_ROW, AV_BYTES = 128 * AV_ROW, ABUF = AK_BYTES + AV_BYTES;
__device__ __forceinline__ void attn_block(const Ctx& C, int b, int h, int qb, LAS unsigned char* lds, int tid, int wave, int lane) {
    const bf16* Q = (const bf16*)(C.ws + WS_Q); const bf16* KN = (const bf16*)(C.ws + WS_KN); const bf16* KPE = (const bf16*)(C.ws + WS_KPE);
    const bf16* VTA = (const bf16*)(C.ws + WS_VTA); bf16* Y = (bf16*)(C.ws + WS_Y); float* stm = (float*)(C.ws + WS_STM);
    const int r = lane & 31, hi = lane >> 5, q0 = qb * 256, q0w = q0 + 32 * wave; const size_t tokq = (size_t)b * SEQ + q0w + r;
    bf16x8 qf[12];
#pragma unroll
    for (int ks = 0; ks < 12; ++ks) qf[ks] = *(const bf16x8*)(Q + tokq * (NH * QKD) + h * QKD + 16 * ks + 8 * hi);
    f32x16 o[4];
#pragma unroll
    for (int db = 0; db < 4; ++db) for (int i = 0; i < 16; ++i) o[db][i] = 0.f;
    float mrun = -1e30f, lrun = 0.f;
    const int ntiles = (q0 + 256) / 64;
    const int kr0 = tid >> 4, kc0 = tid & 15, pr = tid >> 3, pc = tid & 7;
    const unsigned ok0 = (((unsigned)b * SEQ + kr0) * (NH * NOPE) + h * NOPE + kc0 * 8) * 2u;
    const unsigned op0 = (((unsigned)b * SEQ + pr) * ROPE + pc * 8) * 2u;
    const unsigned ov0 = ((((unsigned)b * NH + h) * VD + pr) * SEQ + pc * 8) * 2u;
    const unsigned lk0 = kr0 * AK_ROW + kc0 * 16, lk1 = (kr0 + 32) * AK_ROW + kc0 * 16, lp = pr * AK_ROW + 256 + pc * 16;
    const unsigned lv0 = AK_BYTES + pr * AV_ROW + pc * 16, lv1 = AK_BYTES + (pr + 64) * AV_ROW + pc * 16;
    u32x4 st[5];
#define ATT_GLOAD(j) do { const unsigned j_ = (unsigned)(j); \
        st[0] = *(const u32x4*)((const char*)KN + (ok0 + j_ * (64u * NH * NOPE * 2u))); st[1] = *(const u32x4*)((const char*)KN + (ok0 + j_ * (64u * NH * NOPE * 2u) + 32u * NH * NOPE * 2u)); \
        st[2] = *(const u32x4*)((const char*)KPE + (op0 + j_ * (64u * ROPE * 2u))); \
        st[3] = *(const u32x4*)((const char*)VTA + (ov0 + j_ * 128u)); st[4] = *(const u32x4*)((const char*)VTA + (ov0 + j_ * 128u + 64u * SEQ * 2u)); } while (0)
    ATT_GLOAD(0);
    for (int j = 0; j < ntiles; ++j) {
        LAS unsigned char* buf = lds + (j & 1) * ABUF;
        *(LAS u32x4*)(buf + lk0) = st[0]; *(LAS u32x4*)(buf + lk1) = st[1]; *(LAS u32x4*)(buf + lp) = st[2]; *(LAS u32x4*)(buf + lv0) = st[3]; *(LAS u32x4*)(buf + lv1) = st[4];
        if (j + 1 < ntiles) ATT_GLOAD(j + 1);
        __syncthreads();
        const int kbase = 64 * j;
        if (kbase <= q0w + 31) {
            f32x16 s0, s1;
#pragma unroll
            for (int i = 0; i < 16; ++i) { s0[i] = 0.f; s1[i] = 0.f; }
#pragma unroll
            for (int ks = 0; ks < 12; ++ks) {
                const bf16x8 k0 = *(const LAS bf16x8*)(buf + r * AK_ROW + ks * 32 + hi * 16);
                const bf16x8 k1 = *(const LAS bf16x8*)(buf + (32 + r) * AK_ROW + ks * 32 + hi * 16);
                s0 = __builtin_amdgcn_mfma_f32_32x32x16_bf16(k0, qf[ks], s0, 0, 0, 0);
                s1 = __builtin_amdgcn_mfma_f32_32x32x16_bf16(k1, qf[ks], s1, 0, 0, 0);
                if ((ks & 3) == 3) __builtin_amdgcn_sched_barrier(0); }
            if (kbase + 63 > q0w) {
                const int qrow = q0w + r;
#pragma unroll
                for (int i = 0; i < 16; ++i) { const int key = kbase + (i & 3) + 8 * (i >> 2) + 4 * hi;
                    s0[i] = key > qrow ? -INFINITY : s0[i]; s1[i] = key + 32 > qrow ? -INFINITY : s1[i]; }
            }
            float mx = fmaxf(s0[0], s1[0]);
#pragma unroll
            for (int i = 1; i < 16; ++i) mx = fmaxf(mx, fmaxf(s0[i], s1[i]));
            mx = fmaxf(mx, __shfl_xor(mx, 32));
            if (!__all(mx - mrun <= 8.0f)) { const float mn = fmaxf(mrun, mx), alpha = __builtin_amdgcn_exp2f(mrun - mn); mrun = mn; lrun *= alpha;
#pragma unroll
                for (int db = 0; db < 4; ++db)
#pragma unroll
                    for (int i = 0; i < 16; ++i) o[db][i] *= alpha; }
            float rsum = 0.f;
#pragma unroll
            for (int i = 0; i < 16; ++i) { s0[i] = __builtin_amdgcn_exp2f(s0[i] - mrun); s1[i] = __builtin_amdgcn_exp2f(s1[i] - mrun); rsum += s0[i] + s1[i]; }
            lrun += rsum;
            bf16x8 pf[4];
#pragma unroll
            for (int t = 0; t < 2; ++t) {
                u32x4 w0, w1;
#pragma unroll
                for (int e = 0; e < 4; ++e) { w0[e] = pk2(s0[8 * t + 2 * e], s0[8 * t + 2 * e + 1]); w1[e] = pk2(s1[8 * t + 2 * e], s1[8 * t + 2 * e + 1]); }
                pf[t] = __builtin_bit_cast(bf16x8, w0); pf[2 + t] = __builtin_bit_cast(bf16x8, w1); }
#pragma unroll
            for (int s4 = 0; s4 < 4; ++s4)
#pragma unroll
                for (int db = 0; db < 4; ++db) {
                    const bf16x8 v = *(const LAS bf16x8*)(buf + AK_BYTES + (32 * db + r) * AV_ROW + s4 * 32 + hi * 16);
                    o[db] = __builtin_amdgcn_mfma_f32_32x32x16_bf16(v, pf[s4], o[db], 0, 0, 0); }
        }
    }
#undef ATT_GLOAD
    const float lt = lrun + __shfl_xor(lrun, 32), inv = 1.0f / lt; float ss = 0.f;
#pragma unroll
    for (int db = 0; db < 4; ++db)
#pragma unroll
        for (int g4 = 0; g4 < 4; ++g4) { const int d0 = 32 * db + 8 * g4 + 4 * hi;
            f32x4 y; y[0] = o[db][4 * g4] * inv; y[1] = o[db][4 * g4 + 1] * inv; y[2] = o[db][4 * g4 + 2] * inv; y[3] = o[db][4 * g4 + 3] * inv;
            ss += (y[0] * y[0] + y[1] * y[1]) + (y[2] * y[2] + y[3] * y[3]);
            st_bf16x4(Y + tokq * D + h * VD + d0, y); }
    ss += __shfl_xor(ss, 32);
    if (hi == 0) stm[tokq * 16 + h] = ss;
}

#define CE_DESC(a, b) do { const float hi_ = fmaxf(a, b), lo_ = fminf(a, b); a = hi_; b = lo_; } while (0)
#define CE_ASC(a, b) do { const float hi_ = fmaxf(a, b), lo_ = fminf(a, b); a = lo_; b = hi_; } while (0)
__device__ __forceinline__ void bitonic_merge16_desc(float (&v)[64], const int base) {
#pragma unroll
    for (int j = 8; j > 0; j >>= 1)
#pragma unroll
        for (int i = 0; i < 16; ++i) { const int l = i ^ j; if (l > i) CE_DESC(v[base + i], v[base + l]); }
}
__device__ __forceinline__ void bitonic_sort16_desc(float (&v)[64], const int base) {
#pragma unroll
    for (int k = 2; k <= 16; k <<= 1)
#pragma unroll
        for (int j = k >> 1; j > 0; j >>= 1)
#pragma unroll
            for (int i = 0; i < 16; ++i) { const int l = i ^ j; if (l > i) { if ((i & k) == 0) CE_DESC(v[base + i], v[base + l]); else CE_ASC(v[base + i], v[base + l]); } }
}
__device__ __forceinline__ void merge_top16(float (&v)[64], const int a0, const int b0) {
#pragma unroll
    for (int i = 0; i < 16; ++i) v[a0 + i] = fmaxf(v[a0 + i], v[b0 + 15 - i]);
    bitonic_merge16_desc(v, a0);
}
__device__ __forceinline__ void top16_of_64(float (&v)[64]) {
    bitonic_sort16_desc(v, 0); bitonic_sort16_desc(v, 16); bitonic_sort16_desc(v, 32); bitonic_sort16_desc(v, 48);
    merge_top16(v, 0, 16); merge_top16(v, 32, 48); merge_top16(v, 0, 32);
}
__device__ __forceinline__ void topk_item(const Ctx& C, int item, LAS float* top  , LAS int* pe, LAS float* pg, int lane) {
    const bf16* QP = (const bf16*)(C.ws + WS_QP); const bf16* KEYS = (const bf16*)(C.ws + WS_KEYS);
    const int tb = item >> 3, hh = item & 7, r = lane & 31, hi = lane >> 5; const size_t tok = (size_t)tb * 32 + r;
#pragma unroll 1
    for (int p = 0; p < 2; ++p) {
        f32x16 sc[4];
#pragma unroll
        for (int nb = 0; nb < 4; ++nb) for (int i = 0; i < 16; ++i) sc[nb][i] = 0.f;
#pragma unroll
        for (int ks = 0; ks < 8; ++ks) {
            const bf16x8 bq = *(const bf16x8*)(QP + tok * PQW + hh * PQD + p * PHALF + 16 * ks + 8 * hi);
#pragma unroll
            for (int nb = 0; nb < 4; ++nb) {
                const bf16x8 ak = *(const bf16x8*)(KEYS + ((size_t)(hh * 2 + p) * PNK + 32 * nb + r) * PHALF + 16 * ks + 8 * hi);
                sc[nb] = __builtin_amdgcn_mfma_f32_32x32x16_bf16(ak, bq, sc[nb], 0, 0, 0); } }
        float v[64];
#pragma unroll
        for (int nb = 0; nb < 4; ++nb)
#pragma unroll
            for (int i = 0; i < 16; ++i) { const unsigned n = 32 * nb + (i & 3) + 8 * (i >> 2) + 4 * hi;
                const float scv = sc[nb][i]; v[nb * 16 + i] = __uint_as_float((__float_as_uint(scv) & 0xffffff80u) | n); }
        top16_of_64(v);
#pragma unroll
        for (int i = 0; i < 16; ++i) v[16 + i] = __shfl_xor(v[i], 32);
        merge_top16(v, 0, 16);
#pragma unroll
        for (int k = 0; k < 16; ++k) top[(p * 16 + k) * 64 + lane] = v[k];
    }
    LDS_WAIT();
    float sv0[16], sv1[16];
#pragma unroll
    for (int a = 0; a < 16; ++a) { sv0[a] = top[a * 64 + lane]; sv1[a] = top[(16 + a) * 64 + lane]; }
    float cd[64];
    { int c = 0;
#pragma unroll
      for (int a = 0; a < 16; ++a)
#pragma unroll
        for (int b = 0; b < 16; ++b) if ((a + 1) * (b + 1) <= 16) { cd[c] = __builtin_bit_cast(float, (__builtin_bit_cast(unsigned, sv0[a] + sv1[b]) & ~255u) | (unsigned)(a * 16 + b)); ++c; }
#pragma unroll
      for (int i = 50; i < 64; ++i) cd[i] = -INFINITY; }
    top16_of_64(cd);
#pragma unroll
    for (int k = 0; k < 16; ++k) top[(32 + k) * 64 + lane] = cd[k];
    LDS_WAIT();
    if (hi == 0) {
        const float s0 = top[32 * 64 + lane]; float ev[16]; int ei[16]; float sum = 0.f;
#pragma unroll
        for (int k = 0; k < 16; ++k) { const float s = top[(32 + k) * 64 + lane]; const unsigned code = __builtin_bit_cast(unsigned, s) & 255u, a = code >> 4, b = code & 15u;
            const unsigned i0 = __builtin_bit_cast(unsigned, top[a * 64 + lane]) & 127u, i1 = __builtin_bit_cast(unsigned, top[(16 + b) * 64 + lane]) & 127u;
            ei[k] = (int)(i0 * PNK + i1); ev[k] = __expf(s - s0); sum += ev[k]; }
        const float inv = 1.0f / sum;
        int rv = r; asm volatile("" : "+v"(rv));
#pragma unroll
        for (int k = 0; k < 16; ++k) { pe[rv * 128 + hh * 16 + k] = ei[k]; pg[rv * 128 + hh * 16 + k] = ev[k] * inv; }
    }
    LDS_WAIT();
}

__device__ __forceinline__ void order_pairs(const Ctx& C, int tb, LAS unsigned char* lds, int tid) {
    LAS int* pe = (LAS int*)(lds + 98304); LAS float* pg = (LAS float*)(lds + 98304 + 16384);
    LAS int* pe2 = (LAS int*)lds; LAS float* pg2 = (LAS float*)(lds + 32 * 129 * 4);
    int* lidx = (int*)(C.ws + WS_LIDX); float* lg = (float*)(C.ws + WS_LG); int* na = (int*)(C.ws + WS_NA);
    const int tk = tid >> 4, sub = tid & 15;
    int e[8]; float g[8]; int cnt = 0;
#pragma unroll
    for (int i = 0; i < 8; ++i) { e[i] = pe[tk * 128 + sub * 8 + i]; g[i] = pg[tk * 128 + sub * 8 + i]; cnt += (e[i] < PNE / 2) ? 1 : 0; }
    int inc = cnt;
#pragma unroll
    for (int o = 1; o < 16; o <<= 1) { const int v = __shfl_up(inc, o, 16); if (sub >= o) inc += v; }
    const int total = __shfl(inc, 15, 16); int pa = inc - cnt, pb = total + (sub * 8 - (inc - cnt));
#pragma unroll
    for (int i = 0; i < 8; ++i) { const bool isa = e[i] < PNE / 2; const int pos = isa ? pa : pb; pa += isa ? 1 : 0; pb += isa ? 0 : 1; pe2[tk * 129 + pos] = e[i]; pg2[tk * 129 + pos] = g[i]; }
    if (sub == 0) na[tb * 32 + tk] = total;
    __syncthreads();
#pragma unroll
    for (int i = 0; i < 8; ++i) { const int idx = i * 512 + tid, pos = idx >> 5, t2 = idx & 31;
        lidx[(size_t)pos * M + tb * 32 + t2] = pe2[t2 * 129 + pos]; lg[(size_t)pos * M + tb * 32 + t2] = pg2[t2 * 129 + pos]; }
}

__device__ __forceinline__ void expert_convert_unit(const Ctx& C, int u, LAS unsigned char* lds, int tid) {
    const int tbl = u >> 12, eb = (u >> 4) & 255, r = u & 15, row = tid >> 3, cq = tid & 7;
    const float* src = (tbl ? C.ev : C.eu) + (size_t)(eb * 64 + row) * D + r * 256 + cq * 32;
    f32x4 v[8]; float am = 0.f;
#pragma unroll
    for (int j = 0; j < 8; ++j) { v[j] = ((const f32x4*)src)[j]; am = fmaxf(am, fmaxf(fmaxf(fabsf(v[j][0]), fabsf(v[j][1])), fmaxf(fabsf(v[j][2]), fabsf(v[j][3])))); }
    am = fmaxf(am, __shfl_xor(am, 1)); am = fmaxf(am, __shfl_xor(am, 2)); am = fmaxf(am, __shfl_xor(am, 4));
    const float sc = am > 0.f ? 127.0f / am : 0.f, inv = am * (1.0f / 127.0f);
#pragma unroll
    for (int i = 0; i < 4; ++i) { unsigned w[2];
#pragma unroll
        for (int h = 0; h < 2; ++h) { const f32x4 x = v[2 * i + h] * sc;
            w[h] = (unsigned)((int)rintf(x[0]) & 255) | ((unsigned)((int)rintf(x[1]) & 255) << 8) | ((unsigned)((int)rintf(x[2]) & 255) << 16) | ((unsigned)((int)rintf(x[3]) & 255) << 24); }
        *(LAS u32x2*)(lds + (cq * 4 + i) * 512 + row * 8) = (u32x2){w[0], w[1]}; }
    if (cq == 0) ((float*)(C.ws + WS_ESC))[(size_t)PNE * 16 + (size_t)r * PNE + eb * 64 + row] = inv;
    LDS_BARRIER();
    unsigned char* dst = C.ws + WS_E8 + (size_t)tbl * (64 * MiB);
#pragma unroll
    for (int i = 0; i < 2; ++i) { const int p = tid + 512 * i, ls = p >> 5, off = (p & 31) * 16;
        *(u32x4*)(dst + ((size_t)(r * 32 + ls) * PNE + eb * 64) * 8 + off) = *(const LAS u32x4*)(lds + ls * 512 + off); }
    LDS_BARRIER();
}
__device__ __forceinline__ void expert_convert_u(const Ctx& C, int e, int lane) {
    const f32x4* src = (const f32x4*)(C.eu + (size_t)e * D) + lane;
    f32x4 v[16]; float am = 0.f;
#pragma unroll
    for (int j = 0; j < 16; ++j) v[j] = src[j * 64];
#pragma unroll
    for (int j = 0; j < 16; ++j) am = fmaxf(am, fmaxf(fmaxf(fabsf(v[j][0]), fabsf(v[j][1])), fmaxf(fabsf(v[j][2]), fabsf(v[j][3]))));
    am = wave_max_nonneg(am);
    const float sc = am > 0.f ? 127.0f / am : 0.f;
    const int el = e >> 4, et = (e ^ (e >> 7)) & 15, sw = (el >> 1) & 7;
    unsigned char* dst = C.ws + WS_E8 + ((size_t)(et * 32 + (lane >> 5)) * 1024 + el) * 128 + (((((lane & 31) >> 2) ^ sw) << 4) | ((lane & 3) << 2));
#pragma unroll
    for (int j = 0; j < 16; ++j) { const f32x4 x = v[j] * sc;
        *(unsigned*)(dst + (size_t)j * 262144) = (unsigned)((int)rintf(x[0]) & 255) | ((unsigned)((int)rintf(x[1]) & 255) << 8) | ((unsigned)((int)rintf(x[2]) & 255) << 16) | ((unsigned)((int)rintf(x[3]) & 255) << 24); }
    if (lane == 0) ((float*)(C.ws + WS_ESC))[e] = am * (1.0f / 127.0f);
}
#define PEER_FILL(tblbase, slice) do { const unsigned char* g_ = (tblbase) + (size_t)(slice) * (PNE * 8) + lane * 16; \
    _Pragma("unroll") for (int i_ = 0; i_ < 16; ++i_) { const int c_ = wave * 16 + i_; \
        __builtin_amdgcn_global_load_lds((const unsigned*)(g_ + c_ * 1024), (LAS unsigned*)(lds + c_ * 1024), 16, 0, 0); } } while (0)
#define PEER_WARM(tblbase, slice) do { const unsigned char* g_ = (tblbase) + (size_t)(slice) * (PNE * 8) + lane * 16; \
    _Pragma("unroll") for (int i_ = 0; i_ < 16; ++i_) { const int c_ = wave * 16 + i_; \
        __builtin_amdgcn_global_load_lds((const unsigned*)(g_ + c_ * 1024), (LAS unsigned*)(lds + 131072 + wave * 1024), 16, 0, 0); } } while (0)
typedef int i32x4 __attribute__((ext_vector_type(4)));
constexpr int UNG = 12;
__device__ __forceinline__ void peer_u_item(const Ctx& C, int tg, int et, LAS unsigned char* lds, int tid, int wave, int lane) {
    const int* lidx = (const int*)(C.ws + WS_LIDX); const signed char* H8 = (const signed char*)(C.ws + WS_H8); float* S = (float*)(C.ws + WS_PART); const float* sh = (const float*)(C.ws + WS_SH);
    const unsigned char* U8M = C.ws + WS_E8;
    const int tokw = tg * 512 + wave * 64;
    LAS int* Wa = (LAS int*)(lds + wave * 16384); LAS int* Wcn = Wa + 1280; LAS int* Wt = Wa + 1344; LAS int* Wo = Wa + 2048;
    __syncthreads();
#pragma unroll
    for (int i = 0; i < 20; ++i) Wa[i * 64 + lane] = -1;
    Wcn[lane] = 0;
    LDS_WAIT();
#define UCOL(q_) (((q_) & 1) ? 4 + ((q_) >> 1) : ((((q_) >> 1) < 4) ? ((q_) >> 1) : ((q_) >> 1) + 8))
#define PU_SLOW(tokl_, k2_, el_) do { const int tok_ = tokw + (tokl_), sw_ = ((el_) >> 1) & 7; int dsum_ = 0; \
        const unsigned char* trow_ = U8M + ((size_t)(et * 32 + (lane >> 1)) * 1024 + (el_)) * 128; \
        _Pragma("unroll") for (int q_ = 0; q_ < 4; ++q_) { const i32x4 hv_ = *(const i32x4*)(H8 + (size_t)tok_ * D + lane * 64 + q_ * 16), tv_ = *(const i32x4*)(trow_ + ((((lane & 1) * 4 + q_) ^ sw_) << 4)); \
            dsum_ = __builtin_amdgcn_sdot4(hv_[0], tv_[0], dsum_, false); dsum_ = __builtin_amdgcn_sdot4(hv_[1], tv_[1], dsum_, false); dsum_ = __builtin_amdgcn_sdot4(hv_[2], tv_[2], dsum_, false); dsum_ = __builtin_amdgcn_sdot4(hv_[3], tv_[3], dsum_, false); } \
        _Pragma("unroll") for (int o_ = 32; o_ >= 1; o_ >>= 1) dsum_ += __shfl_xor(dsum_, o_); \
        if (lane == 0) S[(size_t)(k2_) * M + tok_] = (float)dsum_ * sh[tok_]; } while (0)
    const int sgl = lane >> 4, tl = lane & 15;
    {
      int oc = 0;
      unsigned loff = (unsigned)(tokw + lane) * 4u;
#pragma unroll 1
      for (int kb = 0; kb < 2; ++kb) { int ev[64];
#pragma unroll
          for (int j = 0; j < 64; ++j) { ev[j] = *(const int*)((const char*)lidx + loff); loff += (unsigned)M * 4u; asm volatile("" : "+v"(loff)); }
#pragma unroll
          for (int j0 = 0; j0 < 64; j0 += 8) { int rk[8]; int oc = 0;
#pragma unroll
              for (int i = 0; i < 8; ++i) { const int e = ev[j0 + i], q = (e >> 4) & 15; rk[i] = 0;
                  if (((e ^ (e >> 7)) & 15) == et) rk[i] = __hip_atomic_fetch_add(&Wcn[sgl * 16 + q], 1, __ATOMIC_RELAXED, __HIP_MEMORY_SCOPE_WORKGROUP); }
#pragma unroll
              for (int i = 0; i < 8; ++i) { const int e = ev[j0 + i], k = kb * 64 + j0 + i, el = e >> 4, q = el & 15; const bool match = ((e ^ (e >> 7)) & 15) == et;
                  if (match && rk[i] < 20) Wa[sgl * 320 + rk[i] * 16 + UCOL(q)] = el | (tl << 10) | (k << 14);
                  const bool ov = match && rk[i] >= 20;
                  const unsigned long long ovm = __builtin_amdgcn_ballot_w64(ov);
                  if (ov) Wo[oc + (int)__builtin_amdgcn_mbcnt_hi((unsigned)(ovm >> 32), __builtin_amdgcn_mbcnt_lo((unsigned)ovm, 0u))] = (lane << 17) | (k << 10) | el;
                  oc += __builtin_popcountll(ovm); }
              if (oc != 0) { LDS_WAIT();
#pragma unroll 1
                  for (int u = 0; u < oc; ++u) { const int ent = __builtin_amdgcn_readfirstlane(Wo[u]); PU_SLOW(ent >> 17, (ent >> 10) & 127, ent & 1023); } } } }
    }
    LDS_WAIT();
    int NGs;
    {
      const int cq = min(Wcn[lane], 20); int N = cq;
#pragma unroll
      for (int o = 1; o < 16; o <<= 1) N += __shfl_xor(N, o, 16);
      NGs = (N > 160) ? 12 : 10;
      const int exc = max(cq - NGs, 0), fre = max(NGs - cq, 0); int ie = exc, ifr = fre;
#pragma unroll
      for (int o = 1; o < 16; o <<= 1) { const int v0 = __shfl_up(ie, o, 16), v1 = __shfl_up(ifr, o, 16); if (tl >= o) { ie += v0; ifr += v1; } }
      const int E = __shfl(ie, 15, 16), F = __shfl(ifr, 15, 16), exoff = ie - exc, froff = ifr - fre, nq = UCOL(tl);
#pragma unroll
      for (int i = 0; i < 10; ++i) if (i < exc) Wt[sgl * 128 + exoff + i] = Wa[sgl * 320 + (NGs + i) * 16 + nq];
      LDS_WAIT();
#pragma unroll
      for (int j = 0; j < 12; ++j) if (j < fre && froff + j < E) Wa[sgl * 320 + (cq + j) * 16 + nq] = Wt[sgl * 128 + froff + j];
      LDS_WAIT();
#pragma unroll
      for (int s4 = 0; s4 < 4; ++s4) { const int Es = __builtin_amdgcn_readlane(E, s4 * 16), Fs = __builtin_amdgcn_readlane(F, s4 * 16);
#pragma unroll 1
          for (int i = Fs; i < Es; ++i) { const int ent = __builtin_amdgcn_readfirstlane(Wt[s4 * 128 + i]); PU_SLOW(s4 * 16 + ((ent >> 10) & 15), (ent >> 14) & 127, ent & 1023); } }
    }
#undef PU_SLOW
    const int n = lane & 15, g = lane >> 4;
    unsigned ci[4][UNG]; int acc[4][UNG]; int NP[4];
    { const int qn = (n >= 4 && n < 12) ? (n - 4) * 2 + 1 : ((n < 4) ? n : n - 8) * 2;
#pragma unroll
      for (int s4 = 0; s4 < 4; ++s4) { NP[s4] = __builtin_amdgcn_readlane(NGs, s4 * 16) >> 1;
#pragma unroll
        for (int m = 0; m < UNG; ++m) { const int raw = Wa[s4 * 320 + m * 16 + n]; const bool valid = raw >= 0;
            const int row = valid ? (raw & 1023) : qn, tl2 = valid ? ((raw >> 10) & 15) : 0, k = valid ? ((raw >> 14) & 127) : 0;
            ci[s4][m] = (unsigned)(row * 128 + ((g ^ ((row >> 1) & 7)) << 4)) | ((unsigned)k << 17) | ((unsigned)(tl2 >> 2) << 24) | ((unsigned)(valid ? 1 : 0) << 26) | ((unsigned)((tl2 >> 1) & 1) << 30) | ((unsigned)(tl2 & 1) << 31);
            acc[s4][m] = 0; } } }
#undef UCOL
    const char* H8c = (const char*)H8; const unsigned aoff = (unsigned)(tokw + n) * (unsigned)D + (unsigned)g * 16u;
    i32x4 a[4][2];
#define PU_ALOAD(s_, ks_) do { _Pragma("unroll") for (int h_ = 0; h_ < 2; ++h_) a[s_][h_] = *(const i32x4*)(H8c + (aoff + (unsigned)((ks_) * 128 + (s_) * 16 * D + h_ * 64))); } while (0)
#define PU_LOAD2(dst, s_, m_) do { const unsigned a0_ = ci[s_][m_] & 0x1ffffu, a1_ = ci[s_][(m_) + 1] & 0x1ffffu; \
        dst[0][0] = *(const LAS i32x4*)(lds + a0_); dst[1][0] = *(const LAS i32x4*)(lds + a1_); dst[0][1] = *(const LAS i32x4*)(lds + (a0_ ^ 64u)); dst[1][1] = *(const LAS i32x4*)(lds + (a1_ ^ 64u)); } while (0)
#define PU_SEL(d_, c_, ac_) do { const int m0_ = (int)(c_) >> 31, m1_ = __builtin_amdgcn_sbfe((int)(c_), 30u, 1u); \
        const int lo_ = (d_[1] & m0_) | (d_[0] & ~m0_), hi_ = (d_[3] & m0_) | (d_[2] & ~m0_); ac_ += (hi_ & m1_) | (lo_ & ~m1_); } while (0)
#define PU_PAIR(src, s_, m_) do { i32x4 d0_ = {0, 0, 0, 0}, d1_ = {0, 0, 0, 0}; \
        d0_ = __builtin_amdgcn_mfma_i32_16x16x64_i8(a[s_][0], src[0][0], d0_, 0, 0, 0); d1_ = __builtin_amdgcn_mfma_i32_16x16x64_i8(a[s_][0], src[1][0], d1_, 0, 0, 0); \
        d0_ = __builtin_amdgcn_mfma_i32_16x16x64_i8(a[s_][1], src[0][1], d0_, 0, 0, 0); d1_ = __builtin_amdgcn_mfma_i32_16x16x64_i8(a[s_][1], src[1][1], d1_, 0, 0, 0); \
        PU_SEL(d0_, ci[s_][m_], acc[s_][m_]); PU_SEL(d1_, ci[s_][(m_) + 1], acc[s_][(m_) + 1]); asm volatile("" : "+v"(acc[s_][m_]), "+v"(acc[s_][(m_) + 1])); } while (0)
#pragma unroll
    for (int s4 = 0; s4 < 4; ++s4) PU_ALOAD(s4, 0);
#pragma unroll 1
    for (int ks = 0; ks < 32; ++ks) {
        __syncthreads();
#pragma unroll
        for (int s4 = 0; s4 < 4; ++s4)
#pragma unroll
            for (int m = 0; m < UNG; ++m) asm volatile("" : "+v"(ci[s4][m]));
        PEER_FILL(U8M, et * 32 + ks);
        if (tg == (ks & 15) && ks + 1 < 32) PEER_WARM(U8M, et * 32 + ks + 1);
        VM_WAIT(); __syncthreads();
        {
          i32x4 bA[2][2], bB[2][2], bC[2][2];
          PU_LOAD2(bA, 0, 0); PU_LOAD2(bB, 0, 2); PU_LOAD2(bC, 0, 4);
#pragma unroll
          for (int blk = 0; blk < 24; ++blk) { const int s4 = blk / 6, p = blk % 6, nb = blk + 3, ns = nb / 6, np = nb % 6;
              if (blk % 3 == 0)      { if (p < 5 || NP[s4] > 5) PU_PAIR(bA, s4, 2 * p); if (nb < 24 && (np < 5 || NP[ns] > 5)) PU_LOAD2(bA, ns, 2 * np); }
              else if (blk % 3 == 1) { if (p < 5 || NP[s4] > 5) PU_PAIR(bB, s4, 2 * p); if (nb < 24 && (np < 5 || NP[ns] > 5)) PU_LOAD2(bB, ns, 2 * np); }
              else                   { if (p < 5 || NP[s4] > 5) PU_PAIR(bC, s4, 2 * p); if (nb < 24 && (np < 5 || NP[ns] > 5)) PU_LOAD2(bC, ns, 2 * np); }
              __builtin_amdgcn_sched_barrier(0);
              if (p == 5) { if (ks + 1 < 32) PU_ALOAD(s4, ks + 1);
                  __builtin_amdgcn_sched_barrier(0); } } }
    }
#undef PU_ALOAD
#undef PU_LOAD2
#undef PU_SEL
#undef PU_PAIR
#pragma unroll
    for (int s4 = 0; s4 < 4; ++s4)
#pragma unroll
        for (int m = 0; m < UNG; ++m) { if ((m >> 1) < NP[s4]) { const unsigned c = ci[s4][m];
            if (((c >> 26) & 1u) != 0u && (int)((c >> 24) & 3u) == g) { const int tok = tokw + s4 * 16 + g * 4 + (int)(c >> 31) + 2 * (int)((c >> 30) & 1u), k = (int)((c >> 17) & 127u);
                S[(size_t)k * M + tok] = (float)acc[s4][m] * sh[tok]; } } }
    __syncthreads();
}
__device__ __forceinline__ void peer_gates(const Ctx& C, int gt, int NGT) {
    const int* lidx = (const int*)(C.ws + WS_LIDX); const float* lg = (const float*)(C.ws + WS_LG); const float* part = (const float*)(C.ws + WS_PART);
    const float* usc = (const float*)(C.ws + WS_ESC); float* at = (float*)(C.ws + WS_AT);
#pragma unroll 4
    for (int idx = gt; idx < 128 * M; idx += NGT) { const int e = lidx[idx]; const float s = part[idx] * usc[e];
        at[idx] = 0.5f * s * (1.0f + erff(s * 0.70710678f)) * lg[idx]; }
}
__device__ __forceinline__ void peer_v_item(const Ctx& C, int tg, int r, LAS unsigned char* lds, int tid, int wave, int lane) {
    const int* lidx = (const int*)(C.ws + WS_LIDX); const float* at = (const float*)(C.ws + WS_AT); const unsigned char* vscr = (const unsigned char*)((const float*)(C.ws + WS_ESC) + (size_t)PNE * 16 + (size_t)r * PNE);
    const unsigned char* V8T = C.ws + WS_E8 + 64 * MiB; bf16* ft = (bf16*)(C.ws + WS_FT);
    const int t = tg * 512 + tid;
    unsigned ei[64], a8[32]; float os;
    { float af[128]; float am = 0.f;
      __syncthreads();
#pragma unroll
      for (int i = 0; i < 8; ++i) { const int c = wave * 8 + i; __builtin_amdgcn_global_load_lds((const unsigned*)(vscr + c * 1024 + lane * 16), (LAS unsigned*)(lds + c * 1024), 16, 0, 0); }
      VM_WAIT(); __syncthreads();
      unsigned loff = (unsigned)t * 4u;
#pragma unroll
      for (int j = 0; j < 64; ++j) { const unsigned e0 = *(const unsigned*)((const char*)lidx + loff), e1 = *(const unsigned*)((const char*)lidx + (loff + (unsigned)M * 4u)); ei[j] = e0 | (e1 << 16);
          af[2 * j] = *(const float*)((const char*)at + loff) * *(const LAS float*)(lds + e0 * 4u); af[2 * j + 1] = *(const float*)((const char*)at + (loff + (unsigned)M * 4u)) * *(const LAS float*)(lds + e1 * 4u);
          loff += 2u * M * 4u; asm volatile("" : "+v"(loff));
          if ((j & 7) == 7) __builtin_amdgcn_sched_barrier(0); }
#pragma unroll
      for (int k = 0; k < 128; ++k) am = fmaxf(am, fabsf(af[k]));
      const float q = am > 0.f ? 127.0f / am : 0.f; os = am * (1.0f / 127.0f);
#pragma unroll
      for (int j = 0; j < 32; ++j) a8[j] = (unsigned)((int)rintf(af[4 * j] * q) & 255) | ((unsigned)((int)rintf(af[4 * j + 1] * q) & 255) << 8) | ((unsigned)((int)rintf(af[4 * j + 2] * q) & 255) << 16) | ((unsigned)((int)rintf(af[4 * j + 3] * q) & 255) << 24); }
#pragma unroll 1
    for (int s = 0; s < 32; ++s) { const int slice = r * 32 + s;
        LDS_BARRIER();
#pragma unroll
        for (int j = 0; j < 64; ++j) asm volatile("" : "+v"(ei[j]));
        PEER_FILL(V8T, slice);
        if (tg == (s & 15) && s + 1 < 32) PEER_WARM(V8T, slice + 1);
        VM_WAIT(); LDS_BARRIER();
        int o[8];
#pragma unroll
        for (int i = 0; i < 8; ++i) o[i] = 0;
#define PV_LOAD(dst, k0) do { _Pragma("unroll") for (int j_ = 0; j_ < 8; ++j_) { const int k_ = (k0) + j_; const unsigned e_ = (k_ & 1) ? (ei[k_ >> 1] >> 16) : (ei[k_ >> 1] & 0xffffu); dst[j_] = *(const LAS u32x2*)(lds + e_ * 8); } } while (0)
#define PV_Q(w0, w1, w2, w3, ab, ob) do { const unsigned t0_ = __builtin_amdgcn_perm(w1, w0, 0x05010400u), t1_ = __builtin_amdgcn_perm(w1, w0, 0x07030602u), u0_ = __builtin_amdgcn_perm(w3, w2, 0x05010400u), u1_ = __builtin_amdgcn_perm(w3, w2, 0x07030602u); \
            o[ob] = __builtin_amdgcn_sdot4((int)__builtin_amdgcn_perm(u0_, t0_, 0x05040100u), ab, o[ob], false); o[ob + 1] = __builtin_amdgcn_sdot4((int)__builtin_amdgcn_perm(u0_, t0_, 0x07060302u), ab, o[ob + 1], false); \
            o[ob + 2] = __builtin_amdgcn_sdot4((int)__builtin_amdgcn_perm(u1_, t1_, 0x05040100u), ab, o[ob + 2], false); o[ob + 3] = __builtin_amdgcn_sdot4((int)__builtin_amdgcn_perm(u1_, t1_, 0x07060302u), ab, o[ob + 3], false); } while (0)
#define PV_DOT(src, k0) do { const int a0_ = (int)a8[(k0) >> 2], a1_ = (int)a8[((k0) >> 2) + 1]; \
            PV_Q(src[0].x, src[1].x, src[2].x, src[3].x, a0_, 0); PV_Q(src[0].y, src[1].y, src[2].y, src[3].y, a0_, 4); \
            PV_Q(src[4].x, src[5].x, src[6].x, src[7].x, a1_, 0); PV_Q(src[4].y, src[5].y, src[6].y, src[7].y, a1_, 4); } while (0)
        u32x2 wa[8], wb[8];
        PV_LOAD(wa, 0);
#pragma unroll
        for (int k16 = 0; k16 < 128; k16 += 16) {
            PV_LOAD(wb, k16 + 8); PV_DOT(wa, k16); __builtin_amdgcn_sched_barrier(0);
            if (k16 + 16 < 128) PV_LOAD(wa, k16 + 16);
            PV_DOT(wb, k16 + 8); __builtin_amdgcn_sched_barrier(0); }
#undef PV_LOAD
#undef PV_Q
#undef PV_DOT
        u32x4 ow; ow.x = pk2((float)o[0] * os, (float)o[1] * os); ow.y = pk2((float)o[2] * os, (float)o[3] * os); ow.z = pk2((float)o[4] * os, (float)o[5] * os); ow.w = pk2((float)o[6] * os, (float)o[7] * os);
        *(u32x4*)(ft + ((size_t)slice * M + t) * 8) = ow;
    }
    __syncthreads();
}
constexpr int FROWB = D * 2 + 16;
constexpr int FVEC = 8 * FROWB;
__device__ __forceinline__ void final_units(const Ctx& C, int u0, int ustep, LAS unsigned char* lds, int tid, int wave, int lane) {
#define FU_LBAR() do { asm volatile("s_waitcnt lgkmcnt(0)" ::: "memory"); __builtin_amdgcn_s_barrier(); asm volatile("" ::: "memory"); } while (0)
    const bf16* ft = (const bf16*)(C.ws + WS_FT); const bf16* MIX = (const bf16*)(C.ws + WS_Y);
    const float* mod = (const float*)(C.ws + WS_MOD); const float* modf = mod + 2 * 6 * D;
    u32x4 pf[8]; int bcur = -1;
#define FU_GATHER(unit_) do { int tidv_ = tid; asm volatile("" : "+v"(tidv_));   \
        _Pragma("unroll") for (int i = 0; i < 8; ++i) { const int p = i * 512 + tidv_, slice = p >> 3, q = p & 7;                      \
            pf[i] = *(const u32x4*)(ft + ((size_t)slice * M + (unit_) * 8 + q) * 8); } } while (0)
    __syncthreads();
    if (u0 < M / 8) FU_GATHER(u0);
    for (int unit = u0; unit < M / 8; unit += ustep) { const int t0 = unit * 8, b = t0 >> 12;
        if (b != bcur) { bcur = b;
            const float* v0 = mod + (size_t)b * 6 * D + 5 * D; const float* v1 = C.g_f; const float* v2 = modf + (size_t)b * 2 * D; const float* v3 = modf + (size_t)b * 2 * D + D;
#pragma unroll
            for (int i = 0; i < 2; ++i) { const int c4 = tid + 512 * i;
                *(LAS f32x4*)(lds + FVEC + c4 * 16) = ((const f32x4*)v0)[c4]; *(LAS f32x4*)(lds + FVEC + 16384 + c4 * 16) = ((const f32x4*)v1)[c4];
                *(LAS f32x4*)(lds + FVEC + 32768 + c4 * 16) = ((const f32x4*)v2)[c4]; *(LAS f32x4*)(lds + FVEC + 49152 + c4 * 16) = ((const f32x4*)v3)[c4]; } }
        { int tidv = tid; asm volatile("" : "+v"(tidv));
#pragma unroll
          for (int i = 0; i < 8; ++i) { const int p = i * 512 + tidv, slice = p >> 3, q = p & 7; *(LAS u32x4*)(lds + q * FROWB + slice * 16) = pf[i]; } }
        const int m = t0 + wave; f32x4 f[16]; u32x2 aw[16]; float ss = 0.f; int lanev = lane; asm volatile("" : "+v"(lanev));
        const char* mp = (const char*)(MIX + (size_t)m * D); char* op = (char*)(C.out + (size_t)m * D);
#pragma unroll
        for (int j = 0; j < 16; ++j) { const unsigned cb = (unsigned)(64 * j + lanev) * 8u; aw[j] = *(const u32x2*)(mp + cb); }
        FU_LBAR();
        if (unit + ustep < M / 8) FU_GATHER(unit + ustep);
        asm volatile("" : "+v"(lanev));
#pragma unroll
        for (int j = 0; j < 16; ++j) { const unsigned cb = (unsigned)(64 * j + lanev) * 16u;
            const f32x4 gtv = *(const LAS f32x4*)(lds + FVEC + cb); const u32x2 fw = *(const LAS u32x2*)(lds + wave * FROWB + (cb >> 1));
            const f32x4 fv = {bf2f(fw.x & 0xffffu), bf2f(fw.x >> 16), bf2f(fw.y & 0xffffu), bf2f(fw.y >> 16)};
            f[j] = (f32x4){bf2f(aw[j].x & 0xffffu), bf2f(aw[j].x >> 16), bf2f(aw[j].y & 0xffffu), bf2f(aw[j].y >> 16)} + gtv * fv;
            ss += (f[j][0] * f[j][0] + f[j][1] * f[j][1]) + (f[j][2] * f[j][2] + f[j][3] * f[j][3]); if ((j & 3) == 3) __builtin_amdgcn_sched_barrier(0); }
        const float rs = rsqrtf(wave_sum(ss) * (1.0f / D) + EPS);
#pragma unroll
        for (int j = 0; j < 16; ++j) { const unsigned cb = (unsigned)(64 * j + lanev) * 16u;
            const f32x4 gg = *(const LAS f32x4*)(lds + FVEC + 16384 + cb), sh = *(const LAS f32x4*)(lds + FVEC + 32768 + cb), sc = *(const LAS f32x4*)(lds + FVEC + 49152 + cb);
            *(f32x4*)(op + cb) = f[j] * rs * gg * (sc + 1.0f) + sh; if ((j & 3) == 3) __builtin_amdgcn_sched_barrier(0); }
        FU_LBAR();
    }
    __syncthreads();
#undef FU_GATHER
#undef FU_LBAR
}

constexpr int NPHASE = 14;
struct Args { const void* in[25]; float* out; unsigned char* ws; int ph_lo, ph_hi; };
__global__ void __launch_bounds__(NTHR, 2) fwd(Args args) {
    extern __shared__ __attribute__((aligned(16))) unsigned char lds_raw[];
    LAS unsigned char* lds = (LAS unsigned char*)lds_raw;
    int tid = threadIdx.x, lane = tid & 63; const int wave = __builtin_amdgcn_readfirstlane(tid >> 6);
#define REFRESH_IDS() do { lane = (int)__builtin_amdgcn_mbcnt_hi(~0u, __builtin_amdgcn_mbcnt_lo(~0u, 0u)); tid = wave * 64 + lane; } while (0)
    const int G = gridDim.x, bx = blockIdx.x, vcu = (G % 8 == 0) ? (bx % 8) * (G / 8) + bx / 8 : bx;
    const int gw = vcu * NWAVES + wave, NGW = G * NWAVES;
    Ctx C;
    C.x = (const float*)args.in[0]; C.c = (const float*)args.in[1]; C.pos = (const int*)args.in[2]; C.w_ada = (const float*)args.in[3]; C.b_ada = (const float*)args.in[4];
    C.g_mix = (const float*)args.in[5]; C.w_in = (const float*)args.in[6]; C.g_q = (const float*)args.in[7]; C.w_uq = (const float*)args.in[8]; C.g_kv = (const float*)args.in[9];
    C.w_ukv = (const float*)args.in[10]; C.g_sgu = (const float*)args.in[11]; C.w_sgu = (const float*)args.in[12]; C.b_sgu = (const float*)args.in[13]; C.beta_mla = (const float*)args.in[14];
    C.beta_g = (const float*)args.in[15]; C.w_out = (const float*)args.in[16]; C.g_ffn = (const float*)args.in[17]; C.w_pq = (const float*)args.in[18]; C.pkeys = (const float*)args.in[19];
    C.eu = (const float*)args.in[20]; C.ev = (const float*)args.in[21]; C.w_adaf = (const float*)args.in[22]; C.b_adaf = (const float*)args.in[23]; C.g_f = (const float*)args.in[24];
    C.out = args.out; C.ws = args.ws;
    unsigned* ctl = (unsigned*)(C.ws + WS_CTL);
    float* mod = (float*)(C.ws + WS_MOD);
    for (int u = tid; u < (LDS_BYTES - LDSCTL_OFF) / 4; u += NTHR) ((LAS unsigned*)(lds + LDSCTL_OFF))[u] = 0u;
    __syncthreads();
    const int lo = args.ph_lo, hi = args.ph_hi;
    XcdBarrier bar; bar.bar = ctl + CW_BAR; bar.x = 0; bar.st = (volatile LAS unsigned*)(lds + LDSCTL_OFF + 64);
    if (hi - lo > 1) bar = xcd_barrier_post(ctl + CW_BAR, (volatile LAS unsigned*)(lds + LDSCTL_OFF + 64));
#define IN(k) (lo <= (k) && (k) < hi)
#define SEAM(k) do { if (IN(k) && IN((k) + 1)) xcd_barrier(bar); } while (0)

    if (IN(0)) { REFRESH_IDS();
        for (int u = vcu; u < 256; u += G) ada_unit(C, u, (LAS float*)lds, tid, wave, lane);
        LAS float* scr = (LAS float*)(lds + wave * 16384);
        constexpr int I1 = (D / 64) * (INWP / 32), I2 = (QLR / 64) * (NH * QKD / 32), I3 = (KVLR / 64) * (NH * 256 / 32), I4 = (D / 64) * (D / 32), I5 = (D / 64) * (PQW / 32);
        constexpr float QSCALE = 1.4426950408889634f * 0.07216878364870322f;
        for (int it = gw; it < I1 + I2 + I3 + I4 + I5; it += NGW) {
            int q = it;
            if (q < I1) { transpose_item<MAP_W1>(C.w_in, D, INW, INWP, (bf16*)(C.ws + WS_W1T), nullptr, 1.0f, scr, q, lane); continue; } q -= I1;
            if (q < I2) { transpose_item<MAP_UQ>(C.w_uq, QLR, NH * QKD, NH * QKD, (bf16*)(C.ws + WS_WUQT), C.g_q, QSCALE, scr, q, lane); continue; } q -= I2;
            if (q < I3) { transpose_item<MAP_ID>(C.w_ukv, KVLR, NH * 256, NH * 256, (bf16*)(C.ws + WS_WUKVT), C.g_kv, 1.0f, scr, q, lane); continue; } q -= I3;
            if (q < I4) { const int kb = q / (D / 32); const float* ks = (kb < 32) ? C.beta_mla : C.beta_g - GW;
                          transpose_item<MAP_ID>(C.w_out, D, D, D, (bf16*)(C.ws + WS_WOUTT), ks, 1.0f, scr, q, lane); continue; } q -= I4;
            transpose_item<MAP_ID>(C.w_pq, D, PQW, PQW, (bf16*)(C.ws + WS_WPQT), nullptr, 1.0f, scr, q, lane);
        }
        const int gt = vcu * NTHR + tid, NGT = G * NTHR;
        { bf16* kd = (bf16*)(C.ws + WS_KEYS); for (int i = gt; i < PH * 2 * PNK * PHALF; i += NGT) kd[i] = (bf16)f2bf(C.pkeys[i]); }
        { bf16* wd = (bf16*)(C.ws + WS_WSGU); for (int i = gt; i < GH * GC * GC; i += NGT) { const int s = i & 127, t = (i >> 7) & 127; wd[i] = (bf16)(s <= t ? f2bf(C.w_sgu[i]) : 0u); } }
        { float* rp = (float*)(C.ws + WS_ROPE); for (int i = gt; i < M * 32; i += NGT) { const int j = i & 31, tok = i >> 5;
            const float invf = (float)exp(-(double)(2 * j) / 64.0 * 9.210340371976184); const float ang = (float)C.pos[tok] * invf;
            rp[2 * i] = (float)cos((double)ang); rp[2 * i + 1] = (float)sin((double)ang); } }
        __syncthreads();
        for (int e = gw; e < PNE; e += NGW) expert_convert_u(C, e, lane);
        for (int u = vcu; u < 4096; u += G) expert_convert_unit(C, 4096 + u, lds, tid);
    }
    SEAM(0);
    if (IN(1)) { REFRESH_IDS(); norm_mod_rows<false>(C.x, nullptr, C.g_mix, mod, mod + D, (bf16*)(C.ws + WS_H), nullptr, nullptr, nullptr, gw, NGW, lane); }
    SEAM(1);
    if (IN(2)) { REFRESH_IDS();
        pg8::Gemm g{(const bf16*)(C.ws + WS_H), (const bf16*)(C.ws + WS_W1T), M, INWP, D, D, D}; pg8::StaticOrder S; S.init(M, INWP, G, bx);
        EpiZ E{(bf16*)(C.ws + WS_QLAT), (bf16*)(C.ws + WS_KVLAT), (bf16*)(C.ws + WS_KPE), (bf16*)(C.ws + WS_U), (bf16*)(C.ws + WS_VT),
               (float*)(C.ws + WS_STQ), (float*)(C.ws + WS_STKV), (float*)(C.ws + WS_STVS), (float*)(C.ws + WS_STVQ), (const float*)(C.ws + WS_ROPE)};
        pg8::gemm_phase<EpiZ>(lds, g, S, E);
    }
    SEAM(2);
    if (IN(3)) { REFRESH_IDS();
        { pg8::Gemm g{(const bf16*)(C.ws + WS_QLAT), (const bf16*)(C.ws + WS_WUQT), M, NH * QKD, QLR, QLR, QLR}; pg8::StaticOrder S; S.init(M, NH * QKD, G, bx);
          EpiQ E{(bf16*)(C.ws + WS_Q), (const float*)(C.ws + WS_STQ), (const float*)(C.ws + WS_ROPE)};
          pg8::gemm_phase<EpiQ>(lds, g, S, E); }
        { pg8::Gemm g{(const bf16*)(C.ws + WS_KVLAT), (const bf16*)(C.ws + WS_WUKVT), M, NH * 256, KVLR, KVLR, KVLR}; pg8::StaticOrder S; S.init(M, NH * 256, G, bx);
          EpiKV E{(bf16*)(C.ws + WS_KN), (bf16*)(C.ws + WS_VTA), (const float*)(C.ws + WS_STKV)};
          pg8::gemm_phase<EpiKV>(lds, g, S, E); }
        { const int heavy = (G == 256 && bx < 128), lite = (G == 256 && bx >= 128);
          int u = heavy ? bx * 3 : (lite ? 384 + (bx - 128) * 5 : vcu); const int ustep = (G == 256) ? 1 : G, uend = heavy ? bx * 3 + 3 : (lite ? 384 + (bx - 128) * 5 + 5 : NB * 32 * GH);
          sgu_units(C, u, uend, ustep, lds, tid, wave, lane); }
    }
    SEAM(3);
    if (IN(4)) { REFRESH_IDS();
        if (wave >= 4) __builtin_amdgcn_s_setprio(1);
        for (int it = vcu; it < 256; it += G) { const int bh = it >> 3, x = it & 7;
            attn_block(C, bh >> 4, bh & 15, 15 - x, lds, tid, wave, lane);
            attn_block(C, bh >> 4, bh & 15, x, lds, tid, wave, lane); }
        __builtin_amdgcn_s_setprio(0);
    }
    SEAM(4);
    if (IN(6)) { REFRESH_IDS();
        pg8::Gemm g{(const bf16*)(C.ws + WS_Y), (const bf16*)(C.ws + WS_WOUTT), M, D, D, D, D}; pg8::StaticOrder S; S.init(M, D, G, bx);
        LAS f32x2* rsl = (LAS f32x2*)(lds + RING_BYTES);
        pg8::Unit u0, u1; const bool h0 = S.next(0, u0), h1 = S.next(1, u1);
        { const int slot = tid >> 8, pm = slot ? (h1 ? u1.pm : u0.pm) : u0.pm, row = pm * 256 + (tid & 255);
          if (h0) { const float* stm = (const float*)(C.ws + WS_STM); const float* stg = (const float*)(C.ws + WS_STG);
              const float sm = sum_parts(stm + (size_t)row * 16, 4) * (1.0f / GW) + EPS, sg = sum_parts(stg + (size_t)row * 16, 4) * (1.0f / GW) + EPS;
              rsl[slot * 256 + (tid & 255)] = (f32x2){rsqrtf(sm) * sqrtf(sg), rsqrtf(sg)}; } }
        __syncthreads();
        EpiX1 E{mod, (bf16*)(C.ws + WS_X1), rsl, u0.pm};
        pg8::gemm_phase<EpiX1>(lds, g, S, E);
    }
    SEAM(6);
    if (IN(7)) { REFRESH_IDS(); norm_mod_rows<true>(C.x, (const bf16*)(C.ws + WS_X1), C.g_ffn, mod + 3 * D, mod + 4 * D, (bf16*)(C.ws + WS_H), (signed char*)(C.ws + WS_H8), (float*)(C.ws + WS_SH), (bf16*)(C.ws + WS_Y), gw, NGW, lane); }
    SEAM(7);
    if (IN(8)) { REFRESH_IDS();
        pg8::Gemm g{(const bf16*)(C.ws + WS_H), (const bf16*)(C.ws + WS_WPQT), M, PQW, D, D, D}; pg8::StaticOrder S; S.init(M, PQW, G, bx);
        EpiQP E{(bf16*)(C.ws + WS_QP)};
        pg8::gemm_phase<EpiQP>(lds, g, S, E);
    }
    SEAM(8);
    if (IN(9)) { REFRESH_IDS(); for (int tb = vcu; tb < M / 32; tb += G) {
            topk_item(C, tb * 8 + wave, (LAS float*)(lds + wave * 12288), (LAS int*)(lds + 98304), (LAS float*)(lds + 98304 + 16384), lane);
            __syncthreads(); { int tidv = tid; asm volatile("" : "+v"(tidv)); order_pairs(C, tb, lds, tidv); } __syncthreads(); } }
    SEAM(9);
    if (IN(10)) { REFRESH_IDS(); for (int it = vcu; it < 256; it += G) peer_u_item(C, it & 15, it >> 4, lds, tid, wave, lane); }
    SEAM(10);
    if (IN(11)) { REFRESH_IDS(); peer_gates(C, vcu * NTHR + tid, G * NTHR); }
    SEAM(11);
    if (IN(12)) { REFRESH_IDS(); for (int it = vcu; it < 256; it += G) peer_v_item(C, it & 15, it >> 4, lds, tid, wave, lane); }
    SEAM(12);
    if (IN(13)) { REFRESH_IDS(); final_units(C, vcu, G, lds, tid, wave, lane); }
#undef IN
#undef SEAM
#undef REFRESH_IDS
}

extern "C" void kernel_launch(void* const* d_in, const int* in_sizes, int n_in, void* d_out, int out_size, void* d_ws, size_t ws_size, hipStream_t stream) {
    static int grid = 0;
    if (grid == 0) {
        if (n_in != 25 || out_size != M * D || ws_size < WS_END) { fprintf(stderr, "kernel_launch: unexpected problem (n_in %d, out %d, ws %zu)\n", n_in, out_size, ws_size); grid = -1; return; }
        int dev = 0, cus = 0, per_cu = 0;
        if (hipGetDevice(&dev) != hipSuccess || hipDeviceGetAttribute(&cus, hipDeviceAttributeMultiprocessorCount, dev) != hipSuccess) { grid = -1; return; }
        if (hipFuncSetAttribute((const void*)fwd, hipFuncAttributeMaxDynamicSharedMemorySize, LDS_BYTES) != hipSuccess) { fprintf(stderr, "kernel_launch: hipFuncSetAttribute failed\n"); grid = -1; return; }
        if (hipOccupancyMaxActiveBlocksPerMultiprocessor(&per_cu, (const void*)fwd, NTHR, LDS_BYTES) != hipSuccess || per_cu < 1) { fprintf(stderr, "kernel_launch: occupancy query says %d blocks per CU\n", per_cu); }
        (void)hipGetLastError();
        grid = cus;
    }
    if (grid < 0) return;
    if (hipMemsetAsync((char*)d_ws + WS_CTL, 0, CTL_ZERO_BYTES, stream) != hipSuccess) return;
    Args a{};
    for (int i = 0; i < 25; ++i) a.in[i] = d_in[i];
    a.out = (float*)d_out; a.ws = (unsigned char*)d_ws;
#if MK_ONE_LAUNCH
    a.ph_lo = 0; a.ph_hi = NPHASE;
    hipLaunchKernelGGL(fwd, dim3(grid), dim3(NTHR), LDS_BYTES, stream, a);
#else
    for (int p = 0; p < NPHASE; ++p) { a.ph_lo = p; a.ph_hi = p + 1; hipLaunchKernelGGL(fwd, dim3(grid), dim3(NTHR), LDS_BYTES, stream, a); }
#endif
    const hipError_t le = hipPeekAtLastError();
    if (le != hipSuccess) fprintf(stderr, "kernel_launch: launch failed: %s\n", hipGetErrorName(le));
}
```

```cpp
#include <hip/hip_runtime.h>
#include <cstdio>
#include <cstdint>

#ifndef MK_ONE_LAUNCH
#define MK_ONE_LAUNCH 1
#endif

#define LAS __attribute__((address_space(3)))
#define GAS __attribute__((address_space(1)))
typedef unsigned short bf16;
typedef short bf16x8 __attribute__((ext_vector_type(8)));
typedef float f32x4 __attribute__((ext_vector_type(4)));
typedef float f32x2 __attribute__((ext_vector_type(2)));
typedef float f32x16 __attribute__((ext_vector_type(16)));
typedef unsigned u32x4 __attribute__((ext_vector_type(4)));
typedef unsigned u32x2 __attribute__((ext_vector_type(2)));

constexpr int D = 4096, SEQ = 4096, NB = 2, M = NB * SEQ;
constexpr int QLR = 1024, KVLR = 512, ROPE = 64, NOPE = 128, QKD = 192, VD = 128, NH = 16;
constexpr int GW = 2048, GH = 16, GC = 128;
constexpr int INW = QLR + KVLR + ROPE + 2 * GW;
constexpr int INWP = 5888;
constexpr int PH = 8, PNK = 128, PQD = 256, PHALF = 128, PK = 16, PNE = PNK * PNK;
constexpr int PQW = PH * PQD;
constexpr float EPS = 1e-6f;
constexpr int NWAVES = 8, NTHR = 512;

constexpr size_t MiB = 1u << 20;
constexpr size_t WS_CTL = 0, CTL_ZERO_BYTES = 1 * MiB;
constexpr size_t WS_MOD = 1 * MiB;
constexpr size_t WS_ROPE = 2 * MiB;
constexpr size_t WS_KEYS = 4 * MiB;
constexpr size_t WS_WSGU = 5 * MiB;
constexpr size_t WS_STQ = 6 * MiB;
constexpr size_t WS_STKV = 7 * MiB;
constexpr size_t WS_STVS = 8 * MiB;
constexpr size_t WS_STVQ = 9 * MiB;
constexpr size_t WS_STM = 10 * MiB;
constexpr size_t WS_STG = 11 * MiB;
constexpr size_t WS_LIDX = 13 * MiB;
constexpr size_t WS_LG = 17 * MiB;
constexpr size_t WS_NA = 21 * MiB;
constexpr size_t WS_W1T = 32 * MiB;
constexpr size_t WS_WUQT = 80 * MiB;
constexpr size_t WS_WUKVT = 88 * MiB;
constexpr size_t WS_WOUTT = 96 * MiB;
constexpr size_t WS_WPQT = 128 * MiB;
constexpr size_t WS_H = 160 * MiB;
constexpr size_t WS_QLAT = 224 * MiB;
constexpr size_t WS_KVLAT = 240 * MiB;
constexpr size_t WS_KPE = 248 * MiB;
constexpr size_t WS_U = 256 * MiB;
constexpr size_t WS_VT = 288 * MiB;
constexpr size_t WS_Q = 320 * MiB;
constexpr size_t WS_KN = 368 * MiB;
constexpr size_t WS_VTA = 400 * MiB;
constexpr size_t WS_Y = 432 * MiB;
constexpr size_t WS_X1 = 496 * MiB;
constexpr size_t WS_QP = 624 * MiB;
constexpr size_t WS_E8 = 704 * MiB;
constexpr size_t WS_ESC = 832 * MiB;
constexpr size_t WS_PART = 840 * MiB;
constexpr size_t WS_ATR = 844 * MiB;
constexpr size_t WS_AT = 904 * MiB;
constexpr size_t WS_FT = 912 * MiB;
constexpr size_t WS_H8 = 1040 * MiB;
constexpr size_t WS_SH = 1072 * MiB;
constexpr size_t WS_END = 1073 * MiB;
constexpr int CW_BAR = 4096;

constexpr int RING_BYTES = 131072;
constexpr int LDS_BYTES = 147456;
constexpr int LDSCTL_OFF = LDS_BYTES - 1024;

#define RLX_AGENT __ATOMIC_RELAXED, __HIP_MEMORY_SCOPE_AGENT
#define LDS_WAIT() asm volatile("s_waitcnt lgkmcnt(0)" ::: "memory")
#define VM_WAIT() asm volatile("s_waitcnt vmcnt(0)" ::: "memory")

__device__ __forceinline__ unsigned f2bf(float f) { unsigned u = __builtin_bit_cast(unsigned, f); return (u + 0x7fffu + ((u >> 16) & 1u)) >> 16; }
__device__ __forceinline__ unsigned pk2(float lo, float hi) { unsigned r; asm("v_cvt_pk_bf16_f32 %0, %1, %2" : "=v"(r) : "v"(lo), "v"(hi)); return r; }
__device__ __forceinline__ float bf2f(unsigned b) { return __builtin_bit_cast(float, b << 16); }
__device__ __forceinline__ float wave_sum(float v) {
    v += __builtin_bit_cast(float, __builtin_amdgcn_update_dpp(0, __builtin_bit_cast(int, v), 0xB1, 0xF, 0xF, true));
    v += __builtin_bit_cast(float, __builtin_amdgcn_update_dpp(0, __builtin_bit_cast(int, v), 0x4E, 0xF, 0xF, true));
    v += __builtin_bit_cast(float, __builtin_amdgcn_update_dpp(0, __builtin_bit_cast(int, v), 0x141, 0xF, 0xF, true));
    v += __builtin_bit_cast(float, __builtin_amdgcn_update_dpp(0, __builtin_bit_cast(int, v), 0x140, 0xF, 0xF, true));
    v += __builtin_bit_cast(float, __builtin_amdgcn_update_dpp(0, __builtin_bit_cast(int, v), 0x142, 0xA, 0xF, true));
    v += __builtin_bit_cast(float, __builtin_amdgcn_update_dpp(0, __builtin_bit_cast(int, v), 0x143, 0xC, 0xF, true));
    return __builtin_bit_cast(float, __builtin_amdgcn_readlane(__builtin_bit_cast(int, v), 63));
}
__device__ __forceinline__ float gelu_f(float v) {
    const float av = fabsf(v), t = __builtin_amdgcn_rcpf(av * 0.2316418882f + 1.0f);
    float q = t * 0.5307027145f + (-0.7265760135f); q = q * t + 0.7107068705f; q = q * t + (-0.142248368f); q = q * t + 0.127414796f; q = q * t;
    const float e = __builtin_amdgcn_exp2f((v * v) * (-0.72134752044f));
    const float m = v * (q * e);
    return v < 0.f ? m : v - m;
}

#define XB_TMO      128
#define XB_XCNT(j)  (256  + 64 * (j))
#define XB_XSUB(j)  (1280 + 64 * (j))
#define XB_XGEN(j)  (2304 + 64 * (j))
#define XB_TOP      3328
#define XB_TOPGEN   3392
#define XCD_BAR_WORDS 3456
#define XB_SPIN_CAP (1u << 20)

__device__ __forceinline__ unsigned xb_ld(unsigned* p)              { return __hip_atomic_load(p, __ATOMIC_RELAXED, __HIP_MEMORY_SCOPE_AGENT); }
__device__ __forceinline__ unsigned xb_add(unsigned* p, unsigned v) { return __hip_atomic_fetch_add(p, v, __ATOMIC_RELAXED, __HIP_MEMORY_SCOPE_AGENT); }
__device__ __forceinline__ unsigned xb_xcc_id() { return (unsigned)__builtin_amdgcn_s_getreg((3 << 11) | 20) & 0xFu; }
#define XB_SPIN(cond, bar) do { unsigned _sp = 0; while (cond) { __builtin_amdgcn_s_sleep(1); \
    if ((++_sp & 255u) == 0u) { if (xb_ld(&(bar)[XB_TMO])) break; if (_sp > XB_SPIN_CAP) { atomicAdd(&(bar)[XB_TMO], 1u); break; } } } } while (0)

struct XcdBarrier { unsigned* bar; unsigned x; volatile LAS unsigned* st; };

__device__ __forceinline__ XcdBarrier xcd_barrier_post(unsigned* bar, volatile LAS unsigned* st) {
    XcdBarrier b; b.bar = bar; b.x = xb_xcc_id(); b.st = st;
    if (threadIdx.x == 0) (void)xb_add(&bar[XB_XCNT(b.x)], 1u);
    return b;
}
__device__ __forceinline__ void xcd_barrier_complete(unsigned* bar, unsigned x, unsigned& nloc, unsigned& nx) {
    const unsigned G = gridDim.x * gridDim.y * gridDim.z;
    unsigned sum, cnt, mine, sp = 0u;
    for (;;) {
        sum = 0u; cnt = 0u; mine = 0u;
#pragma unroll
        for (unsigned j = 0; j < 16; ++j) { const unsigned c = xb_ld(&bar[XB_XCNT(j)]); sum += c; cnt += (c > 0u) ? 1u : 0u; mine = (j == x) ? c : mine; }
        if (sum == G) break;
        __builtin_amdgcn_s_sleep(1);
        if ((++sp & 255u) == 0u) { if (xb_ld(&bar[XB_TMO])) break; if (sp > XB_SPIN_CAP) { atomicAdd(&bar[XB_TMO], 1u); break; } }
    }
    nloc = mine > 0u ? mine : 1u; nx = cnt > 0u ? cnt : 1u;
}
__device__ __forceinline__ void xcd_barrier(const XcdBarrier& b) {
    asm volatile("s_waitcnt vmcnt(0)" ::: "memory");
    __syncthreads();
    if (threadIdx.x == 0) {
        unsigned* bar = b.bar;
        __builtin_amdgcn_s_waitcnt(0);
        unsigned nloc = b.st[0], nx = b.st[1];
        if (nloc == 0u) { xcd_barrier_complete(bar, b.x, nloc, nx); b.st[0] = nloc; b.st[1] = nx; }
        const unsigned old = xb_add(&bar[XB_XSUB(b.x)], 1u);
        const unsigned gen = old / nloc;
        if (old + 1u == (gen + 1u) * nloc) {
            __builtin_amdgcn_fence(__ATOMIC_RELEASE, "agent");
            asm volatile("s_waitcnt vmcnt(0)" ::: "memory");
            const unsigned og = xb_add(&bar[XB_TOP], 1u);
            const unsigned tg = og / nx;
            if (og + 1u == (tg + 1u) * nx) xb_add(&bar[XB_TOPGEN], 1u);
            else XB_SPIN(xb_ld(&bar[XB_TOPGEN]) == tg, bar);
            __builtin_amdgcn_fence(__ATOMIC_ACQUIRE, "agent");
            xb_add(&bar[XB_XGEN(b.x)], 1u);
            asm volatile("s_waitcnt vmcnt(0)" ::: "memory");
        } else {
            XB_SPIN(xb_ld(&bar[XB_XGEN(b.x)]) == gen, bar);
            __builtin_amdgcn_fence(__ATOMIC_ACQUIRE, "agent");
            asm volatile("s_waitcnt vmcnt(0)" ::: "memory");
        }
    }
    __syncthreads();
}

namespace pg8 {
constexpr int BM = 256, BK = 64, HALF = 128, HTB = HALF * BK * 2, STAGE_BYTES = 8 * HTB, NXCD = 8, WGM = 8;
__host__ __device__ __forceinline__ int lds_byte(int r, int c) { const int st = (r >> 4) * 2 + (c >> 5), rr = r & 15, cc = c & 31, ob = rr * 64 + cc * 2; return st * 1024 + (ob ^ (((ob >> 9) & 1) << 5)); }
__host__ __device__ __forceinline__ void stage_rc(int b, int& R, int& C) { const int st = b / 1024, sb = b % 1024, swz = sb ^ (((sb >> 9) & 1) << 5); R = (st >> 1) * 16 + swz / 64; C = (st & 1) * 32 + (swz % 64) / 2; }
struct Unit { int pm, pn; };
struct Gemm { const bf16* A; const bf16* Bt; int M, N, K, lda, ldb; };
struct StaticOrder {
    int nM, nN, nwg, G, c;
    __device__ __forceinline__ void init(int M_, int N_, int G_, int c_) { nM = M_ / BM; nN = N_ / BM; nwg = nM * nN; G = G_; c = c_; }
    __device__ __forceinline__ bool next(int i, Unit& u) const {
        const long L = (long)i * G + c; if (L >= nwg) return false;
        int wgid = (int)L; { const int q = nwg / NXCD, r = nwg % NXCD, xcd = wgid % NXCD, off = wgid / NXCD; wgid = (xcd < r ? xcd * (q + 1) : r * (q + 1) + (xcd - r) * q) + off; }
        const int nig = WGM * nN, gid = wgid / nig, fm = gid * WGM, gsz = (nM - fm) < WGM ? (nM - fm) : WGM;
        u.pm = fm + ((wgid % nig) % gsz); u.pn = (wgid % nig) / gsz; return true;
    }
};
template <class Epi>
__device__ __forceinline__ void gemm_phase(LAS unsigned char* lds, const Gemm g, const StaticOrder& S, const Epi& E) {
    const int tid = threadIdx.x, wid = __builtin_amdgcn_readfirstlane(tid >> 6), lane = tid & 63, wr = wid >> 2, wc = wid & 3, fr = lane & 15, fq = lane >> 4;
    const int K = g.K, nt = K / BK;
    unsigned voffA[2], voffB[2];
#pragma unroll
    for (int i = 0; i < 2; ++i) { int R, C; stage_rc(tid * 16 + i * 8192, R, C);
        voffA[i] = (unsigned)(R * g.lda + C) * 2u; voffB[i] = (unsigned)(R * g.ldb + C) * 2u; }
    const size_t kstep = (size_t)(BK * 2);
    const size_t hstepA = (size_t)HALF * g.lda * 2, hstepB = (size_t)HALF * g.ldb * 2;
    const size_t tstepA = 2 * hstepA, tstepB = 2 * hstepB;
    const unsigned ldsw = (unsigned)wid * 1024u;
    const int aoff = lds_byte(wr * 64 + fr, fq * 8), boff = lds_byte(wc * 32 + fr, fq * 8);
#define PG8_SA(b, h) (((b) * 2 + (h)) * HTB)
#define PG8_SB(b, h) ((4 + (b) * 2 + (h)) * HTB)
#define PG8_STAGE(bufoff, gbase, voff) do { _Pragma("unroll") for (int _i = 0; _i < 2; ++_i) \
        __builtin_amdgcn_global_load_lds((const unsigned*)((const char*)(gbase) + (voff)[_i]), (LAS unsigned*)(lds + (bufoff) + ldsw + _i * 8192), 16, 0, 0); } while (0)
#define PG8_LDA(dst, b, h) do { _Pragma("unroll") for (int m = 0; m < 4; ++m) _Pragma("unroll") for (int k = 0; k < 2; ++k) dst[m][k] = *(const LAS bf16x8*)(lds + PG8_SA(b, h) + aoff + m * 2048 + k * 1024); } while (0)
#define PG8_LDB(dst, b, h) do { _Pragma("unroll") for (int n = 0; n < 2; ++n) _Pragma("unroll") for (int k = 0; k < 2; ++k) dst[n][k] = *(const LAS bf16x8*)(lds + PG8_SB(b, h) + boff + n * 2048 + k * 1024); } while (0)
#define PG8_MMA(ai, bj, At, Bt) do { __builtin_amdgcn_s_setprio(1); _Pragma("unroll") for (int m = 0; m < 4; ++m) _Pragma("unroll") for (int n = 0; n < 2; ++n) _Pragma("unroll") for (int k = 0; k < 2; ++k) \
        acc[ai][bj][m][n] = __builtin_amdgcn_mfma_f32_16x16x32_bf16(Bt[n][k], At[m][k], acc[ai][bj][m][n], 0, 0, 0); __builtin_amdgcn_s_setprio(0); } while (0)
#define PG8_WAIT_V(n) asm volatile("s_waitcnt vmcnt(" #n ")" ::: "memory")
#define PG8_WAIT_L(n) asm volatile("s_waitcnt lgkmcnt(" #n ")" ::: "memory")
#define PG8_BAR __builtin_amdgcn_s_barrier()
#define PG8_SCHED __builtin_amdgcn_sched_barrier(0)
    Unit cur, nxt; int ui = 0;
    if (!S.next(0, cur)) return;
    f32x4 acc[2][2][4][2];
#pragma unroll
    for (int a = 0; a < 2; ++a)
#pragma unroll
        for (int b = 0; b < 2; ++b)
#pragma unroll
            for (int m = 0; m < 4; ++m)
#pragma unroll
                for (int n = 0; n < 2; ++n) acc[a][b][m][n] = (f32x4){0.f, 0.f, 0.f, 0.f};
    bf16x8 At[4][2], B0[2][2], B1[2][2];
    const char* cA = (const char*)g.A + (size_t)cur.pm * tstepA; const char* cB = (const char*)g.Bt + (size_t)cur.pn * tstepB;
    PG8_STAGE(PG8_SB(0, 0), cB, voffB); PG8_STAGE(PG8_SB(0, 1), cB + hstepB, voffB); PG8_STAGE(PG8_SA(0, 0), cA, voffA); PG8_STAGE(PG8_SA(0, 1), cA + hstepA, voffA);
    if (wr == 1) PG8_BAR;
    PG8_WAIT_V(2); PG8_BAR;
    PG8_STAGE(PG8_SB(1, 0), cB + kstep, voffB); PG8_STAGE(PG8_SA(1, 0), cA + kstep, voffA); PG8_STAGE(PG8_SB(1, 1), cB + hstepB + kstep, voffB);
    PG8_WAIT_V(6); PG8_BAR;
    for (;;) {
        const bool has_next = S.next(ui + 1, nxt);
        const char* nA = has_next ? (const char*)g.A + (size_t)nxt.pm * tstepA : cA; const char* nB = has_next ? (const char*)g.Bt + (size_t)nxt.pn * tstepB : cB;
        for (int t = 0; t < nt; t += 2) {
            const bool last = (t == nt - 2);
            const char* a1 = cA + (size_t)(t + 1) * kstep;
            const char* a2 = last ? nA : cA + (size_t)(t + 2) * kstep; const char* b2 = last ? nB : cB + (size_t)(t + 2) * kstep;
            const char* a3 = a2 + kstep; const char* b3 = b2 + kstep;
            if constexpr (Epi::MID) { if (t == nt / 2) E.mid(acc, cur, wr, wc, fr, fq); }
            PG8_LDB(B0, 0, 0); PG8_LDB(B1, 0, 1); PG8_SCHED; PG8_LDA(At, 0, 0); PG8_STAGE(PG8_SA(1, 1), a1 + hstepA, voffA);
            PG8_WAIT_V(8); PG8_WAIT_L(0); PG8_BAR; PG8_MMA(0, 0, At, B0); PG8_MMA(0, 1, At, B1); PG8_BAR; PG8_SCHED;
            PG8_LDA(At, 0, 1); PG8_STAGE(PG8_SB(0, 0), b2, voffB); PG8_STAGE(PG8_SB(0, 1), b2 + hstepB, voffB); PG8_STAGE(PG8_SA(0, 0), a2, voffA);
            PG8_WAIT_V(8); PG8_WAIT_L(0); PG8_BAR; PG8_MMA(1, 0, At, B0); PG8_MMA(1, 1, At, B1); PG8_BAR; PG8_SCHED;
            PG8_LDB(B0, 1, 0); PG8_LDB(B1, 1, 1); PG8_SCHED; PG8_LDA(At, 1, 0); PG8_STAGE(PG8_SA(0, 1), a2 + hstepA, voffA);
            PG8_WAIT_V(8); PG8_WAIT_L(0); PG8_BAR; PG8_MMA(0, 0, At, B0); PG8_MMA(0, 1, At, B1); PG8_BAR; PG8_SCHED;
            PG8_LDA(At, 1, 1); PG8_STAGE(PG8_SB(1, 0), b3, voffB); PG8_STAGE(PG8_SB(1, 1), b3 + hstepB, voffB); PG8_STAGE(PG8_SA(1, 0), a3, voffA);
            PG8_WAIT_V(8); PG8_WAIT_L(0); PG8_BAR; PG8_MMA(1, 0, At, B0); PG8_MMA(1, 1, At, B1); PG8_BAR; PG8_SCHED;
        }
        if (wr == 0) PG8_BAR;
        E(acc, cur, wr, wc, fr, fq);
        if (!has_next) break;
#pragma unroll
        for (int a = 0; a < 2; ++a)
#pragma unroll
            for (int b = 0; b < 2; ++b)
#pragma unroll
                for (int m = 0; m < 4; ++m)
#pragma unroll
                    for (int n = 0; n < 2; ++n) acc[a][b][m][n] = (f32x4){0.f, 0.f, 0.f, 0.f};
        cur = nxt; cA = nA; cB = nB; ++ui;
        if (wr == 1) PG8_BAR;
    }
    PG8_WAIT_V(0);
    PG8_BAR;
#undef PG8_SA
#undef PG8_SB
#undef PG8_STAGE
#undef PG8_LDA
#undef PG8_LDB
#undef PG8_MMA
#undef PG8_WAIT_V
#undef PG8_WAIT_L
#undef PG8_BAR
#undef PG8_SCHED
}
}

__device__ __forceinline__ void st_bf16x4(bf16* p, f32x4 v) { u32x2 w; w.x = pk2(v[0], v[1]); w.y = pk2(v[2], v[3]); *(u32x2*)p = w; }
__device__ __forceinline__ float sum_parts(const float* p, int n4) { f32x4 s = {0.f, 0.f, 0.f, 0.f}; for (int i = 0; i < n4; ++i) s += ((const f32x4*)p)[i]; return (s[0] + s[1]) + (s[2] + s[3]); }
__device__ __forceinline__ int sperm16(int s) { const int c = s & 15; return (s & ~15) | (8 * ((c >> 2) & 1) + 4 * (c >> 3) + (c & 3)); }

struct EpiZ {
    static constexpr bool MID = false;
    bf16 *qlat, *kvlat, *kpe, *u, *vt; float *stq, *stkv, *stvs, *stvq; const float* rope;
    __device__ __forceinline__ void operator()(const f32x4 (&acc)[2][2][4][2], const pg8::Unit& un, int wr, int wc, int fr, int fq) const {
        const int pn = un.pn, row0 = un.pm * 256 + wr * 64 + fr, cl0 = wc * 32 + 4 * fq;
        if (pn < 6) {
            const bool isq = pn < 4; bf16* dst = isq ? qlat : kvlat; const int ld = isq ? QLR : KVLR, ct = isq ? pn : pn - 4;
#pragma unroll
            for (int ai = 0; ai < 2; ++ai)
#pragma unroll
                for (int m = 0; m < 4; ++m) { const int row = row0 + ai * 128 + m * 16; float ss = 0.f;
#pragma unroll
                    for (int bj = 0; bj < 2; ++bj)
#pragma unroll
                        for (int n = 0; n < 2; ++n) { const f32x4 v = acc[ai][bj][m][n]; ss += (v[0] * v[0] + v[1] * v[1]) + (v[2] * v[2] + v[3] * v[3]);
                            st_bf16x4(dst + (size_t)row * ld + ct * 256 + bj * 128 + cl0 + n * 16, v); }
                    ss += __shfl_xor(ss, 16); ss += __shfl_xor(ss, 32);
                    if (fq == 0) { if (isq) stq[row * 16 + ct * 4 + wc] = ss; else stkv[row * 8 + ct * 4 + wc] = ss; } }
        } else if (pn == 6) {
            if (wc < 2) {
#pragma unroll
                for (int ai = 0; ai < 2; ++ai)
#pragma unroll
                    for (int m = 0; m < 4; ++m) { const int row = row0 + ai * 128 + m * 16, j0 = 16 * wc + 4 * fq;
                        const f32x4 x1 = acc[ai][0][m][0], x2 = acc[ai][0][m][1];
                        const f32x4 c0 = *(const f32x4*)(rope + (size_t)row * 64 + 2 * j0), c1 = *(const f32x4*)(rope + (size_t)row * 64 + 2 * j0 + 4);
                        const float cs[4] = {c0[0], c0[2], c1[0], c1[2]}, sn[4] = {c0[1], c0[3], c1[1], c1[3]};
                        f32x4 o1, o2;
#pragma unroll
                        for (int e = 0; e < 4; ++e) { o1[e] = x1[e] * cs[e] - x2[e] * sn[e]; o2[e] = x2[e] * cs[e] + x1[e] * sn[e]; }
                        st_bf16x4(kpe + (size_t)row * 64 + j0, o1); st_bf16x4(kpe + (size_t)row * 64 + 32 + j0, o2); }
            }
        } else if (pn < 15) {
#pragma unroll
            for (int ai = 0; ai < 2; ++ai)
#pragma unroll
                for (int m = 0; m < 4; ++m) { const int row = row0 + ai * 128 + m * 16;
#pragma unroll
                    for (int bj = 0; bj < 2; ++bj)
#pragma unroll
                        for (int n = 0; n < 2; ++n) { f32x4 v = acc[ai][bj][m][n];
#pragma unroll
                            for (int e = 0; e < 4; ++e) v[e] = gelu_f(v[e]);
                            st_bf16x4(u + (size_t)row * GW + (pn - 7) * 256 + bj * 128 + cl0 + n * 16, v); } }
        } else {
            const int ct = pn - 15;
#pragma unroll
            for (int ai = 0; ai < 2; ++ai)
#pragma unroll
                for (int m = 0; m < 4; ++m) { const int row = row0 + ai * 128 + m * 16, b = row >> 12, s = row & 4095; float s1 = 0.f, s2 = 0.f;
#pragma unroll
                    for (int bj = 0; bj < 2; ++bj)
#pragma unroll
                        for (int n = 0; n < 2; ++n) { const f32x4 v = acc[ai][bj][m][n]; const int col = ct * 256 + bj * 128 + cl0 + n * 16;
#pragma unroll
                            for (int e = 0; e < 4; ++e) { const float g = gelu_f(v[e]); s1 += g; s2 += g * g; vt[((size_t)b * GW + col + e) * SEQ + s] = (bf16)f2bf(g); } }
                    s1 += __shfl_xor(s1, 16); s1 += __shfl_xor(s1, 32); s2 += __shfl_xor(s2, 16); s2 += __shfl_xor(s2, 32);
                    if (fq == 0) { stvs[row * 32 + ct * 4 + wc] = s1; stvq[row * 32 + ct * 4 + wc] = s2; } }
        }
    }
};

struct EpiQ {
    static constexpr bool MID = false;
    bf16* q; const float* stq; const float* rope;
    __device__ __forceinline__ void operator()(const f32x4 (&acc)[2][2][4][2], const pg8::Unit& un, int wr, int wc, int fr, int fq) const {
        const int pn = un.pn, row0 = un.pm * 256 + wr * 64 + fr;
#pragma unroll
        for (int ai = 0; ai < 2; ++ai)
#pragma unroll
            for (int m = 0; m < 4; ++m) { const int row = row0 + ai * 128 + m * 16;
                const float rs = rsqrtf(sum_parts(stq + row * 16, 4) * (1.0f / QLR) + EPS);
#pragma unroll
                for (int bj = 0; bj < 2; ++bj) { const int blk = 4 * pn + 2 * bj + (wc >> 1), head = blk / 3, part = blk - 3 * head;
                    if (part != 2) {
#pragma unroll
                        for (int n = 0; n < 2; ++n) st_bf16x4(q + (size_t)row * (NH * QKD) + pn * 256 + bj * 128 + wc * 32 + n * 16 + 4 * fq, acc[ai][bj][m][n] * rs);
                    } else {
                        const int j0 = 16 * (wc & 1) + 4 * fq; const f32x4 x1 = acc[ai][bj][m][0] * rs, x2 = acc[ai][bj][m][1] * rs;
                        const f32x4 c0 = *(const f32x4*)(rope + (size_t)row * 64 + 2 * j0), c1 = *(const f32x4*)(rope + (size_t)row * 64 + 2 * j0 + 4);
                        const float cs[4] = {c0[0], c0[2], c1[0], c1[2]}, sn[4] = {c0[1], c0[3], c1[1], c1[3]};
                        f32x4 o1, o2;
#pragma unroll
                        for (int e = 0; e < 4; ++e) { o1[e] = x1[e] * cs[e] - x2[e] * sn[e]; o2[e] = x2[e] * cs[e] + x1[e] * sn[e]; }
                        bf16* base = q + (size_t)row * (NH * QKD) + head * QKD + NOPE;
                        st_bf16x4(base + j0, o1); st_bf16x4(base + 32 + j0, o2);
                    } } }
    }
};

struct EpiKV {
    static constexpr bool MID = false;
    bf16 *kn, *vta; const float* stkv;
    __device__ __forceinline__ void operator()(const f32x4 (&acc)[2][2][4][2], const pg8::Unit& un, int wr, int wc, int fr, int fq) const {
        const int pn = un.pn, row0 = un.pm * 256 + wr * 64 + fr;
#pragma unroll
        for (int ai = 0; ai < 2; ++ai)
#pragma unroll
            for (int m = 0; m < 4; ++m) { const int row = row0 + ai * 128 + m * 16, b = row >> 12, sp = sperm16(row & 4095);
                const float rs = rsqrtf(sum_parts(stkv + row * 8, 2) * (1.0f / KVLR) + EPS);
#pragma unroll
                for (int n = 0; n < 2; ++n) { const int d0 = wc * 32 + n * 16 + 4 * fq;
                    st_bf16x4(kn + (size_t)row * (NH * NOPE) + pn * NOPE + d0, acc[ai][0][m][n] * rs);
                    const f32x4 v = acc[ai][1][m][n] * rs;
#pragma unroll
                    for (int e = 0; e < 4; ++e) vta[(((size_t)b * NH + pn) * VD + d0 + e) * SEQ + sp] = (bf16)f2bf(v[e]); } }
    }
};

struct EpiX1 {
    static constexpr bool MID = true;
    const float* mod; bf16* mix; const LAS f32x2* rs; int pm0;
    __device__ __forceinline__ void mid(f32x4 (&acc)[2][2][4][2], const pg8::Unit& un, int wr, int wc, int fr, int fq) const {
        const LAS f32x2* p = rs + (un.pm == pm0 ? 0 : 256) + wr * 64 + fr;
#pragma unroll
        for (int ai = 0; ai < 2; ++ai)
#pragma unroll
            for (int m = 0; m < 4; ++m) { const float ratio = p[ai * 128 + m * 16].x;
#pragma unroll
                for (int bj = 0; bj < 2; ++bj)
#pragma unroll
                    for (int n = 0; n < 2; ++n) acc[ai][bj][m][n] *= ratio; }
    }
    __device__ __forceinline__ void operator()(const f32x4 (&acc)[2][2][4][2], const pg8::Unit& un, int wr, int wc, int fr_, int fq_) const {
        int fr = fr_, fq = fq_; asm volatile("" : "+v"(fr), "+v"(fq));
        const int pn = un.pn, row0 = un.pm * 256 + wr * 64 + fr, b = (un.pm * 256) >> 12;
        const LAS f32x2* p = rs + (un.pm == pm0 ? 0 : 256) + wr * 64 + fr;
        f32x4 gt[2][2];
#pragma unroll
        for (int bj = 0; bj < 2; ++bj)
#pragma unroll
            for (int n = 0; n < 2; ++n) gt[bj][n] = *(const f32x4*)(mod + (size_t)b * 6 * D + 2 * D + pn * 256 + bj * 128 + wc * 32 + n * 16 + 4 * fq);
#pragma unroll
        for (int ai = 0; ai < 2; ++ai)
#pragma unroll
            for (int m = 0; m < 4; ++m) { const int row = row0 + ai * 128 + m * 16; const size_t ro = (size_t)row * D;
                const float rg = p[ai * 128 + m * 16].y;
#pragma unroll
                for (int bj = 0; bj < 2; ++bj)
#pragma unroll
                    for (int n = 0; n < 2; ++n) { const int col = pn * 256 + bj * 128 + wc * 32 + n * 16 + 4 * fq;
                        st_bf16x4(mix + ro + col, gt[bj][n] * (acc[ai][bj][m][n] * rg)); } }
    }
};

struct EpiQP {
    static constexpr bool MID = false;
    bf16* qp;
    __device__ __forceinline__ void operator()(const f32x4 (&acc)[2][2][4][2], const pg8::Unit& un, int wr, int wc, int fr, int fq) const {
        const int pn = un.pn, row0 = un.pm * 256 + wr * 64 + fr;
#pragma unroll
        for (int ai = 0; ai < 2; ++ai)
#pragma unroll
            for (int m = 0; m < 4; ++m) { const size_t ro = (size_t)(row0 + ai * 128 + m * 16) * PQW;
#pragma unroll
                for (int bj = 0; bj < 2; ++bj)
#pragma unroll
                    for (int n = 0; n < 2; ++n) st_bf16x4(qp + ro + pn * 256 + bj * 128 + wc * 32 + n * 16 + 4 * fq, acc[ai][bj][m][n]); }
    }
};

struct Ctx {
    const float *x, *c; const int* pos; const float *w_ada, *b_ada, *g_mix, *w_in, *g_q, *w_uq, *g_kv, *w_ukv, *g_sgu, *w_sgu, *b_sgu, *beta_mla, *beta_g, *w_out, *g_ffn, *w_pq, *pkeys, *eu, *ev, *w_adaf, *b_adaf, *g_f;
    float* out; unsigned char* ws;
};

__device__ __forceinline__ void ada_unit(const Ctx& C, int unit, LAS float* red, int tid, int wave, int lane) {
    const bool fin = unit >= 192; const float* W = fin ? C.w_adaf : C.w_ada; const int N = fin ? 2 * D : 6 * D, n0 = (fin ? unit - 192 : unit) * 128;
    const int half = lane >> 5, l32 = lane & 31;
    f32x4 a0 = {0.f, 0.f, 0.f, 0.f}, a1 = {0.f, 0.f, 0.f, 0.f};
    const int kbeg = wave * 512;
    LAS float* sil = red + 2048;
#pragma unroll
    for (int j = 0; j < 16; ++j) { const float cv = C.c[tid + 512 * j]; sil[tid + 512 * j] = cv / (1.0f + __expf(-cv)); }
    __syncthreads();
    const char* wp = (const char*)(W + (size_t)(kbeg + half) * N + n0 + 4 * l32); const unsigned rstep = 2u * (unsigned)N * 4u;
    f32x4 w[12];
#pragma unroll
    for (int p = 0; p < 12; ++p) w[p] = *(const f32x4*)(wp + (size_t)p * rstep);
#pragma unroll 1
    for (int i = 0; i < 252; i += 12) {
#pragma unroll
        for (int p = 0; p < 12; ++p) { const int k = kbeg + 2 * (i + p) + half; const f32x4 cur = w[p];
            if (i + 12 + p < 256) w[p] = *(const f32x4*)(wp + (size_t)(i + 12 + p) * rstep);
            const float s0 = sil[k], s1 = sil[D + k];
            a0 += cur * s0; a1 += cur * s1; } }
#pragma unroll
    for (int p = 0; p < 4; ++p) { const int k = kbeg + 2 * (252 + p) + half; const float s0 = sil[k], s1 = sil[D + k]; a0 += w[p] * s0; a1 += w[p] * s1; }
#pragma unroll
    for (int e = 0; e < 4; ++e) { a0[e] += __shfl_xor(a0[e], 32); a1[e] += __shfl_xor(a1[e], 32); }
    if (half == 0) { *(LAS f32x4*)(red + (wave * 32 + l32) * 8) = a0; *(LAS f32x4*)(red + (wave * 32 + l32) * 8 + 4) = a1; }
    __syncthreads();
    if (tid < 256) { const int b = tid >> 7, col = tid & 127; float s = 0.f;
#pragma unroll
        for (int w = 0; w < 8; ++w) s += red[(w * 32 + (col >> 2)) * 8 + b * 4 + (col & 3)];
        const float* bias = fin ? C.b_adaf : C.b_ada;
        float* o = (float*)(C.ws + WS_MOD) + (fin ? 2 * 6 * D : 0) + (size_t)b * N + n0 + col;
        *o = s + bias[n0 + col]; }
    __syncthreads();
}

enum { MAP_ID = 0, MAP_W1 = 1, MAP_UQ = 2 };
__device__ __forceinline__ int ropeperm(int p) { return ((p >> 4) & 1) * 32 + 16 * (p >> 5) + (p & 15); }
template <int MAP> __device__ __forceinline__ int colmap(int n) {
    if (MAP == MAP_W1) { if (n < 1536) return n; if (n < 1600) return 1536 + ropeperm(n - 1536); if (n < 1792) return -1; return n - 192; }
    if (MAP == MAP_UQ) { const int blk = n >> 6; if (blk % 3 == 2) return (n & ~63) + ropeperm(n & 63); return n; }
    return n;
}
template <int MAP> __device__ __forceinline__ void transpose_item(const float* W, int K, int N, int NP, bf16* WT, const float* ks, float mul, LAS float* scr, int item, int lane) {
    const int nblk = NP / 32, kb = item / nblk, nb = item % nblk, k0 = 64 * kb, n0 = 32 * nb;
    const int q4 = lane & 7, src = colmap<MAP>(n0 + 4 * q4);
    f32x4 ld[8];
#pragma unroll
    for (int i = 0; i < 8; ++i) { const int kk = (lane >> 3) + 8 * i; ld[i] = (src >= 0) ? *(const f32x4*)(W + (size_t)(k0 + kk) * N + src) : (f32x4){0.f, 0.f, 0.f, 0.f}; }
#pragma unroll
    for (int i = 0; i < 8; ++i) { const int kk = (lane >> 3) + 8 * i;
#pragma unroll
        for (int e = 0; e < 4; ++e) scr[kk * 33 + 4 * q4 + e] = ld[i][e]; }
    LDS_WAIT(); asm volatile("" ::: "memory");
    const int c = lane & 7;
    float sc[8];
#pragma unroll
    for (int e = 0; e < 8; ++e) sc[e] = (ks ? ks[k0 + 8 * c + e] : 1.0f) * mul;
#pragma unroll
    for (int j = 0; j < 4; ++j) { const int n = (lane >> 3) + 8 * j; const LAS float* s = scr + (8 * c) * 33 + n;
        u32x4 o; o.x = pk2(s[0 * 33] * sc[0], s[1 * 33] * sc[1]); o.y = pk2(s[2 * 33] * sc[2], s[3 * 33] * sc[3]); o.z = pk2(s[4 * 33] * sc[4], s[5 * 33] * sc[5]); o.w = pk2(s[6 * 33] * sc[6], s[7 * 33] * sc[7]);
        *(u32x4*)(WT + (size_t)(n0 + n) * K + k0 + 8 * c) = o; }
    LDS_WAIT(); asm volatile("" ::: "memory");
}

__device__ __forceinline__ float wave_max_nonneg(float v) {
    v = fmaxf(v, __builtin_bit_cast(float, __builtin_amdgcn_update_dpp(0, __builtin_bit_cast(int, v), 0xB1, 0xF, 0xF, true)));
    v = fmaxf(v, __builtin_bit_cast(float, __builtin_amdgcn_update_dpp(0, __builtin_bit_cast(int, v), 0x4E, 0xF, 0xF, true)));
    v = fmaxf(v, __builtin_bit_cast(float, __builtin_amdgcn_update_dpp(0, __builtin_bit_cast(int, v), 0x141, 0xF, 0xF, true)));
    v = fmaxf(v, __builtin_bit_cast(float, __builtin_amdgcn_update_dpp(0, __builtin_bit_cast(int, v), 0x140, 0xF, 0xF, true)));
    v = fmaxf(v, __builtin_bit_cast(float, __builtin_amdgcn_update_dpp(0, __builtin_bit_cast(int, v), 0x142, 0xA, 0xF, true)));
    v = fmaxf(v, __builtin_bit_cast(float, __builtin_amdgcn_update_dpp(0, __builtin_bit_cast(int, v), 0x143, 0xC, 0xF, true)));
    return __builtin_bit_cast(float, __builtin_amdgcn_readlane(__builtin_bit_cast(int, v), 63));
}
template <bool Q8> __device__ __forceinline__ void norm_mod_rows(const float* X, const bf16* ADD, const float* g, const float* sh, const float* sc, bf16* O, signed char* O8, float* S8, bf16* X1O, int gw, int NGW, int lane) {
    f32x4 vn[16]; u32x2 an[16];
    if (gw < M) {
#pragma unroll
        for (int j = 0; j < 16; ++j) { vn[j] = ((const f32x4*)(X + (size_t)gw * D))[64 * j + lane]; if (Q8) an[j] = ((const u32x2*)(ADD + (size_t)gw * D))[64 * j + lane]; } }
    for (int m = gw; m < M; m += NGW) { const int b = m >> 12;
        f32x4 v[16]; float ss = 0.f;
#pragma unroll
        for (int j = 0; j < 16; ++j) { v[j] = vn[j];
            if (Q8) v[j] += (f32x4){bf2f(an[j].x & 0xffffu), bf2f(an[j].x >> 16), bf2f(an[j].y & 0xffffu), bf2f(an[j].y >> 16)};
            ss += (v[j][0] * v[j][0] + v[j][1] * v[j][1]) + (v[j][2] * v[j][2] + v[j][3] * v[j][3]); }
        if (m + NGW < M) {
#pragma unroll
            for (int j = 0; j < 16; ++j) { vn[j] = ((const f32x4*)(X + (size_t)(m + NGW) * D))[64 * j + lane]; if (Q8) an[j] = ((const u32x2*)(ADD + (size_t)(m + NGW) * D))[64 * j + lane]; } }
        const float rs = rsqrtf(wave_sum(ss) * (1.0f / D) + EPS);
        const char* gp = (const char*)g; const char* scp = (const char*)(sc + (size_t)b * 6 * D); const char* shp = (const char*)(sh + (size_t)b * 6 * D);
        char* op = (char*)(O + (size_t)m * D); char* o8p = (char*)(O8 + (size_t)m * D); char* x1p = (char*)(X1O + (size_t)m * D);
        int lanev = lane; asm volatile("" : "+v"(lanev));
        float amx = 0.f;
#pragma unroll
        for (int j = 0; j < 16; ++j) { const unsigned cb = (unsigned)(64 * j + lanev) * 16u;
            const f32x4 gg = *(const f32x4*)(gp + cb), s1 = *(const f32x4*)(scp + cb), s0 = *(const f32x4*)(shp + cb);
            const f32x4 y = v[j] * rs * gg * (s1 + 1.0f) + s0;
            u32x2 w; w.x = pk2(y[0], y[1]); w.y = pk2(y[2], y[3]); *(u32x2*)(op + (cb >> 1)) = w;
            if (Q8) { u32x2 w1; w1.x = pk2(v[j][0], v[j][1]); w1.y = pk2(v[j][2], v[j][3]); *(u32x2*)(x1p + (cb >> 1)) = w1;
                v[j] = y; amx = fmaxf(amx, fmaxf(fmaxf(fabsf(y[0]), fabsf(y[1])), fmaxf(fabsf(y[2]), fabsf(y[3])))); }
            if ((j & 1) == 1) __builtin_amdgcn_sched_barrier(0); }
        if (Q8) {
            const float am = wave_max_nonneg(amx), q = am > 0.f ? 127.0f / am : 0.f;
            asm volatile("" : "+v"(lanev));
#pragma unroll
            for (int j = 0; j < 16; ++j) { const unsigned cb = (unsigned)(64 * j + lanev) * 4u;
                const int q0 = (int)rintf(v[j][0] * q), q1 = (int)rintf(v[j][1] * q), q2 = (int)rintf(v[j][2] * q), q3 = (int)rintf(v[j][3] * q);
                *(unsigned*)(o8p + cb) = (unsigned)(q0 & 255) | ((unsigned)(q1 & 255) << 8) | ((unsigned)(q2 & 255) << 16) | ((unsigned)(q3 & 255) << 24); }
            if (lane == 0) S8[m] = am * (1.0f / 127.0f); } }
}

constexpr int SG_ROW = 272;
__device__ __forceinline__ void sgu_units(const Ctx& C, int u0, int uend, int ustep, LAS unsigned char* lds, int tid, int wave, int lane) {
#define SG_LBAR() do { asm volatile("s_waitcnt lgkmcnt(0)" ::: "memory"); __builtin_amdgcn_s_barrier(); asm volatile("" ::: "memory"); } while (0)
    const bf16* VT = (const bf16*)(C.ws + WS_VT); const bf16* U = (const bf16*)(C.ws + WS_U); bf16* Y = (bf16*)(C.ws + WS_Y);
    const float* stvs = (const float*)(C.ws + WS_STVS); const float* stvq = (const float*)(C.ws + WS_STVQ); float* stg = (float*)(C.ws + WS_STG);
    const bf16* WS = (const bf16*)(C.ws + WS_WSGU);
    LAS float* mu = (LAS float*)(lds + 128 * SG_ROW); LAS float* rstd = mu + 128;
    const int r = lane & 31, hi = lane >> 5, db = wave >> 1;
    u32x4 raw[4]; float gq[4]; float ps1 = 0.f, ps2 = 0.f;
#define SG_FETCH(unit_) do { const int hh_ = (unit_) & 15, n_ = ((unit_) >> 4) & 31, b_ = (unit_) >> 9, tok0_ = b_ * SEQ + n_ * GC; int tidv_ = tid; asm volatile("" : "+v"(tidv_)); \
        if (tidv_ < 128) { ps1 = sum_parts(stvs + (size_t)(tok0_ + tidv_) * 32, 8); ps2 = sum_parts(stvq + (size_t)(tok0_ + tidv_) * 32, 8); } \
        _Pragma("unroll") for (int i = 0; i < 4; ++i) { const int idx = tidv_ + 512 * i, d = idx >> 4, ch = idx & 15; \
            raw[i] = *(const u32x4*)(VT + ((size_t)b_ * GW + hh_ * 128 + d) * SEQ + n_ * GC + ch * 8); gq[i] = C.g_sgu[hh_ * 128 + d]; } } while (0)
    __syncthreads();
    if (u0 < uend) SG_FETCH(u0);
    for (int unit = u0; unit < uend; unit += ustep) {
        const int hh = unit & 15, n = (unit >> 4) & 31, b = unit >> 9, tok0 = b * SEQ + n * GC;
        if (tid < 128) { const float mean = ps1 * (1.0f / GW), var = fmaxf(ps2 * (1.0f / GW) - mean * mean, 0.f); mu[tid] = mean; rstd[tid] = rsqrtf(var + EPS); }
        bf16x8 wv[2][8]; u32x2 uu[2][4]; float bias[2];
#pragma unroll
        for (int tt = 0; tt < 2; ++tt) { const int t = 32 * (2 * (wave & 1) + tt) + r;
#pragma unroll
            for (int ks = 0; ks < 8; ++ks) wv[tt][ks] = *(const bf16x8*)(WS + ((size_t)hh * 128 + t) * 128 + 16 * ks + 8 * hi);
#pragma unroll
            for (int g4 = 0; g4 < 4; ++g4) uu[tt][g4] = *(const u32x2*)(U + (size_t)(tok0 + t) * GW + hh * 128 + 32 * db + 8 * g4 + 4 * hi);
            bias[tt] = C.b_sgu[hh * 128 + t]; }
        SG_LBAR();
#pragma unroll
        for (int i = 0; i < 4; ++i) { const int idx = tid + 512 * i, d = idx >> 4, ch = idx & 15;
            const float g = gq[i];
            float f[8];
#pragma unroll
            for (int e = 0; e < 4; ++e) { f[2 * e] = bf2f(raw[i][e] & 0xffffu); f[2 * e + 1] = bf2f(raw[i][e] >> 16); }
#pragma unroll
            for (int e = 0; e < 8; ++e) f[e] = (f[e] - mu[ch * 8 + e]) * rstd[ch * 8 + e] * g;
            u32x4 o; o.x = pk2(f[0], f[1]); o.y = pk2(f[2], f[3]); o.z = pk2(f[4], f[5]); o.w = pk2(f[6], f[7]);
            *(LAS u32x4*)(lds + d * SG_ROW + ch * 16) = o; }
        SG_LBAR();
        if (unit + ustep < uend) SG_FETCH(unit + ustep);
#pragma unroll
        for (int tt = 0; tt < 2; ++tt) { const int tb = 2 * (wave & 1) + tt;
            f32x16 acc; for (int i = 0; i < 16; ++i) acc[i] = 0.f;
#pragma unroll
            for (int ks = 0; ks < 8; ++ks) { if (ks <= 2 * tb + 1) {
                const bf16x8 a = *(const LAS bf16x8*)(lds + (32 * db + r) * SG_ROW + ks * 32 + hi * 16);
                acc = __builtin_amdgcn_mfma_f32_32x32x16_bf16(a, wv[tt][ks], acc, 0, 0, 0); } }
            const int t = 32 * tb + r, tok = tok0 + t; float ss = 0.f;
#pragma unroll
            for (int g4 = 0; g4 < 4; ++g4) { const int d0 = 32 * db + 8 * g4 + 4 * hi; const u32x2 u2 = uu[tt][g4];
                f32x4 y; y[0] = bf2f(u2.x & 0xffffu) * (acc[4 * g4 + 0] + bias[tt]); y[1] = bf2f(u2.x >> 16) * (acc[4 * g4 + 1] + bias[tt]);
                y[2] = bf2f(u2.y & 0xffffu) * (acc[4 * g4 + 2] + bias[tt]); y[3] = bf2f(u2.y >> 16) * (acc[4 * g4 + 3] + bias[tt]);
                ss += (y[0] * y[0] + y[1] * y[1]) + (y[2] * y[2] + y[3] * y[3]);
                st_bf16x4(Y + (size_t)tok * D + GW + hh * 128 + d0, y); }
            ss += __shfl_xor(ss, 32);
            if (hi == 0) ((LAS float*)(lds + 128 * SG_ROW + 1024))[t * 4 + db] = ss; }
        SG_LBAR();
        if (tid < 128) { const f32x4 p4 = *(const LAS f32x4*)(lds + 128 * SG_ROW + 1024 + tid * 16); stg[(size_t)(tok0 + tid) * 16 + hh] = (p4[0] + p4[1]) + (p4[2] + p4[3]); }
    }
    __syncthreads();
#undef SG_FETCH
#undef SG_LBAR
}

constexpr int AK_ROW = 400, AV_ROW = 144, AK_BYTES = 64 * AK_ROW, AV_BYTES = 128 * AV_ROW, ABUF = AK_BYTES + AV_BYTES;
__device__ __forceinline__ void attn_block(const Ctx& C, int b, int h, int qb, LAS unsigned char* lds, int tid, int wave, int lane) {
    const bf16* Q = (const bf16*)(C.ws + WS_Q); const bf16* KN = (const bf16*)(C.ws + WS_KN); const bf16* KPE = (const bf16*)(C.ws + WS_KPE);
    const bf16* VTA = (const bf16*)(C.ws + WS_VTA); bf16* Y = (bf16*)(C.ws + WS_Y); float* stm = (float*)(C.ws + WS_STM);
    const int r = lane & 31, hi = lane >> 5, q0 = qb * 256, q0w = q0 + 32 * wave; const size_t tokq = (size_t)b * SEQ + q0w + r;
    bf16x8 qf[12];
#pragma unroll
    for (int ks = 0; ks < 12; ++ks) qf[ks] = *(const bf16x8*)(Q + tokq * (NH * QKD) + h * QKD + 16 * ks + 8 * hi);
    f32x16 o[4];
#pragma unroll
    for (int db = 0; db < 4; ++db) for (int i = 0; i < 16; ++i) o[db][i] = 0.f;
    float mrun = -1e30f, lrun = 0.f;
    const int ntiles = (q0 + 256) / 64;
    const int kr0 = tid >> 4, kc0 = tid & 15, pr = tid >> 3, pc = tid & 7;
    const unsigned ok0 = (((unsigned)b * SEQ + kr0) * (NH * NOPE) + h * NOPE + kc0 * 8) * 2u;
    const unsigned op0 = (((unsigned)b * SEQ + pr) * ROPE + pc * 8) * 2u;
    const unsigned ov0 = ((((unsigned)b * NH + h) * VD + pr) * SEQ + pc * 8) * 2u;
    const unsigned lk0 = kr0 * AK_ROW + kc0 * 16, lk1 = (kr0 + 32) * AK_ROW + kc0 * 16, lp = pr * AK_ROW + 256 + pc * 16;
    const unsigned lv0 = AK_BYTES + pr * AV_ROW + pc * 16, lv1 = AK_BYTES + (pr + 64) * AV_ROW + pc * 16;
    u32x4 st[5];
#define ATT_GLOAD(j) do { const unsigned j_ = (unsigned)(j); \
        st[0] = *(const u32x4*)((const char*)KN + (ok0 + j_ * (64u * NH * NOPE * 2u))); st[1] = *(const u32x4*)((const char*)KN + (ok0 + j_ * (64u * NH * NOPE * 2u) + 32u * NH * NOPE * 2u)); \
        st[2] = *(const u32x4*)((const char*)KPE + (op0 + j_ * (64u * ROPE * 2u))); \
        st[3] = *(const u32x4*)((const char*)VTA + (ov0 + j_ * 128u)); st[4] = *(const u32x4*)((const char*)VTA + (ov0 + j_ * 128u + 64u * SEQ * 2u)); } while (0)
    ATT_GLOAD(0);
    for (int j = 0; j < ntiles; ++j) {
        LAS unsigned char* buf = lds + (j & 1) * ABUF;
        *(LAS u32x4*)(buf + lk0) = st[0]; *(LAS u32x4*)(buf + lk1) = st[1]; *(LAS u32x4*)(buf + lp) = st[2]; *(LAS u32x4*)(buf + lv0) = st[3]; *(LAS u32x4*)(buf + lv1) = st[4];
        if (j + 1 < ntiles) ATT_GLOAD(j + 1);
        __syncthreads();
        const int kbase = 64 * j;
        if (kbase <= q0w + 31) {
            f32x16 s0, s1;
#pragma unroll
            for (int i = 0; i < 16; ++i) { s0[i] = 0.f; s1[i] = 0.f; }
#pragma unroll
            for (int ks = 0; ks < 12; ++ks) {
                const bf16x8 k0 = *(const LAS bf16x8*)(buf + r * AK_ROW + ks * 32 + hi * 16);
                const bf16x8 k1 = *(const LAS bf16x8*)(buf + (32 + r) * AK_ROW + ks * 32 + hi * 16);
                s0 = __builtin_amdgcn_mfma_f32_32x32x16_bf16(k0, qf[ks], s0, 0, 0, 0);
                s1 = __builtin_amdgcn_mfma_f32_32x32x16_bf16(k1, qf[ks], s1, 0, 0, 0);
                if ((ks & 3) == 3) __builtin_amdgcn_sched_barrier(0); }
            if (kbase + 63 > q0w) {
                const int qrow = q0w + r;
#pragma unroll
                for (int i = 0; i < 16; ++i) { const int key = kbase + (i & 3) + 8 * (i >> 2) + 4 * hi;
                    s0[i] = key > qrow ? -INFINITY : s0[i]; s1[i] = key + 32 > qrow ? -INFINITY : s1[i]; }
            }
            float mx = fmaxf(s0[0], s1[0]);
#pragma unroll
            for (int i = 1; i < 16; ++i) mx = fmaxf(mx, fmaxf(s0[i], s1[i]));
            mx = fmaxf(mx, __shfl_xor(mx, 32));
            if (!__all(mx - mrun <= 8.0f)) { const float mn = fmaxf(mrun, mx), alpha = __builtin_amdgcn_exp2f(mrun - mn); mrun = mn; lrun *= alpha;
#pragma unroll
                for (int db = 0; db < 4; ++db)
#pragma unroll
                    for (int i = 0; i < 16; ++i) o[db][i] *= alpha; }
            float rsum = 0.f;
#pragma unroll
            for (int i = 0; i < 16; ++i) { s0[i] = __builtin_amdgcn_exp2f(s0[i] - mrun); s1[i] = __builtin_amdgcn_exp2f(s1[i] - mrun); rsum += s0[i] + s1[i]; }
            lrun += rsum;
            bf16x8 pf[4];
#pragma unroll
            for (int t = 0; t < 2; ++t) {
                u32x4 w0, w1;
#pragma unroll
                for (int e = 0; e < 4; ++e) { w0[e] = pk2(s0[8 * t + 2 * e], s0[8 * t + 2 * e + 1]); w1[e] = pk2(s1[8 * t + 2 * e], s1[8 * t + 2 * e + 1]); }
                pf[t] = __builtin_bit_cast(bf16x8, w0); pf[2 + t] = __builtin_bit_cast(bf16x8, w1); }
#pragma unroll
            for (int s4 = 0; s4 < 4; ++s4)
#pragma unroll
                for (int db = 0; db < 4; ++db) {
                    const bf16x8 v = *(const LAS bf16x8*)(buf + AK_BYTES + (32 * db + r) * AV_ROW + s4 * 32 + hi * 16);
                    o[db] = __builtin_amdgcn_mfma_f32_32x32x16_bf16(v, pf[s4], o[db], 0, 0, 0); }
        }
    }
#undef ATT_GLOAD
    const float lt = lrun + __shfl_xor(lrun, 32), inv = 1.0f / lt; float ss = 0.f;
#pragma unroll
    for (int db = 0; db < 4; ++db)
#pragma unroll
        for (int g4 = 0; g4 < 4; ++g4) { const int d0 = 32 * db + 8 * g4 + 4 * hi;
            f32x4 y; y[0] = o[db][4 * g4] * inv; y[1] = o[db][4 * g4 + 1] * inv; y[2] = o[db][4 * g4 + 2] * inv; y[3] = o[db][4 * g4 + 3] * inv;
            ss += (y[0] * y[0] + y[1] * y[1]) + (y[2] * y[2] + y[3] * y[3]);
            st_bf16x4(Y + tokq * D + h * VD + d0, y); }
    ss += __shfl_xor(ss, 32);
    if (hi == 0) stm[tokq * 16 + h] = ss;
}

#define CE_DESC(a, b) do { const float hi_ = fmaxf(a, b), lo_ = fminf(a, b); a = hi_; b = lo_; } while (0)
#define CE_ASC(a, b) do { const float hi_ = fmaxf(a, b), lo_ = fminf(a, b); a = lo_; b = hi_; } while (0)
__device__ __forceinline__ void bitonic_merge16_desc(float (&v)[64], const int base) {
#pragma unroll
    for (int j = 8; j > 0; j >>= 1)
#pragma unroll
        for (int i = 0; i < 16; ++i) { const int l = i ^ j; if (l > i) CE_DESC(v[base + i], v[base + l]); }
}
__device__ __forceinline__ void bitonic_sort16_desc(float (&v)[64], const int base) {
#pragma unroll
    for (int k = 2; k <= 16; k <<= 1)
#pragma unroll
        for (int j = k >> 1; j > 0; j >>= 1)
#pragma unroll
            for (int i = 0; i < 16; ++i) { const int l = i ^ j; if (l > i) { if ((i & k) == 0) CE_DESC(v[base + i], v[base + l]); else CE_ASC(v[base + i], v[base + l]); } }
}
__device__ __forceinline__ void merge_top16(float (&v)[64], const int a0, const int b0) {
#pragma unroll
    for (int i = 0; i < 16; ++i) v[a0 + i] = fmaxf(v[a0 + i], v[b0 + 15 - i]);
    bitonic_merge16_desc(v, a0);
}
__device__ __forceinline__ void top16_of_64(float (&v)[64]) {
    bitonic_sort16_desc(v, 0); bitonic_sort16_desc(v, 16); bitonic_sort16_desc(v, 32); bitonic_sort16_desc(v, 48);
    merge_top16(v, 0, 16); merge_top16(v, 32, 48); merge_top16(v, 0, 32);
}
__device__ __forceinline__ void topk_item(const Ctx& C, int item, LAS float* top  , LAS int* pe, LAS float* pg, int lane) {
    const bf16* QP = (const bf16*)(C.ws + WS_QP); const bf16* KEYS = (const bf16*)(C.ws + WS_KEYS);
    const int tb = item >> 3, hh = item & 7, r = lane & 31, hi = lane >> 5; const size_t tok = (size_t)tb * 32 + r;
#pragma unroll 1
    for (int p = 0; p < 2; ++p) {
        f32x16 sc[4];
#pragma unroll
        for (int nb = 0; nb < 4; ++nb) for (int i = 0; i < 16; ++i) sc[nb][i] = 0.f;
#pragma unroll
        for (int ks = 0; ks < 8; ++ks) {
            const bf16x8 bq = *(const bf16x8*)(QP + tok * PQW + hh * PQD + p * PHALF + 16 * ks + 8 * hi);
#pragma unroll
            for (int nb = 0; nb < 4; ++nb) {
                const bf16x8 ak = *(const bf16x8*)(KEYS + ((size_t)(hh * 2 + p) * PNK + 32 * nb + r) * PHALF + 16 * ks + 8 * hi);
                sc[nb] = __builtin_amdgcn_mfma_f32_32x32x16_bf16(ak, bq, sc[nb], 0, 0, 0); } }
        float v[64];
#pragma unroll
        for (int nb = 0; nb < 4; ++nb)
#pragma unroll
            for (int i = 0; i < 16; ++i) { const unsigned n = 32 * nb + (i & 3) + 8 * (i >> 2) + 4 * hi;
                const float scv = sc[nb][i]; v[nb * 16 + i] = __uint_as_float((__float_as_uint(scv) & 0xffffff80u) | n); }
        top16_of_64(v);
#pragma unroll
        for (int i = 0; i < 16; ++i) v[16 + i] = __shfl_xor(v[i], 32);
        merge_top16(v, 0, 16);
#pragma unroll
        for (int k = 0; k < 16; ++k) top[(p * 16 + k) * 64 + lane] = v[k];
    }
    LDS_WAIT();
    float sv0[16], sv1[16];
#pragma unroll
    for (int a = 0; a < 16; ++a) { sv0[a] = top[a * 64 + lane]; sv1[a] = top[(16 + a) * 64 + lane]; }
    float cd[64];
    { int c = 0;
#pragma unroll
      for (int a = 0; a < 16; ++a)
#pragma unroll
        for (int b = 0; b < 16; ++b) if ((a + 1) * (b + 1) <= 16) { cd[c] = __builtin_bit_cast(float, (__builtin_bit_cast(unsigned, sv0[a] + sv1[b]) & ~255u) | (unsigned)(a * 16 + b)); ++c; }
#pragma unroll
      for (int i = 50; i < 64; ++i) cd[i] = -INFINITY; }
    top16_of_64(cd);
#pragma unroll
    for (int k = 0; k < 16; ++k) top[(32 + k) * 64 + lane] = cd[k];
    LDS_WAIT();
    if (hi == 0) {
        const float s0 = top[32 * 64 + lane]; float ev[16]; int ei[16]; float sum = 0.f;
#pragma unroll
        for (int k = 0; k < 16; ++k) { const float s = top[(32 + k) * 64 + lane]; const unsigned code = __builtin_bit_cast(unsigned, s) & 255u, a = code >> 4, b = code & 15u;
            const unsigned i0 = __builtin_bit_cast(unsigned, top[a * 64 + lane]) & 127u, i1 = __builtin_bit_cast(unsigned, top[(16 + b) * 64 + lane]) & 127u;
            ei[k] = (int)(i0 * PNK + i1); ev[k] = __expf(s - s0); sum += ev[k]; }
        const float inv = 1.0f / sum;
        int rv = r; asm volatile("" : "+v"(rv));
#pragma unroll
        for (int k = 0; k < 16; ++k) { pe[rv * 128 + hh * 16 + k] = ei[k]; pg[rv * 128 + hh * 16 + k] = ev[k] * inv; }
    }
    LDS_WAIT();
}

__device__ __forceinline__ void order_pairs(const Ctx& C, int tb, LAS unsigned char* lds, int tid) {
    LAS int* pe = (LAS int*)(lds + 98304); LAS float* pg = (LAS float*)(lds + 98304 + 16384);
    LAS int* pe2 = (LAS int*)lds; LAS float* pg2 = (LAS float*)(lds + 32 * 129 * 4);
    int* lidx = (int*)(C.ws + WS_LIDX); float* lg = (float*)(C.ws + WS_LG); int* na = (int*)(C.ws + WS_NA);
    const int tk = tid >> 4, sub = tid & 15;
    int e[8]; float g[8]; int cnt = 0;
#pragma unroll
    for (int i = 0; i < 8; ++i) { e[i] = pe[tk * 128 + sub * 8 + i]; g[i] = pg[tk * 128 + sub * 8 + i]; cnt += (e[i] < PNE / 2) ? 1 : 0; }
    int inc = cnt;
#pragma unroll
    for (int o = 1; o < 16; o <<= 1) { const int v = __shfl_up(inc, o, 16); if (sub >= o) inc += v; }
    const int total = __shfl(inc, 15, 16); int pa = inc - cnt, pb = total + (sub * 8 - (inc - cnt));
#pragma unroll
    for (int i = 0; i < 8; ++i) { const bool isa = e[i] < PNE / 2; const int pos = isa ? pa : pb; pa += isa ? 1 : 0; pb += isa ? 0 : 1; pe2[tk * 129 + pos] = e[i]; pg2[tk * 129 + pos] = g[i]; }
    if (sub == 0) na[tb * 32 + tk] = total;
    __syncthreads();
#pragma unroll
    for (int i = 0; i < 8; ++i) { const int idx = i * 512 + tid, pos = idx >> 5, t2 = idx & 31;
        lidx[(size_t)pos * M + tb * 32 + t2] = pe2[t2 * 129 + pos]; lg[(size_t)pos * M + tb * 32 + t2] = pg2[t2 * 129 + pos]; }
}

__device__ __forceinline__ void expert_convert_unit(const Ctx& C, int u, LAS unsigned char* lds, int tid) {
    const int tbl = u >> 12, eb = (u >> 4) & 255, r = u & 15, row = tid >> 3, cq = tid & 7;
    const float* src = (tbl ? C.ev : C.eu) + (size_t)(eb * 64 + row) * D + r * 256 + cq * 32;
    f32x4 v[8]; float am = 0.f;
#pragma unroll
    for (int j = 0; j < 8; ++j) { v[j] = ((const f32x4*)src)[j]; am = fmaxf(am, fmaxf(fmaxf(fabsf(v[j][0]), fabsf(v[j][1])), fmaxf(fabsf(v[j][2]), fabsf(v[j][3])))); }
    am = fmaxf(am, __shfl_xor(am, 1)); am = fmaxf(am, __shfl_xor(am, 2)); am = fmaxf(am, __shfl_xor(am, 4));
    const float sc = am > 0.f ? 127.0f / am : 0.f, inv = am * (1.0f / 127.0f);
#pragma unroll
    for (int i = 0; i < 4; ++i) { unsigned w[2];
#pragma unroll
        for (int h = 0; h < 2; ++h) { const f32x4 x = v[2 * i + h] * sc;
            w[h] = (unsigned)((int)rintf(x[0]) & 255) | ((unsigned)((int)rintf(x[1]) & 255) << 8) | ((unsigned)((int)rintf(x[2]) & 255) << 16) | ((unsigned)((int)rintf(x[3]) & 255) << 24); }
        *(LAS u32x2*)(lds + (cq * 4 + i) * 512 + row * 8) = (u32x2){w[0], w[1]}; }
    if (cq == 0) ((float*)(C.ws + WS_ESC))[(size_t)PNE * 16 + (size_t)r * PNE + eb * 64 + row] = inv;
    __syncthreads();
    unsigned char* dst = C.ws + WS_E8 + (size_t)tbl * (64 * MiB);
#pragma unroll
    for (int i = 0; i < 2; ++i) { const int p = tid + 512 * i, ls = p >> 5, off = (p & 31) * 16;
        *(u32x4*)(dst + ((size_t)(r * 32 + ls) * PNE + eb * 64) * 8 + off) = *(const LAS u32x4*)(lds + ls * 512 + off); }
    __syncthreads();
}
__device__ __forceinline__ void expert_convert_u(const Ctx& C, int e, int lane) {
    const f32x4* src = (const f32x4*)(C.eu + (size_t)e * D) + lane;
    f32x4 v[16]; float am = 0.f;
#pragma unroll
    for (int j = 0; j < 16; ++j) v[j] = src[j * 64];
#pragma unroll
    for (int j = 0; j < 16; ++j) am = fmaxf(am, fmaxf(fmaxf(fabsf(v[j][0]), fabsf(v[j][1])), fmaxf(fabsf(v[j][2]), fabsf(v[j][3]))));
    am = wave_max_nonneg(am);
    const float sc = am > 0.f ? 127.0f / am : 0.f;
    const int el = e >> 4, et = (e ^ (e >> 7)) & 15, sw = (el >> 1) & 7;
    unsigned char* dst = C.ws + WS_E8 + ((size_t)(et * 32 + (lane >> 5)) * 1024 + el) * 128 + (((((lane & 31) >> 2) ^ sw) << 4) | ((lane & 3) << 2));
#pragma unroll
    for (int j = 0; j < 16; ++j) { const f32x4 x = v[j] * sc;
        *(unsigned*)(dst + (size_t)j * 262144) = (unsigned)((int)rintf(x[0]) & 255) | ((unsigned)((int)rintf(x[1]) & 255) << 8) | ((unsigned)((int)rintf(x[2]) & 255) << 16) | ((unsigned)((int)rintf(x[3]) & 255) << 24); }
    if (lane == 0) ((float*)(C.ws + WS_ESC))[e] = am * (1.0f / 127.0f);
}
#define PEER_FILL(tblbase, slice) do { const unsigned char* g_ = (tblbase) + (size_t)(slice) * (PNE * 8) + lane * 16; \
    _Pragma("unroll") for (int i_ = 0; i_ < 16; ++i_) { const int c_ = wave * 16 + i_; \
        __builtin_amdgcn_global_load_lds((const unsigned*)(g_ + c_ * 1024), (LAS unsigned*)(lds + c_ * 1024), 16, 0, 0); } } while (0)
#define PEER_WARM(tblbase, slice) do { const unsigned char* g_ = (tblbase) + (size_t)(slice) * (PNE * 8) + lane * 16; \
    _Pragma("unroll") for (int i_ = 0; i_ < 16; ++i_) { const int c_ = wave * 16 + i_; \
        __builtin_amdgcn_global_load_lds((const unsigned*)(g_ + c_ * 1024), (LAS unsigned*)(lds + 131072 + wave * 1024), 16, 0, 0); } } while (0)
typedef int i32x4 __attribute__((ext_vector_type(4)));
constexpr int UNG = 12;
__device__ __forceinline__ void peer_u_item(const Ctx& C, int tg, int et, LAS unsigned char* lds, int tid, int wave, int lane) {
    const int* lidx = (const int*)(C.ws + WS_LIDX); const signed char* H8 = (const signed char*)(C.ws + WS_H8); float* S = (float*)(C.ws + WS_PART); const float* sh = (const float*)(C.ws + WS_SH);
    const unsigned char* U8M = C.ws + WS_E8;
    const int tokw = tg * 512 + wave * 64;
    LAS int* Wa = (LAS int*)(lds + wave * 16384); LAS int* Wcn = Wa + 1280; LAS int* Wt = Wa + 1344; LAS int* Wo = Wa + 2048;
    __syncthreads();
#pragma unroll
    for (int i = 0; i < 20; ++i) Wa[i * 64 + lane] = -1;
    Wcn[lane] = 0;
    LDS_WAIT();
#define UCOL(q_) (((q_) & 1) ? 4 + ((q_) >> 1) : ((((q_) >> 1) < 4) ? ((q_) >> 1) : ((q_) >> 1) + 8))
#define PU_SLOW(tokl_, k2_, el_) do { const int tok_ = tokw + (tokl_), sw_ = ((el_) >> 1) & 7; int dsum_ = 0; \
        const unsigned char* trow_ = U8M + ((size_t)(et * 32 + (lane >> 1)) * 1024 + (el_)) * 128; \
        _Pragma("unroll") for (int q_ = 0; q_ < 4; ++q_) { const i32x4 hv_ = *(const i32x4*)(H8 + (size_t)tok_ * D + lane * 64 + q_ * 16), tv_ = *(const i32x4*)(trow_ + ((((lane & 1) * 4 + q_) ^ sw_) << 4)); \
            dsum_ = __builtin_amdgcn_sdot4(hv_[0], tv_[0], dsum_, false); dsum_ = __builtin_amdgcn_sdot4(hv_[1], tv_[1], dsum_, false); dsum_ = __builtin_amdgcn_sdot4(hv_[2], tv_[2], dsum_, false); dsum_ = __builtin_amdgcn_sdot4(hv_[3], tv_[3], dsum_, false); } \
        _Pragma("unroll") for (int o_ = 32; o_ >= 1; o_ >>= 1) dsum_ += __shfl_xor(dsum_, o_); \
        if (lane == 0) S[(size_t)(k2_) * M + tok_] = (float)dsum_ * sh[tok_]; } while (0)
    const int sgl = lane >> 4, tl = lane & 15;
    {
      int oc = 0;
      unsigned loff = (unsigned)(tokw + lane) * 4u;
#pragma unroll 1
      for (int kb = 0; kb < 2; ++kb) { int ev[64];
#pragma unroll
          for (int j = 0; j < 64; ++j) { ev[j] = *(const int*)((const char*)lidx + loff); loff += (unsigned)M * 4u; asm volatile("" : "+v"(loff)); }
#pragma unroll
          for (int j0 = 0; j0 < 64; j0 += 8) { int rk[8]; int oc = 0;
#pragma unroll
              for (int i = 0; i < 8; ++i) { const int e = ev[j0 + i], q = (e >> 4) & 15; rk[i] = 0;
                  if (((e ^ (e >> 7)) & 15) == et) rk[i] = __hip_atomic_fetch_add(&Wcn[sgl * 16 + q], 1, __ATOMIC_RELAXED, __HIP_MEMORY_SCOPE_WORKGROUP); }
#pragma unroll
              for (int i = 0; i < 8; ++i) { const int e = ev[j0 + i], k = kb * 64 + j0 + i, el = e >> 4, q = el & 15; const bool match = ((e ^ (e >> 7)) & 15) == et;
                  if (match && rk[i] < 20) Wa[sgl * 320 + rk[i] * 16 + UCOL(q)] = el | (tl << 10) | (k << 14);
                  const bool ov = match && rk[i] >= 20;
                  const unsigned long long ovm = __builtin_amdgcn_ballot_w64(ov);
                  if (ov) Wo[oc + (int)__builtin_amdgcn_mbcnt_hi((unsigned)(ovm >> 32), __builtin_amdgcn_mbcnt_lo((unsigned)ovm, 0u))] = (lane << 17) | (k << 10) | el;
                  oc += __builtin_popcountll(ovm); }
              if (oc != 0) { LDS_WAIT();
#pragma unroll 1
                  for (int u = 0; u < oc; ++u) { const int ent = __builtin_amdgcn_readfirstlane(Wo[u]); PU_SLOW(ent >> 17, (ent >> 10) & 127, ent & 1023); } } } }
    }
    LDS_WAIT();
    int NGs;
    {
      const int cq = min(Wcn[lane], 20); int N = cq;
#pragma unroll
      for (int o = 1; o < 16; o <<= 1) N += __shfl_xor(N, o, 16);
      NGs = (N > 160) ? 12 : 10;
      const int exc = max(cq - NGs, 0), fre = max(NGs - cq, 0); int ie = exc, ifr = fre;
#pragma unroll
      for (int o = 1; o < 16; o <<= 1) { const int v0 = __shfl_up(ie, o, 16), v1 = __shfl_up(ifr, o, 16); if (tl >= o) { ie += v0; ifr += v1; } }
      const int E = __shfl(ie, 15, 16), F = __shfl(ifr, 15, 16), exoff = ie - exc, froff = ifr - fre, nq = UCOL(tl);
#pragma unroll
      for (int i = 0; i < 10; ++i) if (i < exc) Wt[sgl * 128 + exoff + i] = Wa[sgl * 320 + (NGs + i) * 16 + nq];
      LDS_WAIT();
#pragma unroll
      for (int j = 0; j < 12; ++j) if (j < fre && froff + j < E) Wa[sgl * 320 + (cq + j) * 16 + nq] = Wt[sgl * 128 + froff + j];
      LDS_WAIT();
#pragma unroll
      for (int s4 = 0; s4 < 4; ++s4) { const int Es = __builtin_amdgcn_readlane(E, s4 * 16), Fs = __builtin_amdgcn_readlane(F, s4 * 16);
#pragma unroll 1
          for (int i = Fs; i < Es; ++i) { const int ent = __builtin_amdgcn_readfirstlane(Wt[s4 * 128 + i]); PU_SLOW(s4 * 16 + ((ent >> 10) & 15), (ent >> 14) & 127, ent & 1023); } }
    }
#undef PU_SLOW
    const int n = lane & 15, g = lane >> 4;
    unsigned ci[4][UNG]; int acc[4][UNG]; int NP[4];
    { const int qn = (n >= 4 && n < 12) ? (n - 4) * 2 + 1 : ((n < 4) ? n : n - 8) * 2;
#pragma unroll
      for (int s4 = 0; s4 < 4; ++s4) { NP[s4] = __builtin_amdgcn_readlane(NGs, s4 * 16) >> 1;
#pragma unroll
        for (int m = 0; m < UNG; ++m) { const int raw = Wa[s4 * 320 + m * 16 + n]; const bool valid = raw >= 0;
            const int row = valid ? (raw & 1023) : qn, tl2 = valid ? ((raw >> 10) & 15) : 0, k = valid ? ((raw >> 14) & 127) : 0;
            ci[s4][m] = (unsigned)(row * 128 + ((g ^ ((row >> 1) & 7)) << 4)) | ((unsigned)k << 17) | ((unsigned)(tl2 >> 2) << 24) | ((unsigned)(valid ? 1 : 0) << 26) | ((unsigned)((tl2 >> 1) & 1) << 30) | ((unsigned)(tl2 & 1) << 31);
            acc[s4][m] = 0; } } }
#undef UCOL
    const char* H8c = (const char*)H8; const unsigned aoff = (unsigned)(tokw + n) * (unsigned)D + (unsigned)g * 16u;
    i32x4 a[4][2];
#define PU_ALOAD(s_, ks_) do { _Pragma("unroll") for (int h_ = 0; h_ < 2; ++h_) a[s_][h_] = *(const i32x4*)(H8c + (aoff + (unsigned)((ks_) * 128 + (s_) * 16 * D + h_ * 64))); } while (0)
#define PU_LOAD2(dst, s_, m_) do { const unsigned a0_ = ci[s_][m_] & 0x1ffffu, a1_ = ci[s_][(m_) + 1] & 0x1ffffu; \
        dst[0][0] = *(const LAS i32x4*)(lds + a0_); dst[1][0] = *(const LAS i32x4*)(lds + a1_); dst[0][1] = *(const LAS i32x4*)(lds + (a0_ ^ 64u)); dst[1][1] = *(const LAS i32x4*)(lds + (a1_ ^ 64u)); } while (0)
#define PU_SEL(d_, c_, ac_) do { const int m0_ = (int)(c_) >> 31, m1_ = __builtin_amdgcn_sbfe((int)(c_), 30u, 1u); \
        const int lo_ = (d_[1] & m0_) | (d_[0] & ~m0_), hi_ = (d_[3] & m0_) | (d_[2] & ~m0_); ac_ += (hi_ & m1_) | (lo_ & ~m1_); } while (0)
#define PU_PAIR(src, s_, m_) do { i32x4 d0_ = {0, 0, 0, 0}, d1_ = {0, 0, 0, 0}; \
        d0_ = __builtin_amdgcn_mfma_i32_16x16x64_i8(a[s_][0], src[0][0], d0_, 0, 0, 0); d1_ = __builtin_amdgcn_mfma_i32_16x16x64_i8(a[s_][0], src[1][0], d1_, 0, 0, 0); \
        d0_ = __builtin_amdgcn_mfma_i32_16x16x64_i8(a[s_][1], src[0][1], d0_, 0, 0, 0); d1_ = __builtin_amdgcn_mfma_i32_16x16x64_i8(a[s_][1], src[1][1], d1_, 0, 0, 0); \
        PU_SEL(d0_, ci[s_][m_], acc[s_][m_]); PU_SEL(d1_, ci[s_][(m_) + 1], acc[s_][(m_) + 1]); asm volatile("" : "+v"(acc[s_][m_]), "+v"(acc[s_][(m_) + 1])); } while (0)
#pragma unroll
    for (int s4 = 0; s4 < 4; ++s4) PU_ALOAD(s4, 0);
#pragma unroll 1
    for (int ks = 0; ks < 32; ++ks) {
        __syncthreads();
#pragma unroll
        for (int s4 = 0; s4 < 4; ++s4)
#pragma unroll
            for (int m = 0; m < UNG; ++m) asm volatile("" : "+v"(ci[s4][m]));
        PEER_FILL(U8M, et * 32 + ks);
        if (tg == (ks & 15) && ks + 1 < 32) PEER_WARM(U8M, et * 32 + ks + 1);
        VM_WAIT(); __syncthreads();
        {
          i32x4 bA[2][2], bB[2][2], bC[2][2];
          PU_LOAD2(bA, 0, 0); PU_LOAD2(bB, 0, 2); PU_LOAD2(bC, 0, 4);
#pragma unroll
          for (int blk = 0; blk < 24; ++blk) { const int s4 = blk / 6, p = blk % 6, nb = blk + 3, ns = nb / 6, np = nb % 6;
              if (blk % 3 == 0)      { if (p < 5 || NP[s4] > 5) PU_PAIR(bA, s4, 2 * p); if (nb < 24 && (np < 5 || NP[ns] > 5)) PU_LOAD2(bA, ns, 2 * np); }
              else if (blk % 3 == 1) { if (p < 5 || NP[s4] > 5) PU_PAIR(bB, s4, 2 * p); if (nb < 24 && (np < 5 || NP[ns] > 5)) PU_LOAD2(bB, ns, 2 * np); }
              else                   { if (p < 5 || NP[s4] > 5) PU_PAIR(bC, s4, 2 * p); if (nb < 24 && (np < 5 || NP[ns] > 5)) PU_LOAD2(bC, ns, 2 * np); }
              __builtin_amdgcn_sched_barrier(0);
              if (p == 5) { if (ks + 1 < 32) PU_ALOAD(s4, ks + 1);
                  __builtin_amdgcn_sched_barrier(0); } } }
    }
#undef PU_ALOAD
#undef PU_LOAD2
#undef PU_SEL
#undef PU_PAIR
#pragma unroll
    for (int s4 = 0; s4 < 4; ++s4)
#pragma unroll
        for (int m = 0; m < UNG; ++m) { if ((m >> 1) < NP[s4]) { const unsigned c = ci[s4][m];
            if (((c >> 26) & 1u) != 0u && (int)((c >> 24) & 3u) == g) { const int tok = tokw + s4 * 16 + g * 4 + (int)(c >> 31) + 2 * (int)((c >> 30) & 1u), k = (int)((c >> 17) & 127u);
                S[(size_t)k * M + tok] = (float)acc[s4][m] * sh[tok]; } } }
    __syncthreads();
}
__device__ __forceinline__ void peer_gates(const Ctx& C, int gt, int NGT) {
    const int* lidx = (const int*)(C.ws + WS_LIDX); const float* lg = (const float*)(C.ws + WS_LG); const float* part = (const float*)(C.ws + WS_PART);
    const float* usc = (const float*)(C.ws + WS_ESC); float* at = (float*)(C.ws + WS_AT);
#pragma unroll 4
    for (int idx = gt; idx < 128 * M; idx += NGT) { const int e = lidx[idx]; const float s = part[idx] * usc[e];
        at[idx] = 0.5f * s * (1.0f + erff(s * 0.70710678f)) * lg[idx]; }
}
__device__ __forceinline__ void peer_v_item(const Ctx& C, int tg, int r, LAS unsigned char* lds, int tid, int wave, int lane) {
    const int* lidx = (const int*)(C.ws + WS_LIDX); const float* at = (const float*)(C.ws + WS_AT); const unsigned char* vscr = (const unsigned char*)((const float*)(C.ws + WS_ESC) + (size_t)PNE * 16 + (size_t)r * PNE);
    const unsigned char* V8T = C.ws + WS_E8 + 64 * MiB; bf16* ft = (bf16*)(C.ws + WS_FT);
    const int t = tg * 512 + tid;
    unsigned ei[64], a8[32]; float os;
    { float af[128]; float am = 0.f;
      __syncthreads();
#pragma unroll
      for (int i = 0; i < 8; ++i) { const int c = wave * 8 + i; __builtin_amdgcn_global_load_lds((const unsigned*)(vscr + c * 1024 + lane * 16), (LAS unsigned*)(lds + c * 1024), 16, 0, 0); }
      VM_WAIT(); __syncthreads();
      unsigned loff = (unsigned)t * 4u;
#pragma unroll
      for (int j = 0; j < 64; ++j) { const unsigned e0 = *(const unsigned*)((const char*)lidx + loff), e1 = *(const unsigned*)((const char*)lidx + (loff + (unsigned)M * 4u)); ei[j] = e0 | (e1 << 16);
          af[2 * j] = *(const float*)((const char*)at + loff) * *(const LAS float*)(lds + e0 * 4u); af[2 * j + 1] = *(const float*)((const char*)at + (loff + (unsigned)M * 4u)) * *(const LAS float*)(lds + e1 * 4u);
          loff += 2u * M * 4u; asm volatile("" : "+v"(loff));
          if ((j & 7) == 7) __builtin_amdgcn_sched_barrier(0); }
#pragma unroll
      for (int k = 0; k < 128; ++k) am = fmaxf(am, fabsf(af[k]));
      const float q = am > 0.f ? 127.0f / am : 0.f; os = am * (1.0f / 127.0f);
#pragma unroll
      for (int j = 0; j < 32; ++j) a8[j] = (unsigned)((int)rintf(af[4 * j] * q) & 255) | ((unsigned)((int)rintf(af[4 * j + 1] * q) & 255) << 8) | ((unsigned)((int)rintf(af[4 * j + 2] * q) & 255) << 16) | ((unsigned)((int)rintf(af[4 * j + 3] * q) & 255) << 24); }
#pragma unroll 1
    for (int s = 0; s < 32; ++s) { const int slice = r * 32 + s;
        __syncthreads();
#pragma unroll
        for (int j = 0; j < 64; ++j) asm volatile("" : "+v"(ei[j]));
        PEER_FILL(V8T, slice);
        if (tg == (s & 15) && s + 1 < 32) PEER_WARM(V8T, slice + 1);
        VM_WAIT(); __syncthreads();
        int o[8];
#pragma unroll
        for (int i = 0; i < 8; ++i) o[i] = 0;
#define PV_LOAD(dst, k0) do { _Pragma("unroll") for (int j_ = 0; j_ < 8; ++j_) { const int k_ = (k0) + j_; const unsigned e_ = (k_ & 1) ? (ei[k_ >> 1] >> 16) : (ei[k_ >> 1] & 0xffffu); dst[j_] = *(const LAS u32x2*)(lds + e_ * 8); } } while (0)
#define PV_Q(w0, w1, w2, w3, ab, ob) do { const unsigned t0_ = __builtin_amdgcn_perm(w1, w0, 0x05010400u), t1_ = __builtin_amdgcn_perm(w1, w0, 0x07030602u), u0_ = __builtin_amdgcn_perm(w3, w2, 0x05010400u), u1_ = __builtin_amdgcn_perm(w3, w2, 0x07030602u); \
            o[ob] = __builtin_amdgcn_sdot4((int)__builtin_amdgcn_perm(u0_, t0_, 0x05040100u), ab, o[ob], false); o[ob + 1] = __builtin_amdgcn_sdot4((int)__builtin_amdgcn_perm(u0_, t0_, 0x07060302u), ab, o[ob + 1], false); \
            o[ob + 2] = __builtin_amdgcn_sdot4((int)__builtin_amdgcn_perm(u1_, t1_, 0x05040100u), ab, o[ob + 2], false); o[ob + 3] = __builtin_amdgcn_sdot4((int)__builtin_amdgcn_perm(u1_, t1_, 0x07060302u), ab, o[ob + 3], false); } while (0)
#define PV_DOT(src, k0) do { const int a0_ = (int)a8[(k0) >> 2], a1_ = (int)a8[((k0) >> 2) + 1]; \
            PV_Q(src[0].x, src[1].x, src[2].x, src[3].x, a0_, 0); PV_Q(src[0].y, src[1].y, src[2].y, src[3].y, a0_, 4); \
            PV_Q(src[4].x, src[5].x, src[6].x, src[7].x, a1_, 0); PV_Q(src[4].y, src[5].y, src[6].y, src[7].y, a1_, 4); } while (0)
        u32x2 wa[8], wb[8];
        PV_LOAD(wa, 0);
#pragma unroll
        for (int k16 = 0; k16 < 128; k16 += 16) {
            PV_LOAD(wb, k16 + 8); PV_DOT(wa, k16); __builtin_amdgcn_sched_barrier(0);
            if (k16 + 16 < 128) PV_LOAD(wa, k16 + 16);
            PV_DOT(wb, k16 + 8); __builtin_amdgcn_sched_barrier(0); }
#undef PV_LOAD
#undef PV_Q
#undef PV_DOT
        u32x4 ow; ow.x = pk2((float)o[0] * os, (float)o[1] * os); ow.y = pk2((float)o[2] * os, (float)o[3] * os); ow.z = pk2((float)o[4] * os, (float)o[5] * os); ow.w = pk2((float)o[6] * os, (float)o[7] * os);
        *(u32x4*)(ft + ((size_t)slice * M + t) * 8) = ow;
    }
    __syncthreads();
}
constexpr int FROWB = D * 2 + 16;
constexpr int FVEC = 8 * FROWB;
__device__ __forceinline__ void final_units(const Ctx& C, int u0, int ustep, LAS unsigned char* lds, int tid, int wave, int lane) {
#define FU_LBAR() do { asm volatile("s_waitcnt lgkmcnt(0)" ::: "memory"); __builtin_amdgcn_s_barrier(); asm volatile("" ::: "memory"); } while (0)
    const bf16* ft = (const bf16*)(C.ws + WS_FT); const bf16* MIX = (const bf16*)(C.ws + WS_Y);
    const float* mod = (const float*)(C.ws + WS_MOD); const float* modf = mod + 2 * 6 * D;
    u32x4 pf[8]; int bcur = -1;
#define FU_GATHER(unit_) do { int tidv_ = tid; asm volatile("" : "+v"(tidv_));   \
        _Pragma("unroll") for (int i = 0; i < 8; ++i) { const int p = i * 512 + tidv_, slice = p >> 3, q = p & 7;                      \
            pf[i] = *(const u32x4*)(ft + ((size_t)slice * M + (unit_) * 8 + q) * 8); } } while (0)
    __syncthreads();
    if (u0 < M / 8) FU_GATHER(u0);
    for (int unit = u0; unit < M / 8; unit += ustep) { const int t0 = unit * 8, b = t0 >> 12;
        if (b != bcur) { bcur = b;
            const float* v0 = mod + (size_t)b * 6 * D + 5 * D; const float* v1 = C.g_f; const float* v2 = modf + (size_t)b * 2 * D; const float* v3 = modf + (size_t)b * 2 * D + D;
#pragma unroll
            for (int i = 0; i < 2; ++i) { const int c4 = tid + 512 * i;
                *(LAS f32x4*)(lds + FVEC + c4 * 16) = ((const f32x4*)v0)[c4]; *(LAS f32x4*)(lds + FVEC + 16384 + c4 * 16) = ((const f32x4*)v1)[c4];
                *(LAS f32x4*)(lds + FVEC + 32768 + c4 * 16) = ((const f32x4*)v2)[c4]; *(LAS f32x4*)(lds + FVEC + 49152 + c4 * 16) = ((const f32x4*)v3)[c4]; } }
        { int tidv = tid; asm volatile("" : "+v"(tidv));
#pragma unroll
          for (int i = 0; i < 8; ++i) { const int p = i * 512 + tidv, slice = p >> 3, q = p & 7; *(LAS u32x4*)(lds + q * FROWB + slice * 16) = pf[i]; } }
        const int m = t0 + wave; f32x4 f[16]; u32x2 aw[16]; float ss = 0.f; int lanev = lane; asm volatile("" : "+v"(lanev));
        const char* mp = (const char*)(MIX + (size_t)m * D); char* op = (char*)(C.out + (size_t)m * D);
#pragma unroll
        for (int j = 0; j < 16; ++j) { const unsigned cb = (unsigned)(64 * j + lanev) * 8u; aw[j] = *(const u32x2*)(mp + cb); }
        FU_LBAR();
        if (unit + ustep < M / 8) FU_GATHER(unit + ustep);
        asm volatile("" : "+v"(lanev));
#pragma unroll
        for (int j = 0; j < 16; ++j) { const unsigned cb = (unsigned)(64 * j + lanev) * 16u;
            const f32x4 gtv = *(const LAS f32x4*)(lds + FVEC + cb); const u32x2 fw = *(const LAS u32x2*)(lds + wave * FROWB + (cb >> 1));
            const f32x4 fv = {bf2f(fw.x & 0xffffu), bf2f(fw.x >> 16), bf2f(fw.y & 0xffffu), bf2f(fw.y >> 16)};
            f[j] = (f32x4){bf2f(aw[j].x & 0xffffu), bf2f(aw[j].x >> 16), bf2f(aw[j].y & 0xffffu), bf2f(aw[j].y >> 16)} + gtv * fv;
            ss += (f[j][0] * f[j][0] + f[j][1] * f[j][1]) + (f[j][2] * f[j][2] + f[j][3] * f[j][3]); if ((j & 3) == 3) __builtin_amdgcn_sched_barrier(0); }
        const float rs = rsqrtf(wave_sum(ss) * (1.0f / D) + EPS);
#pragma unroll
        for (int j = 0; j < 16; ++j) { const unsigned cb = (unsigned)(64 * j + lanev) * 16u;
            const f32x4 gg = *(const LAS f32x4*)(lds + FVEC + 16384 + cb), sh = *(const LAS f32x4*)(lds + FVEC + 32768 + cb), sc = *(const LAS f32x4*)(lds + FVEC + 49152 + cb);
            *(f32x4*)(op + cb) = f[j] * rs * gg * (sc + 1.0f) + sh; if ((j & 3) == 3) __builtin_amdgcn_sched_barrier(0); }
        FU_LBAR();
    }
    __syncthreads();
#undef FU_GATHER
#undef FU_LBAR
}

constexpr int NPHASE = 14;
struct Args { const void* in[25]; float* out; unsigned char* ws; int ph_lo, ph_hi; };
__global__ void __launch_bounds__(NTHR, 2) fwd(Args args) {
    extern __shared__ __attribute__((aligned(16))) unsigned char lds_raw[];
    LAS unsigned char* lds = (LAS unsigned char*)lds_raw;
    int tid = threadIdx.x, lane = tid & 63; const int wave = __builtin_amdgcn_readfirstlane(tid >> 6);
#define REFRESH_IDS() do { lane = (int)__builtin_amdgcn_mbcnt_hi(~0u, __builtin_amdgcn_mbcnt_lo(~0u, 0u)); tid = wave * 64 + lane; } while (0)
    const int G = gridDim.x, bx = blockIdx.x, vcu = (G % 8 == 0) ? (bx % 8) * (G / 8) + bx / 8 : bx;
    const int gw = vcu * NWAVES + wave, NGW = G * NWAVES;
    Ctx C;
    C.x = (const float*)args.in[0]; C.c = (const float*)args.in[1]; C.pos = (const int*)args.in[2]; C.w_ada = (const float*)args.in[3]; C.b_ada = (const float*)args.in[4];
    C.g_mix = (const float*)args.in[5]; C.w_in = (const float*)args.in[6]; C.g_q = (const float*)args.in[7]; C.w_uq = (const float*)args.in[8]; C.g_kv = (const float*)args.in[9];
    C.w_ukv = (const float*)args.in[10]; C.g_sgu = (const float*)args.in[11]; C.w_sgu = (const float*)args.in[12]; C.b_sgu = (const float*)args.in[13]; C.beta_mla = (const float*)args.in[14];
    C.beta_g = (const float*)args.in[15]; C.w_out = (const float*)args.in[16]; C.g_ffn = (const float*)args.in[17]; C.w_pq = (const float*)args.in[18]; C.pkeys = (const float*)args.in[19];
    C.eu = (const float*)args.in[20]; C.ev = (const float*)args.in[21]; C.w_adaf = (const float*)args.in[22]; C.b_adaf = (const float*)args.in[23]; C.g_f = (const float*)args.in[24];
    C.out = args.out; C.ws = args.ws;
    unsigned* ctl = (unsigned*)(C.ws + WS_CTL);
    float* mod = (float*)(C.ws + WS_MOD);
    for (int u = tid; u < (LDS_BYTES - LDSCTL_OFF) / 4; u += NTHR) ((LAS unsigned*)(lds + LDSCTL_OFF))[u] = 0u;
    __syncthreads();
    const int lo = args.ph_lo, hi = args.ph_hi;
    XcdBarrier bar; bar.bar = ctl + CW_BAR; bar.x = 0; bar.st = (volatile LAS unsigned*)(lds + LDSCTL_OFF + 64);
    if (hi - lo > 1) bar = xcd_barrier_post(ctl + CW_BAR, (volatile LAS unsigned*)(lds + LDSCTL_OFF + 64));
#define IN(k) (lo <= (k) && (k) < hi)
#define SEAM(k) do { if (IN(k) && IN((k) + 1)) xcd_barrier(bar); } while (0)

    if (IN(0)) { REFRESH_IDS();
        for (int u = vcu; u < 256; u += G) ada_unit(C, u, (LAS float*)lds, tid, wave, lane);
        LAS float* scr = (LAS float*)(lds + wave * 16384);
        constexpr int I1 = (D / 64) * (INWP / 32), I2 = (QLR / 64) * (NH * QKD / 32), I3 = (KVLR / 64) * (NH * 256 / 32), I4 = (D / 64) * (D / 32), I5 = (D / 64) * (PQW / 32);
        constexpr float QSCALE = 1.4426950408889634f * 0.07216878364870322f;
        for (int it = gw; it < I1 + I2 + I3 + I4 + I5; it += NGW) {
            int q = it;
            if (q < I1) { transpose_item<MAP_W1>(C.w_in, D, INW, INWP, (bf16*)(C.ws + WS_W1T), nullptr, 1.0f, scr, q, lane); continue; } q -= I1;
            if (q < I2) { transpose_item<MAP_UQ>(C.w_uq, QLR, NH * QKD, NH * QKD, (bf16*)(C.ws + WS_WUQT), C.g_q, QSCALE, scr, q, lane); continue; } q -= I2;
            if (q < I3) { transpose_item<MAP_ID>(C.w_ukv, KVLR, NH * 256, NH * 256, (bf16*)(C.ws + WS_WUKVT), C.g_kv, 1.0f, scr, q, lane); continue; } q -= I3;
            if (q < I4) { const int kb = q / (D / 32); const float* ks = (kb < 32) ? C.beta_mla : C.beta_g - GW;
                          transpose_item<MAP_ID>(C.w_out, D, D, D, (bf16*)(C.ws + WS_WOUTT), ks, 1.0f, scr, q, lane); continue; } q -= I4;
            transpose_item<MAP_ID>(C.w_pq, D, PQW, PQW, (bf16*)(C.ws + WS_WPQT), nullptr, 1.0f, scr, q, lane);
        }
        const int gt = vcu * NTHR + tid, NGT = G * NTHR;
        { bf16* kd = (bf16*)(C.ws + WS_KEYS); for (int i = gt; i < PH * 2 * PNK * PHALF; i += NGT) kd[i] = (bf16)f2bf(C.pkeys[i]); }
        { bf16* wd = (bf16*)(C.ws + WS_WSGU); for (int i = gt; i < GH * GC * GC; i += NGT) { const int s = i & 127, t = (i >> 7) & 127; wd[i] = (bf16)(s <= t ? f2bf(C.w_sgu[i]) : 0u); } }
        { float* rp = (float*)(C.ws + WS_ROPE); for (int i = gt; i < M * 32; i += NGT) { const int j = i & 31, tok = i >> 5;
            const float invf = (float)exp(-(double)(2 * j) / 64.0 * 9.210340371976184); const float ang = (float)C.pos[tok] * invf;
            rp[2 * i] = (float)cos((double)ang); rp[2 * i + 1] = (float)sin((double)ang); } }
        __syncthreads();
        for (int e = gw; e < PNE; e += NGW) expert_convert_u(C, e, lane);
        for (int u = vcu; u < 4096; u += G) expert_convert_unit(C, 4096 + u, lds, tid);
    }
    SEAM(0);
    if (IN(1)) { REFRESH_IDS(); norm_mod_rows<false>(C.x, nullptr, C.g_mix, mod, mod + D, (bf16*)(C.ws + WS_H), nullptr, nullptr, nullptr, gw, NGW, lane); }
    SEAM(1);
    if (IN(2)) { REFRESH_IDS();
        pg8::Gemm g{(const bf16*)(C.ws + WS_H), (const bf16*)(C.ws + WS_W1T), M, INWP, D, D, D}; pg8::StaticOrder S; S.init(M, INWP, G, bx);
        EpiZ E{(bf16*)(C.ws + WS_QLAT), (bf16*)(C.ws + WS_KVLAT), (bf16*)(C.ws + WS_KPE), (bf16*)(C.ws + WS_U), (bf16*)(C.ws + WS_VT),
               (float*)(C.ws + WS_STQ), (float*)(C.ws + WS_STKV), (float*)(C.ws + WS_STVS), (float*)(C.ws + WS_STVQ), (const float*)(C.ws + WS_ROPE)};
        pg8::gemm_phase<EpiZ>(lds, g, S, E);
    }
    SEAM(2);
    if (IN(3)) { REFRESH_IDS();
        { pg8::Gemm g{(const bf16*)(C.ws + WS_QLAT), (const bf16*)(C.ws + WS_WUQT), M, NH * QKD, QLR, QLR, QLR}; pg8::StaticOrder S; S.init(M, NH * QKD, G, bx);
          EpiQ E{(bf16*)(C.ws + WS_Q), (const float*)(C.ws + WS_STQ), (const float*)(C.ws + WS_ROPE)};
          pg8::gemm_phase<EpiQ>(lds, g, S, E); }
        { pg8::Gemm g{(const bf16*)(C.ws + WS_KVLAT), (const bf16*)(C.ws + WS_WUKVT), M, NH * 256, KVLR, KVLR, KVLR}; pg8::StaticOrder S; S.init(M, NH * 256, G, bx);
          EpiKV E{(bf16*)(C.ws + WS_KN), (bf16*)(C.ws + WS_VTA), (const float*)(C.ws + WS_STKV)};
          pg8::gemm_phase<EpiKV>(lds, g, S, E); }
        { const int heavy = (G == 256 && bx < 128), lite = (G == 256 && bx >= 128);
          int u = heavy ? bx * 3 : (lite ? 384 + (bx - 128) * 5 : vcu); const int ustep = (G == 256) ? 1 : G, uend = heavy ? bx * 3 + 3 : (lite ? 384 + (bx - 128) * 5 + 5 : NB * 32 * GH);
          sgu_units(C, u, uend, ustep, lds, tid, wave, lane); }
    }
    SEAM(3);
    if (IN(4)) { REFRESH_IDS();
        if (wave >= 4) __builtin_amdgcn_s_setprio(1);
        for (int it = vcu; it < 256; it += G) { const int bh = it >> 3, x = it & 7;
            attn_block(C, bh >> 4, bh & 15, 15 - x, lds, tid, wave, lane);
            attn_block(C, bh >> 4, bh & 15, x, lds, tid, wave, lane); }
        __builtin_amdgcn_s_setprio(0);
    }
    SEAM(4);
    if (IN(6)) { REFRESH_IDS();
        pg8::Gemm g{(const bf16*)(C.ws + WS_Y), (const bf16*)(C.ws + WS_WOUTT), M, D, D, D, D}; pg8::StaticOrder S; S.init(M, D, G, bx);
        LAS f32x2* rsl = (LAS f32x2*)(lds + RING_BYTES);
        pg8::Unit u0, u1; const bool h0 = S.next(0, u0), h1 = S.next(1, u1);
        { const int slot = tid >> 8, pm = slot ? (h1 ? u1.pm : u0.pm) : u0.pm, row = pm * 256 + (tid & 255);
          if (h0) { const float* stm = (const float*)(C.ws + WS_STM); const float* stg = (const float*)(C.ws + WS_STG);
              const float sm = sum_parts(stm + (size_t)row * 16, 4) * (1.0f / GW) + EPS, sg = sum_parts(stg + (size_t)row * 16, 4) * (1.0f / GW) + EPS;
              rsl[slot * 256 + (tid & 255)] = (f32x2){rsqrtf(sm) * sqrtf(sg), rsqrtf(sg)}; } }
        __syncthreads();
        EpiX1 E{mod, (bf16*)(C.ws + WS_X1), rsl, u0.pm};
        pg8::gemm_phase<EpiX1>(lds, g, S, E);
    }
    SEAM(6);
    if (IN(7)) { REFRESH_IDS(); norm_mod_rows<true>(C.x, (const bf16*)(C.ws + WS_X1), C.g_ffn, mod + 3 * D, mod + 4 * D, (bf16*)(C.ws + WS_H), (signed char*)(C.ws + WS_H8), (float*)(C.ws + WS_SH), (bf16*)(C.ws + WS_Y), gw, NGW, lane); }
    SEAM(7);
    if (IN(8)) { REFRESH_IDS();
        pg8::Gemm g{(const bf16*)(C.ws + WS_H), (const bf16*)(C.ws + WS_WPQT), M, PQW, D, D, D}; pg8::StaticOrder S; S.init(M, PQW, G, bx);
        EpiQP E{(bf16*)(C.ws + WS_QP)};
        pg8::gemm_phase<EpiQP>(lds, g, S, E);
    }
    SEAM(8);
    if (IN(9)) { REFRESH_IDS(); for (int tb = vcu; tb < M / 32; tb += G) {
            topk_item(C, tb * 8 + wave, (LAS float*)(lds + wave * 12288), (LAS int*)(lds + 98304), (LAS float*)(lds + 98304 + 16384), lane);
            __syncthreads(); { int tidv = tid; asm volatile("" : "+v"(tidv)); order_pairs(C, tb, lds, tidv); } __syncthreads(); } }
    SEAM(9);
    if (IN(10)) { REFRESH_IDS(); for (int it = vcu; it < 256; it += G) peer_u_item(C, it & 15, it >> 4, lds, tid, wave, lane); }
    SEAM(10);
    if (IN(11)) { REFRESH_IDS(); peer_gates(C, vcu * NTHR + tid, G * NTHR); }
    SEAM(11);
    if (IN(12)) { REFRESH_IDS(); for (int it = vcu; it < 256; it += G) peer_v_item(C, it & 15, it >> 4, lds, tid, wave, lane); }
    SEAM(12);
    if (IN(13)) { REFRESH_IDS(); final_units(C, vcu, G, lds, tid, wave, lane); }
#undef IN
#undef SEAM
#undef REFRESH_IDS
}

extern "C" void kernel_launch(void* const* d_in, const int* in_sizes, int n_in, void* d_out, int out_size, void* d_ws, size_t ws_size, hipStream_t stream) {
    static int grid = 0;
    if (grid == 0) {
        if (n_in != 25 || out_size != M * D || ws_size < WS_END) { fprintf(stderr, "kernel_launch: unexpected problem (n_in %d, out %d, ws %zu)\n", n_in, out_size, ws_size); grid = -1; return; }
        int dev = 0, cus = 0, per_cu = 0;
        if (hipGetDevice(&dev) != hipSuccess || hipDeviceGetAttribute(&cus, hipDeviceAttributeMultiprocessorCount, dev) != hipSuccess) { grid = -1; return; }
        if (hipFuncSetAttribute((const void*)fwd, hipFuncAttributeMaxDynamicSharedMemorySize, LDS_BYTES) != hipSuccess) { fprintf(stderr, "kernel_launch: hipFuncSetAttribute failed\n"); grid = -1; return; }
        if (hipOccupancyMaxActiveBlocksPerMultiprocessor(&per_cu, (const void*)fwd, NTHR, LDS_BYTES) != hipSuccess || per_cu < 1) { fprintf(stderr, "kernel_launch: occupancy query says %d blocks per CU\n", per_cu); }
        (void)hipGetLastError();
        grid = cus;
    }
    if (grid < 0) return;
    if (hipMemsetAsync((char*)d_ws + WS_CTL, 0, CTL_ZERO_BYTES, stream) != hipSuccess) return;
    Args a{};
    for (int i = 0; i < 25; ++i) a.in[i] = d_in[i];
    a.out = (float*)d_out; a.ws = (unsigned char*)d_ws;
#if MK_ONE_LAUNCH
    a.ph_lo = 0; a.ph_hi = NPHASE;
    hipLaunchKernelGGL(fwd, dim3(grid), dim3(NTHR), LDS_BYTES, stream, a);
#else
    for (int p = 0; p < NPHASE; ++p) { a.ph_lo = p; a.ph_hi = p + 1; hipLaunchKernelGGL(fwd, dim3(grid), dim3(NTHR), LDS_BYTES, stream, a); }
#endif
    const hipError_t le = hipPeekAtLastError();
    if (le != hipSuccess) fprintf(stderr, "kernel_launch: launch failed: %s\n", hipGetErrorName(le));
}
```

```cpp
#include <hip/hip_runtime.h>
#include <cstdio>
#include <cstdint>

#ifndef MK_ONE_LAUNCH
#define MK_ONE_LAUNCH 1
#endif

#define LAS __attribute__((address_space(3)))
#define GAS __attribute__((address_space(1)))
typedef unsigned short bf16;
typedef short bf16x8 __attribute__((ext_vector_type(8)));
typedef float f32x4 __attribute__((ext_vector_type(4)));
typedef float f32x2 __attribute__((ext_vector_type(2)));
typedef float f32x16 __attribute__((ext_vector_type(16)));
typedef unsigned u32x4 __attribute__((ext_vector_type(4)));
typedef unsigned u32x2 __attribute__((ext_vector_type(2)));

constexpr int D = 4096, SEQ = 4096, NB = 2, M = NB * SEQ;
constexpr int QLR = 1024, KVLR = 512, ROPE = 64, NOPE = 128, QKD = 192, VD = 128, NH = 16;
constexpr int GW = 2048, GH = 16, GC = 128;
constexpr int INW = QLR + KVLR + ROPE + 2 * GW;
constexpr int INWP = 5888;
constexpr int PH = 8, PNK = 128, PQD = 256, PHALF = 128, PK = 16, PNE = PNK * PNK;
constexpr int PQW = PH * PQD;
constexpr float EPS = 1e-6f;
constexpr int NWAVES = 8, NTHR = 512;

constexpr size_t MiB = 1u << 20;
constexpr size_t WS_CTL = 0, CTL_ZERO_BYTES = 1 * MiB;
constexpr size_t WS_MOD = 1 * MiB;
constexpr size_t WS_ROPE = 2 * MiB;
constexpr size_t WS_KEYS = 4 * MiB;
constexpr size_t WS_WSGU = 5 * MiB;
constexpr size_t WS_STQ = 6 * MiB;
constexpr size_t WS_STKV = 7 * MiB;
constexpr size_t WS_STVS = 8 * MiB;
constexpr size_t WS_STVQ = 9 * MiB;
constexpr size_t WS_STM = 10 * MiB;
constexpr size_t WS_STG = 11 * MiB;
constexpr size_t WS_LIDX = 13 * MiB;
constexpr size_t WS_LG = 17 * MiB;
constexpr size_t WS_NA = 21 * MiB;
constexpr size_t WS_W1T = 32 * MiB;
constexpr size_t WS_WUQT = 80 * MiB;
constexpr size_t WS_WUKVT = 88 * MiB;
constexpr size_t WS_WOUTT = 96 * MiB;
constexpr size_t WS_WPQT = 128 * MiB;
constexpr size_t WS_H = 160 * MiB;
constexpr size_t WS_QLAT = 224 * MiB;
constexpr size_t WS_KVLAT = 240 * MiB;
constexpr size_t WS_KPE = 248 * MiB;
constexpr size_t WS_U = 256 * MiB;
constexpr size_t WS_VT = 288 * MiB;
constexpr size_t WS_Q = 320 * MiB;
constexpr size_t WS_KN = 368 * MiB;
constexpr size_t WS_VTA = 400 * MiB;
constexpr size_t WS_Y = 432 * MiB;
constexpr size_t WS_X1 = 496 * MiB;
constexpr size_t WS_QP = 624 * MiB;
constexpr size_t WS_E8 = 704 * MiB;
constexpr size_t WS_ESC = 832 * MiB;
constexpr size_t WS_PART = 840 * MiB;
constexpr size_t WS_ATR = 844 * MiB;
constexpr size_t WS_AT = 904 * MiB;
constexpr size_t WS_FT = 912 * MiB;
constexpr size_t WS_H8 = 1040 * MiB;
constexpr size_t WS_SH = 1072 * MiB;
constexpr size_t WS_END = 1073 * MiB;
constexpr int CW_BAR = 4096;

constexpr int RING_BYTES = 131072;
constexpr int LDS_BYTES = 147456;
constexpr int LDSCTL_OFF = LDS_BYTES - 1024;

#define RLX_AGENT __ATOMIC_RELAXED, __HIP_MEMORY_SCOPE_AGENT
#define LDS_WAIT() asm volatile("s_waitcnt lgkmcnt(0)" ::: "memory")
#define LDS_BARRIER() do { asm volatile("s_waitcnt lgkmcnt(0)" ::: "memory"); __builtin_amdgcn_s_barrier(); asm volatile("" ::: "memory"); } while (0)
#define VM_WAIT() asm volatile("s_waitcnt vmcnt(0)" ::: "memory")

__device__ __forceinline__ unsigned f2bf(float f) { unsigned u = __builtin_bit_cast(unsigned, f); return (u + 0x7fffu + ((u >> 16) & 1u)) >> 16; }
__device__ __forceinline__ unsigned pk2(float lo, float hi) { unsigned r; asm("v_cvt_pk_bf16_f32 %0, %1, %2" : "=v"(r) : "v"(lo), "v"(hi)); return r; }
__device__ __forceinline__ float bf2f(unsigned b) { return __builtin_bit_cast(float, b << 16); }
__device__ __forceinline__ float wave_sum(float v) {
    v += __builtin_bit_cast(float, __builtin_amdgcn_update_dpp(0, __builtin_bit_cast(int, v), 0xB1, 0xF, 0xF, true));
    v += __builtin_bit_cast(float, __builtin_amdgcn_update_dpp(0, __builtin_bit_cast(int, v), 0x4E, 0xF, 0xF, true));
    v += __builtin_bit_cast(float, __builtin_amdgcn_update_dpp(0, __builtin_bit_cast(int, v), 0x141, 0xF, 0xF, true));
    v += __builtin_bit_cast(float, __builtin_amdgcn_update_dpp(0, __builtin_bit_cast(int, v), 0x140, 0xF, 0xF, true));
    v += __builtin_bit_cast(float, __builtin_amdgcn_update_dpp(0, __builtin_bit_cast(int, v), 0x142, 0xA, 0xF, true));
    v += __builtin_bit_cast(float, __builtin_amdgcn_update_dpp(0, __builtin_bit_cast(int, v), 0x143, 0xC, 0xF, true));
    return __builtin_bit_cast(float, __builtin_amdgcn_readlane(__builtin_bit_cast(int, v), 63));
}
__device__ __forceinline__ float gelu_f(float v) {
    const float av = fabsf(v), t = __builtin_amdgcn_rcpf(av * 0.2316418882f + 1.0f);
    float q = t * 0.5307027145f + (-0.7265760135f); q = q * t + 0.7107068705f; q = q * t + (-0.142248368f); q = q * t + 0.127414796f; q = q * t;
    const float e = __builtin_amdgcn_exp2f((v * v) * (-0.72134752044f));
    const float m = v * (q * e);
    return v < 0.f ? m : v - m;
}

#define XB_TMO      128
#define XB_XCNT(j)  (256  + 64 * (j))
#define XB_XSUB(j)  (1280 + 64 * (j))
#define XB_XGEN(j)  (2304 + 64 * (j))
#define XB_TOP      3328
#define XB_TOPGEN   3392
#define XCD_BAR_WORDS 3456
#define XB_SPIN_CAP (1u << 20)

__device__ __forceinline__ unsigned xb_ld(unsigned* p)              { return __hip_atomic_load(p, __ATOMIC_RELAXED, __HIP_MEMORY_SCOPE_AGENT); }
__device__ __forceinline__ unsigned xb_add(unsigned* p, unsigned v) { return __hip_atomic_fetch_add(p, v, __ATOMIC_RELAXED, __HIP_MEMORY_SCOPE_AGENT); }
__device__ __forceinline__ unsigned xb_xcc_id() { return (unsigned)__builtin_amdgcn_s_getreg((3 << 11) | 20) & 0xFu; }
#define XB_SPIN(cond, bar) do { unsigned _sp = 0; while (cond) { __builtin_amdgcn_s_sleep(1); \
    if ((++_sp & 255u) == 0u) { if (xb_ld(&(bar)[XB_TMO])) break; if (_sp > XB_SPIN_CAP) { atomicAdd(&(bar)[XB_TMO], 1u); break; } } } } while (0)

struct XcdBarrier { unsigned* bar; unsigned x; volatile LAS unsigned* st; };

__device__ __forceinline__ XcdBarrier xcd_barrier_post(unsigned* bar, volatile LAS unsigned* st) {
    XcdBarrier b; b.bar = bar; b.x = xb_xcc_id(); b.st = st;
    if (threadIdx.x == 0) (void)xb_add(&bar[XB_XCNT(b.x)], 1u);
    return b;
}
__device__ __forceinline__ void xcd_barrier_complete(unsigned* bar, unsigned x, unsigned& nloc, unsigned& nx) {
    const unsigned G = gridDim.x * gridDim.y * gridDim.z;
    unsigned sum, cnt, mine, sp = 0u;
    for (;;) {
        sum = 0u; cnt = 0u; mine = 0u;
#pragma unroll
        for (unsigned j = 0; j < 16; ++j) { const unsigned c = xb_ld(&bar[XB_XCNT(j)]); sum += c; cnt += (c > 0u) ? 1u : 0u; mine = (j == x) ? c : mine; }
        if (sum == G) break;
        __builtin_amdgcn_s_sleep(1);
        if ((++sp & 255u) == 0u) { if (xb_ld(&bar[XB_TMO])) break; if (sp > XB_SPIN_CAP) { atomicAdd(&bar[XB_TMO], 1u); break; } }
    }
    nloc = mine > 0u ? mine : 1u; nx = cnt > 0u ? cnt : 1u;
}
__device__ __forceinline__ void xcd_barrier(const XcdBarrier& b) {
    asm volatile("s_waitcnt vmcnt(0)" ::: "memory");
    __syncthreads();
    if (threadIdx.x == 0) {
        unsigned* bar = b.bar;
        __builtin_amdgcn_s_waitcnt(0);
        unsigned nloc = b.st[0], nx = b.st[1];
        if (nloc == 0u) { xcd_barrier_complete(bar, b.x, nloc, nx); b.st[0] = nloc; b.st[1] = nx; }
        const unsigned old = xb_add(&bar[XB_XSUB(b.x)], 1u);
        const unsigned gen = old / nloc;
        if (old + 1u == (gen + 1u) * nloc) {
            __builtin_amdgcn_fence(__ATOMIC_RELEASE, "agent");
            asm volatile("s_waitcnt vmcnt(0)" ::: "memory");
            const unsigned og = xb_add(&bar[XB_TOP], 1u);
            const unsigned tg = og / nx;
            if (og + 1u == (tg + 1u) * nx) xb_add(&bar[XB_TOPGEN], 1u);
            else XB_SPIN(xb_ld(&bar[XB_TOPGEN]) == tg, bar);
            __builtin_amdgcn_fence(__ATOMIC_ACQUIRE, "agent");
            xb_add(&bar[XB_XGEN(b.x)], 1u);
            asm volatile("s_waitcnt vmcnt(0)" ::: "memory");
        } else {
            XB_SPIN(xb_ld(&bar[XB_XGEN(b.x)]) == gen, bar);
            __builtin_amdgcn_fence(__ATOMIC_ACQUIRE, "agent");
            asm volatile("s_waitcnt vmcnt(0)" ::: "memory");
        }
    }
    __syncthreads();
}

namespace pg8 {
constexpr int BM = 256, BK = 64, HALF = 128, HTB = HALF * BK * 2, STAGE_BYTES = 8 * HTB, NXCD = 8, WGM = 8;
__host__ __device__ __forceinline__ int lds_byte(int r, int c) { const int st = (r >> 4) * 2 + (c >> 5), rr = r & 15, cc = c & 31, ob = rr * 64 + cc * 2; return st * 1024 + (ob ^ (((ob >> 9) & 1) << 5)); }
__host__ __device__ __forceinline__ void stage_rc(int b, int& R, int& C) { const int st = b / 1024, sb = b % 1024, swz = sb ^ (((sb >> 9) & 1) << 5); R = (st >> 1) * 16 + swz / 64; C = (st & 1) * 32 + (swz % 64) / 2; }
struct Unit { int pm, pn; };
struct Gemm { const bf16* A; const bf16* Bt; int M, N, K, lda, ldb; };
struct StaticOrder {
    int nM, nN, nwg, G, c;
    __device__ __forceinline__ void init(int M_, int N_, int G_, int c_) { nM = M_ / BM; nN = N_ / BM; nwg = nM * nN; G = G_; c = c_; }
    __device__ __forceinline__ bool next(int i, Unit& u) const {
        const long L = (long)i * G + c; if (L >= nwg) return false;
        int wgid = (int)L; { const int q = nwg / NXCD, r = nwg % NXCD, xcd = wgid % NXCD, off = wgid / NXCD; wgid = (xcd < r ? xcd * (q + 1) : r * (q + 1) + (xcd - r) * q) + off; }
        const int nig = WGM * nN, gid = wgid / nig, fm = gid * WGM, gsz = (nM - fm) < WGM ? (nM - fm) : WGM;
        u.pm = fm + ((wgid % nig) % gsz); u.pn = (wgid % nig) / gsz; return true;
    }
};
template <class Epi>
__device__ __forceinline__ void gemm_phase(LAS unsigned char* lds, const Gemm g, const StaticOrder& S, const Epi& E) {
    const int tid = threadIdx.x, wid = __builtin_amdgcn_readfirstlane(tid >> 6), lane = tid & 63, wr = wid >> 2, wc = wid & 3, fr = lane & 15, fq = lane >> 4;
    const int K = g.K, nt = K / BK;
    unsigned voffA[2], voffB[2];
#pragma unroll
    for (int i = 0; i < 2; ++i) { int R, C; stage_rc(tid * 16 + i * 8192, R, C);
        voffA[i] = (unsigned)(R * g.lda + C) * 2u; voffB[i] = (unsigned)(R * g.ldb + C) * 2u; }
    const size_t kstep = (size_t)(BK * 2);
    const size_t hstepA = (size_t)HALF * g.lda * 2, hstepB = (size_t)HALF * g.ldb * 2;
    const size_t tstepA = 2 * hstepA, tstepB = 2 * hstepB;
    const unsigned ldsw = (unsigned)wid * 1024u;
    const int aoff = lds_byte(wr * 64 + fr, fq * 8), boff = lds_byte(wc * 32 + fr, fq * 8);
#define PG8_SA(b, h) (((b) * 2 + (h)) * HTB)
#define PG8_SB(b, h) ((4 + (b) * 2 + (h)) * HTB)
#define PG8_STAGE(bufoff, gbase, voff) do { _Pragma("unroll") for (int _i = 0; _i < 2; ++_i) \
        __builtin_amdgcn_global_load_lds((const unsigned*)((const char*)(gbase) + (voff)[_i]), (LAS unsigned*)(lds + (bufoff) + ldsw + _i * 8192), 16, 0, 0); } while (0)
#define PG8_LDA(dst, b, h) do { _Pragma("unroll") for (int m = 0; m < 4; ++m) _Pragma("unroll") for (int k = 0; k < 2; ++k) dst[m][k] = *(const LAS bf16x8*)(lds + PG8_SA(b, h) + aoff + m * 2048 + k * 1024); } while (0)
#define PG8_LDB(dst, b, h) do { _Pragma("unroll") for (int n = 0; n < 2; ++n) _Pragma("unroll") for (int k = 0; k < 2; ++k) dst[n][k] = *(const LAS bf16x8*)(lds + PG8_SB(b, h) + boff + n * 2048 + k * 1024); } while (0)
#define PG8_MMA(ai, bj, At, Bt) do { __builtin_amdgcn_s_setprio(1); _Pragma("unroll") for (int m = 0; m < 4; ++m) _Pragma("unroll") for (int n = 0; n < 2; ++n) _Pragma("unroll") for (int k = 0; k < 2; ++k) \
        acc[ai][bj][m][n] = __builtin_amdgcn_mfma_f32_16x16x32_bf16(Bt[n][k], At[m][k], acc[ai][bj][m][n], 0, 0, 0); __builtin_amdgcn_s_setprio(0); } while (0)
#define PG8_WAIT_V(n) asm volatile("s_waitcnt vmcnt(" #n ")" ::: "memory")
#define PG8_WAIT_L(n) asm volatile("s_waitcnt lgkmcnt(" #n ")" ::: "memory")
#define PG8_BAR __builtin_amdgcn_s_barrier()
#define PG8_SCHED __builtin_amdgcn_sched_barrier(0)
    Unit cur, nxt; int ui = 0;
    if (!S.next(0, cur)) return;
    f32x4 acc[2][2][4][2];
#pragma unroll
    for (int a = 0; a < 2; ++a)
#pragma unroll
        for (int b = 0; b < 2; ++b)
#pragma unroll
            for (int m = 0; m < 4; ++m)
#pragma unroll
                for (int n = 0; n < 2; ++n) acc[a][b][m][n] = (f32x4){0.f, 0.f, 0.f, 0.f};
    bf16x8 At[4][2], B0[2][2], B1[2][2];
    const char* cA = (const char*)g.A + (size_t)cur.pm * tstepA; const char* cB = (const char*)g.Bt + (size_t)cur.pn * tstepB;
    PG8_STAGE(PG8_SB(0, 0), cB, voffB); PG8_STAGE(PG8_SB(0, 1), cB + hstepB, voffB); PG8_STAGE(PG8_SA(0, 0), cA, voffA); PG8_STAGE(PG8_SA(0, 1), cA + hstepA, voffA);
    if (wr == 1) PG8_BAR;
    PG8_WAIT_V(2); PG8_BAR;
    PG8_STAGE(PG8_SB(1, 0), cB + kstep, voffB); PG8_STAGE(PG8_SA(1, 0), cA + kstep, voffA); PG8_STAGE(PG8_SB(1, 1), cB + hstepB + kstep, voffB);
    PG8_WAIT_V(6); PG8_BAR;
    for (;;) {
        const bool has_next = S.next(ui + 1, nxt);
        const char* nA = has_next ? (const char*)g.A + (size_t)nxt.pm * tstepA : cA; const char* nB = has_next ? (const char*)g.Bt + (size_t)nxt.pn * tstepB : cB;
        for (int t = 0; t < nt; t += 2) {
            const bool last = (t == nt - 2);
            const char* a1 = cA + (size_t)(t + 1) * kstep;
            const char* a2 = last ? nA : cA + (size_t)(t + 2) * kstep; const char* b2 = last ? nB : cB + (size_t)(t + 2) * kstep;
            const char* a3 = a2 + kstep; const char* b3 = b2 + kstep;
            if constexpr (Epi::MID) { if (t == nt / 2) E.mid(acc, cur, wr, wc, fr, fq); }
            PG8_LDB(B0, 0, 0); PG8_LDB(B1, 0, 1); PG8_SCHED; PG8_LDA(At, 0, 0); PG8_STAGE(PG8_SA(1, 1), a1 + hstepA, voffA);
            PG8_WAIT_V(8); PG8_WAIT_L(0); PG8_BAR; PG8_MMA(0, 0, At, B0); PG8_MMA(0, 1, At, B1); PG8_BAR; PG8_SCHED;
            PG8_LDA(At, 0, 1); PG8_STAGE(PG8_SB(0, 0), b2, voffB); PG8_STAGE(PG8_SB(0, 1), b2 + hstepB, voffB); PG8_STAGE(PG8_SA(0, 0), a2, voffA);
            PG8_WAIT_V(8); PG8_WAIT_L(0); PG8_BAR; PG8_MMA(1, 0, At, B0); PG8_MMA(1, 1, At, B1); PG8_BAR; PG8_SCHED;
            PG8_LDB(B0, 1, 0); PG8_LDB(B1, 1, 1); PG8_SCHED; PG8_LDA(At, 1, 0); PG8_STAGE(PG8_SA(0, 1), a2 + hstepA, voffA);
            PG8_WAIT_V(8); PG8_WAIT_L(0); PG8_BAR; PG8_MMA(0, 0, At, B0); PG8_MMA(0, 1, At, B1); PG8_BAR; PG8_SCHED;
            PG8_LDA(At, 1, 1); PG8_STAGE(PG8_SB(1, 0), b3, voffB); PG8_STAGE(PG8_SB(1, 1), b3 + hstepB, voffB); PG8_STAGE(PG8_SA(1, 0), a3, voffA);
            PG8_WAIT_V(8); PG8_WAIT_L(0); PG8_BAR; PG8_MMA(1, 0, At, B0); PG8_MMA(1, 1, At, B1); PG8_BAR; PG8_SCHED;
        }
        if (wr == 0) PG8_BAR;
        E(acc, cur, wr, wc, fr, fq);
        if (!has_next) break;
#pragma unroll
        for (int a = 0; a < 2; ++a)
#pragma unroll
            for (int b = 0; b < 2; ++b)
#pragma unroll
                for (int m = 0; m < 4; ++m)
#pragma unroll
                    for (int n = 0; n < 2; ++n) acc[a][b][m][n] = (f32x4){0.f, 0.f, 0.f, 0.f};
        cur = nxt; cA = nA; cB = nB; ++ui;
        if (wr == 1) PG8_BAR;
    }
    PG8_WAIT_V(0);
    PG8_BAR;
#undef PG8_SA
#undef PG8_SB
#undef PG8_STAGE
#undef PG8_LDA
#undef PG8_LDB
#undef PG8_MMA
#undef PG8_WAIT_V
#undef PG8_WAIT_L
#undef PG8_BAR
#undef PG8_SCHED
}
}

__device__ __forceinline__ void st_bf16x4(bf16* p, f32x4 v) { u32x2 w; w.x = pk2(v[0], v[1]); w.y = pk2(v[2], v[3]); *(u32x2*)p = w; }
__device__ __forceinline__ float sum_parts(const float* p, int n4) { f32x4 s = {0.f, 0.f, 0.f, 0.f}; for (int i = 0; i < n4; ++i) s += ((const f32x4*)p)[i]; return (s[0] + s[1]) + (s[2] + s[3]); }
__device__ __forceinline__ int sperm16(int s) { const int c = s & 15; return (s & ~15) | (8 * ((c >> 2) & 1) + 4 * (c >> 3) + (c & 3)); }

struct EpiZ {
    static constexpr bool MID = false;
    bf16 *qlat, *kvlat, *kpe, *u, *vt; float *stq, *stkv, *stvs, *stvq; const float* rope;
    __device__ __forceinline__ void operator()(const f32x4 (&acc)[2][2][4][2], const pg8::Unit& un, int wr, int wc, int fr, int fq) const {
        const int pn = un.pn, row0 = un.pm * 256 + wr * 64 + fr, cl0 = wc * 32 + 4 * fq;
        if (pn < 6) {
            const bool isq = pn < 4; bf16* dst = isq ? qlat : kvlat; const int ld = isq ? QLR : KVLR, ct = isq ? pn : pn - 4;
#pragma unroll
            for (int ai = 0; ai < 2; ++ai)
#pragma unroll
                for (int m = 0; m < 4; ++m) { const int row = row0 + ai * 128 + m * 16; float ss = 0.f;
#pragma unroll
                    for (int bj = 0; bj < 2; ++bj)
#pragma unroll
                        for (int n = 0; n < 2; ++n) { const f32x4 v = acc[ai][bj][m][n]; ss += (v[0] * v[0] + v[1] * v[1]) + (v[2] * v[2] + v[3] * v[3]);
                            st_bf16x4(dst + (size_t)row * ld + ct * 256 + bj * 128 + cl0 + n * 16, v); }
                    ss += __shfl_xor(ss, 16); ss += __shfl_xor(ss, 32);
                    if (fq == 0) { if (isq) stq[row * 16 + ct * 4 + wc] = ss; else stkv[row * 8 + ct * 4 + wc] = ss; } }
        } else if (pn == 6) {
            if (wc < 2) {
#pragma unroll
                for (int ai = 0; ai < 2; ++ai)
#pragma unroll
                    for (int m = 0; m < 4; ++m) { const int row = row0 + ai * 128 + m * 16, j0 = 16 * wc + 4 * fq;
                        const f32x4 x1 = acc[ai][0][m][0], x2 = acc[ai][0][m][1];
                        const f32x4 c0 = *(const f32x4*)(rope + (size_t)row * 64 + 2 * j0), c1 = *(const f32x4*)(rope + (size_t)row * 64 + 2 * j0 + 4);
                        const float cs[4] = {c0[0], c0[2], c1[0], c1[2]}, sn[4] = {c0[1], c0[3], c1[1], c1[3]};
                        f32x4 o1, o2;
#pragma unroll
                        for (int e = 0; e < 4; ++e) { o1[e] = x1[e] * cs[e] - x2[e] * sn[e]; o2[e] = x2[e] * cs[e] + x1[e] * sn[e]; }
                        st_bf16x4(kpe + (size_t)row * 64 + j0, o1); st_bf16x4(kpe + (size_t)row * 64 + 32 + j0, o2); }
            }
        } else if (pn < 15) {
#pragma unroll
            for (int ai = 0; ai < 2; ++ai)
#pragma unroll
                for (int m = 0; m < 4; ++m) { const int row = row0 + ai * 128 + m * 16;
#pragma unroll
                    for (int bj = 0; bj < 2; ++bj)
#pragma unroll
                        for (int n = 0; n < 2; ++n) { f32x4 v = acc[ai][bj][m][n];
#pragma unroll
                            for (int e = 0; e < 4; ++e) v[e] = gelu_f(v[e]);
                            st_bf16x4(u + (size_t)row * GW + (pn - 7) * 256 + bj * 128 + cl0 + n * 16, v); } }
        } else {
            const int ct = pn - 15;
#pragma unroll
            for (int ai = 0; ai < 2; ++ai)
#pragma unroll
                for (int m = 0; m < 4; ++m) { const int row = row0 + ai * 128 + m * 16, b = row >> 12, s = row & 4095; float s1 = 0.f, s2 = 0.f;
#pragma unroll
                    for (int bj = 0; bj < 2; ++bj)
#pragma unroll
                        for (int n = 0; n < 2; ++n) { const f32x4 v = acc[ai][bj][m][n]; const int col = ct * 256 + bj * 128 + cl0 + n * 16;
#pragma unroll
                            for (int e = 0; e < 4; ++e) { const float g = gelu_f(v[e]); s1 += g; s2 += g * g; vt[((size_t)b * GW + col + e) * SEQ + s] = (bf16)f2bf(g); } }
                    s1 += __shfl_xor(s1, 16); s1 += __shfl_xor(s1, 32); s2 += __shfl_xor(s2, 16); s2 += __shfl_xor(s2, 32);
                    if (fq == 0) { stvs[row * 32 + ct * 4 + wc] = s1; stvq[row * 32 + ct * 4 + wc] = s2; } }
        }
    }
};

struct EpiQ {
    static constexpr bool MID = false;
    bf16* q; const float* stq; const float* rope;
    __device__ __forceinline__ void operator()(const f32x4 (&acc)[2][2][4][2], const pg8::Unit& un, int wr, int wc, int fr, int fq) const {
        const int pn = un.pn, row0 = un.pm * 256 + wr * 64 + fr;
#pragma unroll
        for (int ai = 0; ai < 2; ++ai)
#pragma unroll
            for (int m = 0; m < 4; ++m) { const int row = row0 + ai * 128 + m * 16;
                const float rs = rsqrtf(sum_parts(stq + row * 16, 4) * (1.0f / QLR) + EPS);
#pragma unroll
                for (int bj = 0; bj < 2; ++bj) { const int blk = 4 * pn + 2 * bj + (wc >> 1), head = blk / 3, part = blk - 3 * head;
                    if (part != 2) {
#pragma unroll
                        for (int n = 0; n < 2; ++n) st_bf16x4(q + (size_t)row * (NH * QKD) + pn * 256 + bj * 128 + wc * 32 + n * 16 + 4 * fq, acc[ai][bj][m][n] * rs);
                    } else {
                        const int j0 = 16 * (wc & 1) + 4 * fq; const f32x4 x1 = acc[ai][bj][m][0] * rs, x2 = acc[ai][bj][m][1] * rs;
                        const f32x4 c0 = *(const f32x4*)(rope + (size_t)row * 64 + 2 * j0), c1 = *(const f32x4*)(rope + (size_t)row * 64 + 2 * j0 + 4);
                        const float cs[4] = {c0[0], c0[2], c1[0], c1[2]}, sn[4] = {c0[1], c0[3], c1[1], c1[3]};
                        f32x4 o1, o2;
#pragma unroll
                        for (int e = 0; e < 4; ++e) { o1[e] = x1[e] * cs[e] - x2[e] * sn[e]; o2[e] = x2[e] * cs[e] + x1[e] * sn[e]; }
                        bf16* base = q + (size_t)row * (NH * QKD) + head * QKD + NOPE;
                        st_bf16x4(base + j0, o1); st_bf16x4(base + 32 + j0, o2);
                    } } }
    }
};

struct EpiKV {
    static constexpr bool MID = false;
    bf16 *kn, *vta; const float* stkv;
    __device__ __forceinline__ void operator()(const f32x4 (&acc)[2][2][4][2], const pg8::Unit& un, int wr, int wc, int fr, int fq) const {
        const int pn = un.pn, row0 = un.pm * 256 + wr * 64 + fr;
#pragma unroll
        for (int ai = 0; ai < 2; ++ai)
#pragma unroll
            for (int m = 0; m < 4; ++m) { const int row = row0 + ai * 128 + m * 16, b = row >> 12, sp = sperm16(row & 4095);
                const float rs = rsqrtf(sum_parts(stkv + row * 8, 2) * (1.0f / KVLR) + EPS);
#pragma unroll
                for (int n = 0; n < 2; ++n) { const int d0 = wc * 32 + n * 16 + 4 * fq;
                    st_bf16x4(kn + (size_t)row * (NH * NOPE) + pn * NOPE + d0, acc[ai][0][m][n] * rs);
                    const f32x4 v = acc[ai][1][m][n] * rs;
#pragma unroll
                    for (int e = 0; e < 4; ++e) vta[(((size_t)b * NH + pn) * VD + d0 + e) * SEQ + sp] = (bf16)f2bf(v[e]); } }
    }
};

struct EpiX1 {
    static constexpr bool MID = true;
    const float* mod; bf16* mix; const LAS f32x2* rs; int pm0;
    __device__ __forceinline__ void mid(f32x4 (&acc)[2][2][4][2], const pg8::Unit& un, int wr, int wc, int fr, int fq) const {
        const LAS f32x2* p = rs + (un.pm == pm0 ? 0 : 256) + wr * 64 + fr;
#pragma unroll
        for (int ai = 0; ai < 2; ++ai)
#pragma unroll
            for (int m = 0; m < 4; ++m) { const float ratio = p[ai * 128 + m * 16].x;
#pragma unroll
                for (int bj = 0; bj < 2; ++bj)
#pragma unroll
                    for (int n = 0; n < 2; ++n) acc[ai][bj][m][n] *= ratio; }
    }
    __device__ __forceinline__ void operator()(const f32x4 (&acc)[2][2][4][2], const pg8::Unit& un, int wr, int wc, int fr_, int fq_) const {
        int fr = fr_, fq = fq_; asm volatile("" : "+v"(fr), "+v"(fq));
        const int pn = un.pn, row0 = un.pm * 256 + wr * 64 + fr, b = (un.pm * 256) >> 12;
        const LAS f32x2* p = rs + (un.pm == pm0 ? 0 : 256) + wr * 64 + fr;
        f32x4 gt[2][2];
#pragma unroll
        for (int bj = 0; bj < 2; ++bj)
#pragma unroll
            for (int n = 0; n < 2; ++n) gt[bj][n] = *(const f32x4*)(mod + (size_t)b * 6 * D + 2 * D + pn * 256 + bj * 128 + wc * 32 + n * 16 + 4 * fq);
#pragma unroll
        for (int ai = 0; ai < 2; ++ai)
#pragma unroll
            for (int m = 0; m < 4; ++m) { const int row = row0 + ai * 128 + m * 16; const size_t ro = (size_t)row * D;
                const float rg = p[ai * 128 + m * 16].y;
#pragma unroll
                for (int bj = 0; bj < 2; ++bj)
#pragma unroll
                    for (int n = 0; n < 2; ++n) { const int col = pn * 256 + bj * 128 + wc * 32 + n * 16 + 4 * fq;
                        st_bf16x4(mix + ro + col, gt[bj][n] * (acc[ai][bj][m][n] * rg)); } }
    }
};

struct EpiQP {
    static constexpr bool MID = false;
    bf16* qp;
    __device__ __forceinline__ void operator()(const f32x4 (&acc)[2][2][4][2], const pg8::Unit& un, int wr, int wc, int fr, int fq) const {
        const int pn = un.pn, row0 = un.pm * 256 + wr * 64 + fr;
#pragma unroll
        for (int ai = 0; ai < 2; ++ai)
#pragma unroll
            for (int m = 0; m < 4; ++m) { const size_t ro = (size_t)(row0 + ai * 128 + m * 16) * PQW;
#pragma unroll
                for (int bj = 0; bj < 2; ++bj)
#pragma unroll
                    for (int n = 0; n < 2; ++n) st_bf16x4(qp + ro + pn * 256 + bj * 128 + wc * 32 + n * 16 + 4 * fq, acc[ai][bj][m][n]); }
    }
};

struct Ctx {
    const float *x, *c; const int* pos; const float *w_ada, *b_ada, *g_mix, *w_in, *g_q, *w_uq, *g_kv, *w_ukv, *g_sgu, *w_sgu, *b_sgu, *beta_mla, *beta_g, *w_out, *g_ffn, *w_pq, *pkeys, *eu, *ev, *w_adaf, *b_adaf, *g_f;
    float* out; unsigned char* ws;
};

__device__ __forceinline__ void ada_unit(const Ctx& C, int unit, LAS float* red, int tid, int wave, int lane) {
    const bool fin = unit >= 192; const float* W = fin ? C.w_adaf : C.w_ada; const int N = fin ? 2 * D : 6 * D, n0 = (fin ? unit - 192 : unit) * 128;
    const int half = lane >> 5, l32 = lane & 31;
    f32x4 a0 = {0.f, 0.f, 0.f, 0.f}, a1 = {0.f, 0.f, 0.f, 0.f};
    const int kbeg = wave * 512;
    LAS float* sil = red + 2048;
#pragma unroll
    for (int j = 0; j < 16; ++j) { const float cv = C.c[tid + 512 * j]; sil[tid + 512 * j] = cv / (1.0f + __expf(-cv)); }
    __syncthreads();
    const char* wp = (const char*)(W + (size_t)(kbeg + half) * N + n0 + 4 * l32); const unsigned rstep = 2u * (unsigned)N * 4u;
    f32x4 w[12];
#pragma unroll
    for (int p = 0; p < 12; ++p) w[p] = *(const f32x4*)(wp + (size_t)p * rstep);
#pragma unroll 1
    for (int i = 0; i < 252; i += 12) {
#pragma unroll
        for (int p = 0; p < 12; ++p) { const int k = kbeg + 2 * (i + p) + half; const f32x4 cur = w[p];
            if (i + 12 + p < 256) w[p] = *(const f32x4*)(wp + (size_t)(i + 12 + p) * rstep);
            const float s0 = sil[k], s1 = sil[D + k];
            a0 += cur * s0; a1 += cur * s1; } }
#pragma unroll
    for (int p = 0; p < 4; ++p) { const int k = kbeg + 2 * (252 + p) + half; const float s0 = sil[k], s1 = sil[D + k]; a0 += w[p] * s0; a1 += w[p] * s1; }
#pragma unroll
    for (int e = 0; e < 4; ++e) { a0[e] += __shfl_xor(a0[e], 32); a1[e] += __shfl_xor(a1[e], 32); }
    if (half == 0) { *(LAS f32x4*)(red + (wave * 32 + l32) * 8) = a0; *(LAS f32x4*)(red + (wave * 32 + l32) * 8 + 4) = a1; }
    __syncthreads();
    if (tid < 256) { const int b = tid >> 7, col = tid & 127; float s = 0.f;
#pragma unroll
        for (int w = 0; w < 8; ++w) s += red[(w * 32 + (col >> 2)) * 8 + b * 4 + (col & 3)];
        const float* bias = fin ? C.b_adaf : C.b_ada;
        float* o = (float*)(C.ws + WS_MOD) + (fin ? 2 * 6 * D : 0) + (size_t)b * N + n0 + col;
        *o = s + bias[n0 + col]; }
    __syncthreads();
}

enum { MAP_ID = 0, MAP_W1 = 1, MAP_UQ = 2 };
__device__ __forceinline__ int ropeperm(int p) { return ((p >> 4) & 1) * 32 + 16 * (p >> 5) + (p & 15); }
template <int MAP> __device__ __forceinline__ int colmap(int n) {
    if (MAP == MAP_W1) { if (n < 1536) return n; if (n < 1600) return 1536 + ropeperm(n - 1536); if (n < 1792) return -1; return n - 192; }
    if (MAP == MAP_UQ) { const int blk = n >> 6; if (blk % 3 == 2) return (n & ~63) + ropeperm(n & 63); return n; }
    return n;
}
template <int MAP> __device__ __forceinline__ void transpose_item(const float* W, int K, int N, int NP, bf16* WT, const float* ks, float mul, LAS float* scr, int item, int lane) {
    const int nblk = NP / 32, kb = item / nblk, nb = item % nblk, k0 = 64 * kb, n0 = 32 * nb;
    const int q4 = lane & 7, src = colmap<MAP>(n0 + 4 * q4);
    f32x4 ld[8];
#pragma unroll
    for (int i = 0; i < 8; ++i) { const int kk = (lane >> 3) + 8 * i; ld[i] = (src >= 0) ? *(const f32x4*)(W + (size_t)(k0 + kk) * N + src) : (f32x4){0.f, 0.f, 0.f, 0.f}; }
#pragma unroll
    for (int i = 0; i < 8; ++i) { const int kk = (lane >> 3) + 8 * i;
#pragma unroll
        for (int e = 0; e < 4; ++e) scr[kk * 33 + 4 * q4 + e] = ld[i][e]; }
    LDS_WAIT(); asm volatile("" ::: "memory");
    const int c = lane & 7;
    float sc[8];
#pragma unroll
    for (int e = 0; e < 8; ++e) sc[e] = (ks ? ks[k0 + 8 * c + e] : 1.0f) * mul;
#pragma unroll
    for (int j = 0; j < 4; ++j) { const int n = (lane >> 3) + 8 * j; const LAS float* s = scr + (8 * c) * 33 + n;
        u32x4 o; o.x = pk2(s[0 * 33] * sc[0], s[1 * 33] * sc[1]); o.y = pk2(s[2 * 33] * sc[2], s[3 * 33] * sc[3]); o.z = pk2(s[4 * 33] * sc[4], s[5 * 33] * sc[5]); o.w = pk2(s[6 * 33] * sc[6], s[7 * 33] * sc[7]);
        *(u32x4*)(WT + (size_t)(n0 + n) * K + k0 + 8 * c) = o; }
    LDS_WAIT(); asm volatile("" ::: "memory");
}

__device__ __forceinline__ float wave_max_nonneg(float v) {
    v = fmaxf(v, __builtin_bit_cast(float, __builtin_amdgcn_update_dpp(0, __builtin_bit_cast(int, v), 0xB1, 0xF, 0xF, true)));
    v = fmaxf(v, __builtin_bit_cast(float, __builtin_amdgcn_update_dpp(0, __builtin_bit_cast(int, v), 0x4E, 0xF, 0xF, true)));
    v = fmaxf(v, __builtin_bit_cast(float, __builtin_amdgcn_update_dpp(0, __builtin_bit_cast(int, v), 0x141, 0xF, 0xF, true)));
    v = fmaxf(v, __builtin_bit_cast(float, __builtin_amdgcn_update_dpp(0, __builtin_bit_cast(int, v), 0x140, 0xF, 0xF, true)));
    v = fmaxf(v, __builtin_bit_cast(float, __builtin_amdgcn_update_dpp(0, __builtin_bit_cast(int, v), 0x142, 0xA, 0xF, true)));
    v = fmaxf(v, __builtin_bit_cast(float, __builtin_amdgcn_update_dpp(0, __builtin_bit_cast(int, v), 0x143, 0xC, 0xF, true)));
    return __builtin_bit_cast(float, __builtin_amdgcn_readlane(__builtin_bit_cast(int, v), 63));
}
template <bool Q8, bool VL> __device__ __forceinline__ void norm_mod_rows(const float* X, const bf16* ADD, const float* g, const float* sh, const float* sc, bf16* O, signed char* O8, float* S8, bf16* X1O, int gw, int NGW, int lane, LAS unsigned char* lds, int tid) {
    f32x4 vn[16]; u32x2 an[16]; int bcur = -1;
    if (gw < M) {
#pragma unroll
        for (int j = 0; j < 16; ++j) { vn[j] = ((const f32x4*)(X + (size_t)gw * D))[64 * j + lane]; if (Q8) an[j] = ((const u32x2*)(ADD + (size_t)gw * D))[64 * j + lane]; } }
    for (int m = gw; m < M; m += NGW) { const int b = m >> 12;
        if (VL && b != bcur) { bcur = b; LDS_BARRIER();
#pragma unroll
            for (int i = 0; i < 2; ++i) { const int c4 = tid + 512 * i;
                *(LAS f32x4*)(lds + c4 * 16) = ((const f32x4*)g)[c4]; *(LAS f32x4*)(lds + 16384 + c4 * 16) = ((const f32x4*)(sc + (size_t)b * 6 * D))[c4]; *(LAS f32x4*)(lds + 32768 + c4 * 16) = ((const f32x4*)(sh + (size_t)b * 6 * D))[c4]; }
            LDS_BARRIER(); }
        f32x4 v[16]; float ss = 0.f;
#pragma unroll
        for (int j = 0; j < 16; ++j) { v[j] = vn[j];
            if (Q8) v[j] += (f32x4){bf2f(an[j].x & 0xffffu), bf2f(an[j].x >> 16), bf2f(an[j].y & 0xffffu), bf2f(an[j].y >> 16)};
            ss += (v[j][0] * v[j][0] + v[j][1] * v[j][1]) + (v[j][2] * v[j][2] + v[j][3] * v[j][3]); }
        if (m + NGW < M) {
#pragma unroll
            for (int j = 0; j < 16; ++j) { vn[j] = ((const f32x4*)(X + (size_t)(m + NGW) * D))[64 * j + lane]; if (Q8) an[j] = ((const u32x2*)(ADD + (size_t)(m + NGW) * D))[64 * j + lane]; } }
        const float rs = rsqrtf(wave_sum(ss) * (1.0f / D) + EPS);
        const char* gp = (const char*)g; const char* scp = (const char*)(sc + (size_t)b * 6 * D); const char* shp = (const char*)(sh + (size_t)b * 6 * D);
        char* op = (char*)(O + (size_t)m * D); char* o8p = (char*)(O8 + (size_t)m * D); char* x1p = (char*)(X1O + (size_t)m * D);
        int lanev = lane; asm volatile("" : "+v"(lanev));
        float amx = 0.f;
#pragma unroll
        for (int j = 0; j < 16; ++j) { const unsigned cb = (unsigned)(64 * j + lanev) * 16u;
            f32x4 gg, s1, s0;
            if (VL) { gg = *(const LAS f32x4*)(lds + cb); s1 = *(const LAS f32x4*)(lds + 16384 + cb); s0 = *(const LAS f32x4*)(lds + 32768 + cb); }
            else { gg = *(const f32x4*)(gp + cb); s1 = *(const f32x4*)(scp + cb); s0 = *(const f32x4*)(shp + cb); }
            const f32x4 y = v[j] * rs * gg * (s1 + 1.0f) + s0;
            u32x2 w; w.x = pk2(y[0], y[1]); w.y = pk2(y[2], y[3]); *(u32x2*)(op + (cb >> 1)) = w;
            if (Q8) { u32x2 w1; w1.x = pk2(v[j][0], v[j][1]); w1.y = pk2(v[j][2], v[j][3]); *(u32x2*)(x1p + (cb >> 1)) = w1;
                v[j] = y; amx = fmaxf(amx, fmaxf(fmaxf(fabsf(y[0]), fabsf(y[1])), fmaxf(fabsf(y[2]), fabsf(y[3])))); }
            if ((j & 1) == 1) __builtin_amdgcn_sched_barrier(0); }
        if (Q8) {
            const float am = wave_max_nonneg(amx), q = am > 0.f ? 127.0f / am : 0.f;
            asm volatile("" : "+v"(lanev));
#pragma unroll
            for (int j = 0; j < 16; ++j) { const unsigned cb = (unsigned)(64 * j + lanev) * 4u;
                const int q0 = (int)rintf(v[j][0] * q), q1 = (int)rintf(v[j][1] * q), q2 = (int)rintf(v[j][2] * q), q3 = (int)rintf(v[j][3] * q);
                *(unsigned*)(o8p + cb) = (unsigned)(q0 & 255) | ((unsigned)(q1 & 255) << 8) | ((unsigned)(q2 & 255) << 16) | ((unsigned)(q3 & 255) << 24); }
            if (lane == 0) S8[m] = am * (1.0f / 127.0f); } }
}

constexpr int SG_ROW = 272;
__device__ __forceinline__ void sgu_units(const Ctx& C, int u0, int uend, int ustep, LAS unsigned char* lds, int tid, int wave, int lane) {
#define SG_LBAR() do { asm volatile("s_waitcnt lgkmcnt(0)" ::: "memory"); __builtin_amdgcn_s_barrier(); asm volatile("" ::: "memory"); } while (0)
    const bf16* VT = (const bf16*)(C.ws + WS_VT); const bf16* U = (const bf16*)(C.ws + WS_U); bf16* Y = (bf16*)(C.ws + WS_Y);
    const float* stvs = (const float*)(C.ws + WS_STVS); const float* stvq = (const float*)(C.ws + WS_STVQ); float* stg = (float*)(C.ws + WS_STG);
    const bf16* WS = (const bf16*)(C.ws + WS_WSGU);
    LAS float* mu = (LAS float*)(lds + 128 * SG_ROW); LAS float* rstd = mu + 128;
    const int r = lane & 31, hi = lane >> 5, db = wave >> 1;
    u32x4 raw[4]; float gq[4]; float ps1 = 0.f, ps2 = 0.f;
#define SG_FETCH(unit_) do { const int hh_ = (unit_) & 15, n_ = ((unit_) >> 4) & 31, b_ = (unit_) >> 9, tok0_ = b_ * SEQ + n_ * GC; int tidv_ = tid; asm volatile("" : "+v"(tidv_)); \
        if (tidv_ < 128) { ps1 = sum_parts(stvs + (size_t)(tok0_ + tidv_) * 32, 8); ps2 = sum_parts(stvq + (size_t)(tok0_ + tidv_) * 32, 8); } \
        _Pragma("unroll") for (int i = 0; i < 4; ++i) { const int idx = tidv_ + 512 * i, d = idx >> 4, ch = idx & 15; \
            raw[i] = *(const u32x4*)(VT + ((size_t)b_ * GW + hh_ * 128 + d) * SEQ + n_ * GC + ch * 8); gq[i] = C.g_sgu[hh_ * 128 + d]; } } while (0)
    __syncthreads();
    if (u0 < uend) SG_FETCH(u0);
    for (int unit = u0; unit < uend; unit += ustep) {
        const int hh = unit & 15, n = (unit >> 4) & 31, b = unit >> 9, tok0 = b * SEQ + n * GC;
        if (tid < 128) { const float mean = ps1 * (1.0f / GW), var = fmaxf(ps2 * (1.0f / GW) - mean * mean, 0.f); mu[tid] = mean; rstd[tid] = rsqrtf(var + EPS); }
        bf16x8 wv[2][8]; u32x2 uu[2][4]; float bias[2];
#pragma unroll
        for (int tt = 0; tt < 2; ++tt) { const int t = 32 * (2 * (wave & 1) + tt) + r;
#pragma unroll
            for (int ks = 0; ks < 8; ++ks) wv[tt][ks] = *(const bf16x8*)(WS + ((size_t)hh * 128 + t) * 128 + 16 * ks + 8 * hi);
#pragma unroll
            for (int g4 = 0; g4 < 4; ++g4) uu[tt][g4] = *(const u32x2*)(U + (size_t)(tok0 + t) * GW + hh * 128 + 32 * db + 8 * g4 + 4 * hi);
            bias[tt] = C.b_sgu[hh * 128 + t]; }
        SG_LBAR();
#pragma unroll
        for (int i = 0; i < 4; ++i) { const int idx = tid + 512 * i, d = idx >> 4, ch = idx & 15;
            const float g = gq[i];
            float f[8];
#pragma unroll
            for (int e = 0; e < 4; ++e) { f[2 * e] = bf2f(raw[i][e] & 0xffffu); f[2 * e + 1] = bf2f(raw[i][e] >> 16); }
#pragma unroll
            for (int e = 0; e < 8; ++e) f[e] = (f[e] - mu[ch * 8 + e]) * rstd[ch * 8 + e] * g;
            u32x4 o; o.x = pk2(f[0], f[1]); o.y = pk2(f[2], f[3]); o.z = pk2(f[4], f[5]); o.w = pk2(f[6], f[7]);
            *(LAS u32x4*)(lds + d * SG_ROW + ch * 16) = o; }
        SG_LBAR();
        if (unit + ustep < uend) SG_FETCH(unit + ustep);
#pragma unroll
        for (int tt = 0; tt < 2; ++tt) { const int tb = 2 * (wave & 1) + tt;
            f32x16 acc; for (int i = 0; i < 16; ++i) acc[i] = 0.f;
#pragma unroll
            for (int ks = 0; ks < 8; ++ks) { if (ks <= 2 * tb + 1) {
                const bf16x8 a = *(const LAS bf16x8*)(lds + (32 * db + r) * SG_ROW + ks * 32 + hi * 16);
                acc = __builtin_amdgcn_mfma_f32_32x32x16_bf16(a, wv[tt][ks], acc, 0, 0, 0); } }
            const int t = 32 * tb + r, tok = tok0 + t; float ss = 0.f;
#pragma unroll
            for (int g4 = 0; g4 < 4; ++g4) { const int d0 = 32 * db + 8 * g4 + 4 * hi; const u32x2 u2 = uu[tt][g4];
                f32x4 y; y[0] = bf2f(u2.x & 0xffffu) * (acc[4 * g4 + 0] + bias[tt]); y[1] = bf2f(u2.x >> 16) * (acc[4 * g4 + 1] + bias[tt]);
                y[2] = bf2f(u2.y & 0xffffu) * (acc[4 * g4 + 2] + bias[tt]); y[3] = bf2f(u2.y >> 16) * (acc[4 * g4 + 3] + bias[tt]);
                ss += (y[0] * y[0] + y[1] * y[1]) + (y[2] * y[2] + y[3] * y[3]);
                st_bf16x4(Y + (size_t)tok * D + GW + hh * 128 + d0, y); }
            ss += __shfl_xor(ss, 32);
            if (hi == 0) ((LAS float*)(lds + 128 * SG_ROW + 1024))[t * 4 + db] = ss; }
        SG_LBAR();
        if (tid < 128) { const f32x4 p4 = *(const LAS f32x4*)(lds + 128 * SG_ROW + 1024 + tid * 16); stg[(size_t)(tok0 + tid) * 16 + hh] = (p4[0] + p4[1]) + (p4[2] + p4[3]); }
    }
    __syncthreads();
#undef SG_FETCH
#undef SG_LBAR
}

constexpr int AK_ROW = 400, AV_ROW = 144, AK_BYTES = 64 * AK_ROW, AV_BYTES = 128 * AV_ROW, ABUF = AK_BYTES + AV_BYTES;
__device__ __forceinline__ void attn_block(const Ctx& C, int b, int h, int qb, LAS unsigned char* lds, int tid, int wave, int lane) {
    const bf16* Q = (const bf16*)(C.ws + WS_Q); const bf16* KN = (const bf16*)(C.ws + WS_KN); const bf16* KPE = (const bf16*)(C.ws + WS_KPE);
    const bf16* VTA = (const bf16*)(C.ws + WS_VTA); bf16* Y = (bf16*)(C.ws + WS_Y); float* stm = (float*)(C.ws + WS_STM);
    const int r = lane & 31, hi = lane >> 5, q0 = qb * 256, q0w = q0 + 32 * wave; const size_t tokq = (size_t)b * SEQ + q0w + r;
    bf16x8 qf[12];
#pragma unroll
    for (int ks = 0; ks < 12; ++ks) qf[ks] = *(const bf16x8*)(Q + tokq * (NH * QKD) + h * QKD + 16 * ks + 8 * hi);
    f32x16 o[4];
#pragma unroll
    for (int db = 0; db < 4; ++db) for (int i = 0; i < 16; ++i) o[db][i] = 0.f;
    float mrun = -1e30f, lrun = 0.f;
    const int ntiles = (q0 + 256) / 64;
    const int kr0 = tid >> 4, kc0 = tid & 15, pr = tid >> 3, pc = tid & 7;
    const unsigned ok0 = (((unsigned)b * SEQ + kr0) * (NH * NOPE) + h * NOPE + kc0 * 8) * 2u;
    const unsigned op0 = (((unsigned)b * SEQ + pr) * ROPE + pc * 8) * 2u;
    const unsigned ov0 = ((((unsigned)b * NH + h) * VD + pr) * SEQ + pc * 8) * 2u;
    const unsigned lk0 = kr0 * AK_ROW + kc0 * 16, lk1 = (kr0 + 32) * AK_ROW + kc0 * 16, lp = pr * AK_ROW + 256 + pc * 16;
    const unsigned lv0 = AK_BYTES + pr * AV_ROW + pc * 16, lv1 = AK_BYTES + (pr + 64) * AV_ROW + pc * 16;
    u32x4 st[5];
#define ATT_GLOAD(j) do { const unsigned j_ = (unsigned)(j); \
        st[0] = *(const u32x4*)((const char*)KN + (ok0 + j_ * (64u * NH * NOPE * 2u))); st[1] = *(const u32x4*)((const char*)KN + (ok0 + j_ * (64u * NH * NOPE * 2u) + 32u * NH * NOPE * 2u)); \
        st[2] = *(const u32x4*)((const char*)KPE + (op0 + j_ * (64u * ROPE * 2u))); \
        st[3] = *(const u32x4*)((const char*)VTA + (ov0 + j_ * 128u)); st[4] = *(const u32x4*)((const char*)VTA + (ov0 + j_ * 128u + 64u * SEQ * 2u)); } while (0)
    ATT_GLOAD(0);
    for (int j = 0; j < ntiles; ++j) {
        LAS unsigned char* buf = lds + (j & 1) * ABUF;
        *(LAS u32x4*)(buf + lk0) = st[0]; *(LAS u32x4*)(buf + lk1) = st[1]; *(LAS u32x4*)(buf + lp) = st[2]; *(LAS u32x4*)(buf + lv0) = st[3]; *(LAS u32x4*)(buf + lv1) = st[4];
        if (j + 1 < ntiles) ATT_GLOAD(j + 1);
        __syncthreads();
        const int kbase = 64 * j;
        if (kbase <= q0w + 31) {
            f32x16 s0, s1;
#pragma unroll
            for (int i = 0; i < 16; ++i) { s0[i] = 0.f; s1[i] = 0.f; }
#pragma unroll
            for (int ks = 0; ks < 12; ++ks) {
                const bf16x8 k0 = *(const LAS bf16x8*)(buf + r * AK_ROW + ks * 32 + hi * 16);
                const bf16x8 k1 = *(const LAS bf16x8*)(buf + (32 + r) * AK_ROW + ks * 32 + hi * 16);
                s0 = __builtin_amdgcn_mfma_f32_32x32x16_bf16(k0, qf[ks], s0, 0, 0, 0);
                s1 = __builtin_amdgcn_mfma_f32_32x32x16_bf16(k1, qf[ks], s1, 0, 0, 0);
                if ((ks & 3) == 3) __builtin_amdgcn_sched_barrier(0); }
            if (kbase + 63 > q0w) {
                const int qrow = q0w + r;
#pragma unroll
                for (int i = 0; i < 16; ++i) { const int key = kbase + (i & 3) + 8 * (i >> 2) + 4 * hi;
                    s0[i] = key > qrow ? -INFINITY : s0[i]; s1[i] = key + 32 > qrow ? -INFINITY : s1[i]; }
            }
            float mx = fmaxf(s0[0], s1[0]);
#pragma unroll
            for (int i = 1; i < 16; ++i) mx = fmaxf(mx, fmaxf(s0[i], s1[i]));
            mx = fmaxf(mx, __shfl_xor(mx, 32));
            if (!__all(mx - mrun <= 8.0f)) { const float mn = fmaxf(mrun, mx), alpha = __builtin_amdgcn_exp2f(mrun - mn); mrun = mn; lrun *= alpha;
#pragma unroll
                for (int db = 0; db < 4; ++db)
#pragma unroll
                    for (int i = 0; i < 16; ++i) o[db][i] *= alpha; }
            float rsum = 0.f;
#pragma unroll
            for (int i = 0; i < 16; ++i) { s0[i] = __builtin_amdgcn_exp2f(s0[i] - mrun); s1[i] = __builtin_amdgcn_exp2f(s1[i] - mrun); rsum += s0[i] + s1[i]; }
            lrun += rsum;
            bf16x8 pf[4];
#pragma unroll
            for (int t = 0; t < 2; ++t) {
                u32x4 w0, w1;
#pragma unroll
                for (int e = 0; e < 4; ++e) { w0[e] = pk2(s0[8 * t + 2 * e], s0[8 * t + 2 * e + 1]); w1[e] = pk2(s1[8 * t + 2 * e], s1[8 * t + 2 * e + 1]); }
                pf[t] = __builtin_bit_cast(bf16x8, w0); pf[2 + t] = __builtin_bit_cast(bf16x8, w1); }
#pragma unroll
            for (int s4 = 0; s4 < 4; ++s4)
#pragma unroll
                for (int db = 0; db < 4; ++db) {
                    const bf16x8 v = *(const LAS bf16x8*)(buf + AK_BYTES + (32 * db + r) * AV_ROW + s4 * 32 + hi * 16);
                    o[db] = __builtin_amdgcn_mfma_f32_32x32x16_bf16(v, pf[s4], o[db], 0, 0, 0); }
        }
    }
#undef ATT_GLOAD
    const float lt = lrun + __shfl_xor(lrun, 32), inv = 1.0f / lt; float ss = 0.f;
#pragma unroll
    for (int db = 0; db < 4; ++db)
#pragma unroll
        for (int g4 = 0; g4 < 4; ++g4) { const int d0 = 32 * db + 8 * g4 + 4 * hi;
            f32x4 y; y[0] = o[db][4 * g4] * inv; y[1] = o[db][4 * g4 + 1] * inv; y[2] = o[db][4 * g4 + 2] * inv; y[3] = o[db][4 * g4 + 3] * inv;
            ss += (y[0] * y[0] + y[1] * y[1]) + (y[2] * y[2] + y[3] * y[3]);
            st_bf16x4(Y + tokq * D + h * VD + d0, y); }
    ss += __shfl_xor(ss, 32);
    if (hi == 0) stm[tokq * 16 + h] = ss;
}

#define CE_DESC(a, b) do { const float hi_ = fmaxf(a, b), lo_ = fminf(a, b); a = hi_; b = lo_; } while (0)
#define CE_ASC(a, b) do { const float hi_ = fmaxf(a, b), lo_ = fminf(a, b); a = lo_; b = hi_; } while (0)
__device__ __forceinline__ void bitonic_merge16_desc(float (&v)[64], const int base) {
#pragma unroll
    for (int j = 8; j > 0; j >>= 1)
#pragma unroll
        for (int i = 0; i < 16; ++i) { const int l = i ^ j; if (l > i) CE_DESC(v[base + i], v[base + l]); }
}
__device__ __forceinline__ void bitonic_sort16_desc(float (&v)[64], const int base) {
#pragma unroll
    for (int k = 2; k <= 16; k <<= 1)
#pragma unroll
        for (int j = k >> 1; j > 0; j >>= 1)
#pragma unroll
            for (int i = 0; i < 16; ++i) { const int l = i ^ j; if (l > i) { if ((i & k) == 0) CE_DESC(v[base + i], v[base + l]); else CE_ASC(v[base + i], v[base + l]); } }
}
__device__ __forceinline__ void merge_top16(float (&v)[64], const int a0, const int b0) {
#pragma unroll
    for (int i = 0; i < 16; ++i) v[a0 + i] = fmaxf(v[a0 + i], v[b0 + 15 - i]);
    bitonic_merge16_desc(v, a0);
}
__device__ __forceinline__ void top16_of_64(float (&v)[64]) {
    bitonic_sort16_desc(v, 0); bitonic_sort16_desc(v, 16); bitonic_sort16_desc(v, 32); bitonic_sort16_desc(v, 48);
    merge_top16(v, 0, 16); merge_top16(v, 32, 48); merge_top16(v, 0, 32);
}
__device__ __forceinline__ void topk_item(const Ctx& C, int item, LAS float* top  , LAS int* pe, LAS float* pg, int lane) {
    const bf16* QP = (const bf16*)(C.ws + WS_QP); const bf16* KEYS = (const bf16*)(C.ws + WS_KEYS);
    const int tb = item >> 3, hh = item & 7, r = lane & 31, hi = lane >> 5; const size_t tok = (size_t)tb * 32 + r;
#pragma unroll 1
    for (int p = 0; p < 2; ++p) {
        f32x16 sc[4];
#pragma unroll
        for (int nb = 0; nb < 4; ++nb) for (int i = 0; i < 16; ++i) sc[nb][i] = 0.f;
#pragma unroll
        for (int ks = 0; ks < 8; ++ks) {
            const bf16x8 bq = *(const bf16x8*)(QP + tok * PQW + hh * PQD + p * PHALF + 16 * ks + 8 * hi);
#pragma unroll
            for (int nb = 0; nb < 4; ++nb) {
                const bf16x8 ak = *(const bf16x8*)(KEYS + ((size_t)(hh * 2 + p) * PNK + 32 * nb + r) * PHALF + 16 * ks + 8 * hi);
                sc[nb] = __builtin_amdgcn_mfma_f32_32x32x16_bf16(ak, bq, sc[nb], 0, 0, 0); } }
        float v[64];
#pragma unroll
        for (int nb = 0; nb < 4; ++nb)
#pragma unroll
            for (int i = 0; i < 16; ++i) { const unsigned n = 32 * nb + (i & 3) + 8 * (i >> 2) + 4 * hi;
                const float scv = sc[nb][i]; v[nb * 16 + i] = __uint_as_float((__float_as_uint(scv) & 0xffffff80u) | n); }
        top16_of_64(v);
#pragma unroll
        for (int i = 0; i < 16; ++i) v[16 + i] = __shfl_xor(v[i], 32);
        merge_top16(v, 0, 16);
#pragma unroll
        for (int k = 0; k < 16; ++k) top[(p * 16 + k) * 64 + lane] = v[k];
    }
    LDS_WAIT();
    float sv0[16], sv1[16];
#pragma unroll
    for (int a = 0; a < 16; ++a) { sv0[a] = top[a * 64 + lane]; sv1[a] = top[(16 + a) * 64 + lane]; }
    float cd[64];
    { int c = 0;
#pragma unroll
      for (int a = 0; a < 16; ++a)
#pragma unroll
        for (int b = 0; b < 16; ++b) if ((a + 1) * (b + 1) <= 16) { cd[c] = __builtin_bit_cast(float, (__builtin_bit_cast(unsigned, sv0[a] + sv1[b]) & ~255u) | (unsigned)(a * 16 + b)); ++c; }
#pragma unroll
      for (int i = 50; i < 64; ++i) cd[i] = -INFINITY; }
    top16_of_64(cd);
#pragma unroll
    for (int k = 0; k < 16; ++k) top[(32 + k) * 64 + lane] = cd[k];
    LDS_WAIT();
    if (hi == 0) {
        const float s0 = top[32 * 64 + lane]; float ev[16]; int ei[16]; float sum = 0.f;
#pragma unroll
        for (int k = 0; k < 16; ++k) { const float s = top[(32 + k) * 64 + lane]; const unsigned code = __builtin_bit_cast(unsigned, s) & 255u, a = code >> 4, b = code & 15u;
            const unsigned i0 = __builtin_bit_cast(unsigned, top[a * 64 + lane]) & 127u, i1 = __builtin_bit_cast(unsigned, top[(16 + b) * 64 + lane]) & 127u;
            ei[k] = (int)(i0 * PNK + i1); ev[k] = __expf(s - s0); sum += ev[k]; }
        const float inv = 1.0f / sum;
        int rv = r; asm volatile("" : "+v"(rv));
#pragma unroll
        for (int k = 0; k < 16; ++k) { pe[rv * 128 + hh * 16 + k] = ei[k]; pg[rv * 128 + hh * 16 + k] = ev[k] * inv; }
    }
    LDS_WAIT();
}

__device__ __forceinline__ void order_pairs(const Ctx& C, int tb, LAS unsigned char* lds, int tid) {
    LAS int* pe = (LAS int*)(lds + 98304); LAS float* pg = (LAS float*)(lds + 98304 + 16384);
    LAS int* pe2 = (LAS int*)lds; LAS float* pg2 = (LAS float*)(lds + 32 * 129 * 4);
    int* lidx = (int*)(C.ws + WS_LIDX); float* lg = (float*)(C.ws + WS_LG); int* na = (int*)(C.ws + WS_NA);
    const int tk = tid >> 4, sub = tid & 15;
    int e[8]; float g[8]; int cnt = 0;
#pragma unroll
    for (int i = 0; i < 8; ++i) { e[i] = pe[tk * 128 + sub * 8 + i]; g[i] = pg[tk * 128 + sub * 8 + i]; cnt += (e[i] < PNE / 2) ? 1 : 0; }
    int inc = cnt;
#pragma unroll
    for (int o = 1; o < 16; o <<= 1) { const int v = __shfl_up(inc, o, 16); if (sub >= o) inc += v; }
    const int total = __shfl(inc, 15, 16); int pa = inc - cnt, pb = total + (sub * 8 - (inc - cnt));
#pragma unroll
    for (int i = 0; i < 8; ++i) { const bool isa = e[i] < PNE / 2; const int pos = isa ? pa : pb; pa += isa ? 1 : 0; pb += isa ? 0 : 1; pe2[tk * 129 + pos] = e[i]; pg2[tk * 129 + pos] = g[i]; }
    if (sub == 0) na[tb * 32 + tk] = total;
    __syncthreads();
#pragma unroll
    for (int i = 0; i < 8; ++i) { const int idx = i * 512 + tid, pos = idx >> 5, t2 = idx & 31;
        lidx[(size_t)pos * M + tb * 32 + t2] = pe2[t2 * 129 + pos]; lg[(size_t)pos * M + tb * 32 + t2] = pg2[t2 * 129 + pos]; }
}

__device__ __forceinline__ void expert_convert_unit(const Ctx& C, int u, LAS unsigned char* lds, int tid) {
    const int tbl = u >> 12, eb = (u >> 4) & 255, r = u & 15, row = tid >> 3, cq = tid & 7;
    const float* src = (tbl ? C.ev : C.eu) + (size_t)(eb * 64 + row) * D + r * 256 + cq * 32;
    f32x4 v[8]; float am = 0.f;
#pragma unroll
    for (int j = 0; j < 8; ++j) { v[j] = ((const f32x4*)src)[j]; am = fmaxf(am, fmaxf(fmaxf(fabsf(v[j][0]), fabsf(v[j][1])), fmaxf(fabsf(v[j][2]), fabsf(v[j][3])))); }
    am = fmaxf(am, __shfl_xor(am, 1)); am = fmaxf(am, __shfl_xor(am, 2)); am = fmaxf(am, __shfl_xor(am, 4));
    const float sc = am > 0.f ? 127.0f / am : 0.f, inv = am * (1.0f / 127.0f);
#pragma unroll
    for (int i = 0; i < 4; ++i) { unsigned w[2];
#pragma unroll
        for (int h = 0; h < 2; ++h) { const f32x4 x = v[2 * i + h] * sc;
            w[h] = (unsigned)((int)rintf(x[0]) & 255) | ((unsigned)((int)rintf(x[1]) & 255) << 8) | ((unsigned)((int)rintf(x[2]) & 255) << 16) | ((unsigned)((int)rintf(x[3]) & 255) << 24); }
        *(LAS u32x2*)(lds + (cq * 4 + i) * 512 + row * 8) = (u32x2){w[0], w[1]}; }
    if (cq == 0) ((float*)(C.ws + WS_ESC))[(size_t)PNE * 16 + (size_t)r * PNE + eb * 64 + row] = inv;
    __syncthreads();
    unsigned char* dst = C.ws + WS_E8 + (size_t)tbl * (64 * MiB);
#pragma unroll
    for (int i = 0; i < 2; ++i) { const int p = tid + 512 * i, ls = p >> 5, off = (p & 31) * 16;
        *(u32x4*)(dst + ((size_t)(r * 32 + ls) * PNE + eb * 64) * 8 + off) = *(const LAS u32x4*)(lds + ls * 512 + off); }
    __syncthreads();
}
__device__ __forceinline__ void expert_convert_u(const Ctx& C, int e, int lane) {
    const f32x4* src = (const f32x4*)(C.eu + (size_t)e * D) + lane;
    f32x4 v[16]; float am = 0.f;
#pragma unroll
    for (int j = 0; j < 16; ++j) v[j] = src[j * 64];
#pragma unroll
    for (int j = 0; j < 16; ++j) am = fmaxf(am, fmaxf(fmaxf(fabsf(v[j][0]), fabsf(v[j][1])), fmaxf(fabsf(v[j][2]), fabsf(v[j][3]))));
    am = wave_max_nonneg(am);
    const float sc = am > 0.f ? 127.0f / am : 0.f;
    const int el = e >> 4, et = (e ^ (e >> 7)) & 15, sw = (el >> 1) & 7;
    unsigned char* dst = C.ws + WS_E8 + ((size_t)(et * 32 + (lane >> 5)) * 1024 + el) * 128 + (((((lane & 31) >> 2) ^ sw) << 4) | ((lane & 3) << 2));
#pragma unroll
    for (int j = 0; j < 16; ++j) { const f32x4 x = v[j] * sc;
        *(unsigned*)(dst + (size_t)j * 262144) = (unsigned)((int)rintf(x[0]) & 255) | ((unsigned)((int)rintf(x[1]) & 255) << 8) | ((unsigned)((int)rintf(x[2]) & 255) << 16) | ((unsigned)((int)rintf(x[3]) & 255) << 24); }
    if (lane == 0) ((float*)(C.ws + WS_ESC))[e] = am * (1.0f / 127.0f);
}
#define PEER_FILL(tblbase, slice) do { const unsigned char* g_ = (tblbase) + (size_t)(slice) * (PNE * 8) + lane * 16; \
    _Pragma("unroll") for (int i_ = 0; i_ < 16; ++i_) { const int c_ = wave * 16 + i_; \
        __builtin_amdgcn_global_load_lds((const unsigned*)(g_ + c_ * 1024), (LAS unsigned*)(lds + c_ * 1024), 16, 0, 0); } } while (0)
#define PEER_WARM(tblbase, slice) do { const unsigned char* g_ = (tblbase) + (size_t)(slice) * (PNE * 8) + lane * 16; \
    _Pragma("unroll") for (int i_ = 0; i_ < 16; ++i_) { const int c_ = wave * 16 + i_; \
        __builtin_amdgcn_global_load_lds((const unsigned*)(g_ + c_ * 1024), (LAS unsigned*)(lds + 131072 + wave * 1024), 16, 0, 0); } } while (0)
typedef int i32x4 __attribute__((ext_vector_type(4)));
constexpr int UNG = 12;
__device__ __forceinline__ void peer_u_item(const Ctx& C, int tg, int et, LAS unsigned char* lds, int tid, int wave, int lane) {
    const int* lidx = (const int*)(C.ws + WS_LIDX); const signed char* H8 = (const signed char*)(C.ws + WS_H8); float* S = (float*)(C.ws + WS_PART); const float* sh = (const float*)(C.ws + WS_SH);
    const unsigned char* U8M = C.ws + WS_E8;
    const int tokw = tg * 512 + wave * 64;
    LAS int* Wa = (LAS int*)(lds + wave * 16384); LAS int* Wcn = Wa + 1280; LAS int* Wt = Wa + 1344; LAS int* Wo = Wa + 2048;
    __syncthreads();
#pragma unroll
    for (int i = 0; i < 20; ++i) Wa[i * 64 + lane] = -1;
    Wcn[lane] = 0;
    LDS_WAIT();
#define UCOL(q_) (((q_) & 1) ? 4 + ((q_) >> 1) : ((((q_) >> 1) < 4) ? ((q_) >> 1) : ((q_) >> 1) + 8))
#define PU_SLOW(tokl_, k2_, el_) do { const int tok_ = tokw + (tokl_), sw_ = ((el_) >> 1) & 7; int dsum_ = 0; \
        const unsigned char* trow_ = U8M + ((size_t)(et * 32 + (lane >> 1)) * 1024 + (el_)) * 128; \
        _Pragma("unroll") for (int q_ = 0; q_ < 4; ++q_) { const i32x4 hv_ = *(const i32x4*)(H8 + (size_t)tok_ * D + lane * 64 + q_ * 16), tv_ = *(const i32x4*)(trow_ + ((((lane & 1) * 4 + q_) ^ sw_) << 4)); \
            dsum_ = __builtin_amdgcn_sdot4(hv_[0], tv_[0], dsum_, false); dsum_ = __builtin_amdgcn_sdot4(hv_[1], tv_[1], dsum_, false); dsum_ = __builtin_amdgcn_sdot4(hv_[2], tv_[2], dsum_, false); dsum_ = __builtin_amdgcn_sdot4(hv_[3], tv_[3], dsum_, false); } \
        _Pragma("unroll") for (int o_ = 32; o_ >= 1; o_ >>= 1) dsum_ += __shfl_xor(dsum_, o_); \
        if (lane == 0) S[(size_t)(k2_) * M + tok_] = (float)dsum_ * sh[tok_]; } while (0)
    const int sgl = lane >> 4, tl = lane & 15;
    {
      int oc = 0;
      unsigned loff = (unsigned)(tokw + lane) * 4u;
#pragma unroll 1
      for (int kb = 0; kb < 2; ++kb) { int ev[64];
#pragma unroll
          for (int j = 0; j < 64; ++j) { ev[j] = *(const int*)((const char*)lidx + loff); loff += (unsigned)M * 4u; asm volatile("" : "+v"(loff)); }
#pragma unroll
          for (int j0 = 0; j0 < 64; j0 += 8) { int rk[8]; int oc = 0;
#pragma unroll
              for (int i = 0; i < 8; ++i) { const int e = ev[j0 + i], q = (e >> 4) & 15; rk[i] = 0;
                  if (((e ^ (e >> 7)) & 15) == et) rk[i] = __hip_atomic_fetch_add(&Wcn[sgl * 16 + q], 1, __ATOMIC_RELAXED, __HIP_MEMORY_SCOPE_WORKGROUP); }
#pragma unroll
              for (int i = 0; i < 8; ++i) { const int e = ev[j0 + i], k = kb * 64 + j0 + i, el = e >> 4, q = el & 15; const bool match = ((e ^ (e >> 7)) & 15) == et;
                  if (match && rk[i] < 20) Wa[sgl * 320 + rk[i] * 16 + UCOL(q)] = el | (tl << 10) | (k << 14);
                  const bool ov = match && rk[i] >= 20;
                  const unsigned long long ovm = __builtin_amdgcn_ballot_w64(ov);
                  if (ov) Wo[oc + (int)__builtin_amdgcn_mbcnt_hi((unsigned)(ovm >> 32), __builtin_amdgcn_mbcnt_lo((unsigned)ovm, 0u))] = (lane << 17) | (k << 10) | el;
                  oc += __builtin_popcountll(ovm); }
              if (oc != 0) { LDS_WAIT();
#pragma unroll 1
                  for (int u = 0; u < oc; ++u) { const int ent = __builtin_amdgcn_readfirstlane(Wo[u]); PU_SLOW(ent >> 17, (ent >> 10) & 127, ent & 1023); } } } }
    }
    LDS_WAIT();
    int NGs;
    {
      const int cq = min(Wcn[lane], 20); int N = cq;
#pragma unroll
      for (int o = 1; o < 16; o <<= 1) N += __shfl_xor(N, o, 16);
      NGs = (N > 160) ? 12 : 10;
      const int exc = max(cq - NGs, 0), fre = max(NGs - cq, 0); int ie = exc, ifr = fre;
#pragma unroll
      for (int o = 1; o < 16; o <<= 1) { const int v0 = __shfl_up(ie, o, 16), v1 = __shfl_up(ifr, o, 16); if (tl >= o) { ie += v0; ifr += v1; } }
      const int E = __shfl(ie, 15, 16), F = __shfl(ifr, 15, 16), exoff = ie - exc, froff = ifr - fre, nq = UCOL(tl);
#pragma unroll
      for (int i = 0; i < 10; ++i) if (i < exc) Wt[sgl * 128 + exoff + i] = Wa[sgl * 320 + (NGs + i) * 16 + nq];
      LDS_WAIT();
#pragma unroll
      for (int j = 0; j < 12; ++j) if (j < fre && froff + j < E) Wa[sgl * 320 + (cq + j) * 16 + nq] = Wt[sgl * 128 + froff + j];
      LDS_WAIT();
#pragma unroll
      for (int s4 = 0; s4 < 4; ++s4) { const int Es = __builtin_amdgcn_readlane(E, s4 * 16), Fs = __builtin_amdgcn_readlane(F, s4 * 16);
#pragma unroll 1
          for (int i = Fs; i < Es; ++i) { const int ent = __builtin_amdgcn_readfirstlane(Wt[s4 * 128 + i]); PU_SLOW(s4 * 16 + ((ent >> 10) & 15), (ent >> 14) & 127, ent & 1023); } }
    }
#undef PU_SLOW
    const int n = lane & 15, g = lane >> 4;
    unsigned ci[4][UNG]; int acc[4][UNG]; int NP[4];
    { const int qn = (n >= 4 && n < 12) ? (n - 4) * 2 + 1 : ((n < 4) ? n : n - 8) * 2;
#pragma unroll
      for (int s4 = 0; s4 < 4; ++s4) { NP[s4] = __builtin_amdgcn_readlane(NGs, s4 * 16) >> 1;
#pragma unroll
        for (int m = 0; m < UNG; ++m) { const int raw = Wa[s4 * 320 + m * 16 + n]; const bool valid = raw >= 0;
            const int row = valid ? (raw & 1023) : qn, tl2 = valid ? ((raw >> 10) & 15) : 0, k = valid ? ((raw >> 14) & 127) : 0;
            ci[s4][m] = (unsigned)(row * 128 + ((g ^ ((row >> 1) & 7)) << 4)) | ((unsigned)k << 17) | ((unsigned)(tl2 >> 2) << 24) | ((unsigned)(valid ? 1 : 0) << 26) | ((unsigned)((tl2 >> 1) & 1) << 30) | ((unsigned)(tl2 & 1) << 31);
            acc[s4][m] = 0; } } }
#undef UCOL
    const char* H8c = (const char*)H8; const unsigned aoff = (unsigned)(tokw + n) * (unsigned)D + (unsigned)g * 16u;
    i32x4 a[4][2];
#define PU_ALOAD(s_, ks_) do { _Pragma("unroll") for (int h_ = 0; h_ < 2; ++h_) a[s_][h_] = *(const i32x4*)(H8c + (aoff + (unsigned)((ks_) * 128 + (s_) * 16 * D + h_ * 64))); } while (0)
#define PU_LOAD2(dst, s_, m_) do { const unsigned a0_ = ci[s_][m_] & 0x1ffffu, a1_ = ci[s_][(m_) + 1] & 0x1ffffu; \
        dst[0][0] = *(const LAS i32x4*)(lds + a0_); dst[1][0] = *(const LAS i32x4*)(lds + a1_); dst[0][1] = *(const LAS i32x4*)(lds + (a0_ ^ 64u)); dst[1][1] = *(const LAS i32x4*)(lds + (a1_ ^ 64u)); } while (0)
#define PU_SEL(d_, c_, ac_) do { const int m0_ = (int)(c_) >> 31, m1_ = __builtin_amdgcn_sbfe((int)(c_), 30u, 1u); \
        const int lo_ = (d_[1] & m0_) | (d_[0] & ~m0_), hi_ = (d_[3] & m0_) | (d_[2] & ~m0_); ac_ += (hi_ & m1_) | (lo_ & ~m1_); } while (0)
#define PU_PAIR(src, s_, m_) do { i32x4 d0_ = {0, 0, 0, 0}, d1_ = {0, 0, 0, 0}; \
        d0_ = __builtin_amdgcn_mfma_i32_16x16x64_i8(a[s_][0], src[0][0], d0_, 0, 0, 0); d1_ = __builtin_amdgcn_mfma_i32_16x16x64_i8(a[s_][0], src[1][0], d1_, 0, 0, 0); \
        d0_ = __builtin_amdgcn_mfma_i32_16x16x64_i8(a[s_][1], src[0][1], d0_, 0, 0, 0); d1_ = __builtin_amdgcn_mfma_i32_16x16x64_i8(a[s_][1], src[1][1], d1_, 0, 0, 0); \
        PU_SEL(d0_, ci[s_][m_], acc[s_][m_]); PU_SEL(d1_, ci[s_][(m_) + 1], acc[s_][(m_) + 1]); asm volatile("" : "+v"(acc[s_][m_]), "+v"(acc[s_][(m_) + 1])); } while (0)
#pragma unroll
    for (int s4 = 0; s4 < 4; ++s4) PU_ALOAD(s4, 0);
#pragma unroll 1
    for (int ks = 0; ks < 32; ++ks) {
        __syncthreads();
#pragma unroll
        for (int s4 = 0; s4 < 4; ++s4)
#pragma unroll
            for (int m = 0; m < UNG; ++m) asm volatile("" : "+v"(ci[s4][m]));
        PEER_FILL(U8M, et * 32 + ks);
        if (tg == (ks & 15) && ks + 1 < 32) PEER_WARM(U8M, et * 32 + ks + 1);
        VM_WAIT(); __syncthreads();
        {
          i32x4 bA[2][2], bB[2][2], bC[2][2];
          PU_LOAD2(bA, 0, 0); PU_LOAD2(bB, 0, 2); PU_LOAD2(bC, 0, 4);
#pragma unroll
          for (int blk = 0; blk < 24; ++blk) { const int s4 = blk / 6, p = blk % 6, nb = blk + 3, ns = nb / 6, np = nb % 6;
              if (blk % 3 == 0)      { if (p < 5 || NP[s4] > 5) PU_PAIR(bA, s4, 2 * p); if (nb < 24 && (np < 5 || NP[ns] > 5)) PU_LOAD2(bA, ns, 2 * np); }
              else if (blk % 3 == 1) { if (p < 5 || NP[s4] > 5) PU_PAIR(bB, s4, 2 * p); if (nb < 24 && (np < 5 || NP[ns] > 5)) PU_LOAD2(bB, ns, 2 * np); }
              else                   { if (p < 5 || NP[s4] > 5) PU_PAIR(bC, s4, 2 * p); if (nb < 24 && (np < 5 || NP[ns] > 5)) PU_LOAD2(bC, ns, 2 * np); }
              __builtin_amdgcn_sched_barrier(0);
              if (p == 5) { if (ks + 1 < 32) PU_ALOAD(s4, ks + 1);
                  __builtin_amdgcn_sched_barrier(0); } } }
    }
#undef PU_ALOAD
#undef PU_LOAD2
#undef PU_SEL
#undef PU_PAIR
#pragma unroll
    for (int s4 = 0; s4 < 4; ++s4)
#pragma unroll
        for (int m = 0; m < UNG; ++m) { if ((m >> 1) < NP[s4]) { const unsigned c = ci[s4][m];
            if (((c >> 26) & 1u) != 0u && (int)((c >> 24) & 3u) == g) { const int tok = tokw + s4 * 16 + g * 4 + (int)(c >> 31) + 2 * (int)((c >> 30) & 1u), k = (int)((c >> 17) & 127u);
                S[(size_t)k * M + tok] = (float)acc[s4][m] * sh[tok]; } } }
    __syncthreads();
}
__device__ __forceinline__ void peer_gates(const Ctx& C, int gt, int NGT) {
    const int* lidx = (const int*)(C.ws + WS_LIDX); const float* lg = (const float*)(C.ws + WS_LG); const float* part = (const float*)(C.ws + WS_PART);
    const float* usc = (const float*)(C.ws + WS_ESC); float* at = (float*)(C.ws + WS_AT);
#pragma unroll 4
    for (int idx = gt; idx < 128 * M; idx += NGT) { const int e = lidx[idx]; const float s = part[idx] * usc[e];
        at[idx] = 0.5f * s * (1.0f + erff(s * 0.70710678f)) * lg[idx]; }
}
__device__ __forceinline__ void peer_v_item(const Ctx& C, int tg, int r, LAS unsigned char* lds, int tid, int wave, int lane) {
    const int* lidx = (const int*)(C.ws + WS_LIDX); const float* at = (const float*)(C.ws + WS_AT); const unsigned char* vscr = (const unsigned char*)((const float*)(C.ws + WS_ESC) + (size_t)PNE * 16 + (size_t)r * PNE);
    const unsigned char* V8T = C.ws + WS_E8 + 64 * MiB; bf16* ft = (bf16*)(C.ws + WS_FT);
    const int t = tg * 512 + tid;
    unsigned ei[64], a8[32]; float os;
    { float af[128]; float am = 0.f;
      __syncthreads();
#pragma unroll
      for (int i = 0; i < 8; ++i) { const int c = wave * 8 + i; __builtin_amdgcn_global_load_lds((const unsigned*)(vscr + c * 1024 + lane * 16), (LAS unsigned*)(lds + c * 1024), 16, 0, 0); }
      VM_WAIT(); __syncthreads();
      unsigned loff = (unsigned)t * 4u;
#pragma unroll
      for (int j = 0; j < 64; ++j) { const unsigned e0 = *(const unsigned*)((const char*)lidx + loff), e1 = *(const unsigned*)((const char*)lidx + (loff + (unsigned)M * 4u)); ei[j] = e0 | (e1 << 16);
          af[2 * j] = *(const float*)((const char*)at + loff) * *(const LAS float*)(lds + e0 * 4u); af[2 * j + 1] = *(const float*)((const char*)at + (loff + (unsigned)M * 4u)) * *(const LAS float*)(lds + e1 * 4u);
          loff += 2u * M * 4u; asm volatile("" : "+v"(loff));
          if ((j & 7) == 7) __builtin_amdgcn_sched_barrier(0); }
#pragma unroll
      for (int k = 0; k < 128; ++k) am = fmaxf(am, fabsf(af[k]));
      const float q = am > 0.f ? 127.0f / am : 0.f; os = am * (1.0f / 127.0f);
#pragma unroll
      for (int j = 0; j < 32; ++j) a8[j] = (unsigned)((int)rintf(af[4 * j] * q) & 255) | ((unsigned)((int)rintf(af[4 * j + 1] * q) & 255) << 8) | ((unsigned)((int)rintf(af[4 * j + 2] * q) & 255) << 16) | ((unsigned)((int)rintf(af[4 * j + 3] * q) & 255) << 24); }
#pragma unroll 1
    for (int s = 0; s < 32; ++s) { const int slice = r * 32 + s;
        __syncthreads();
#pragma unroll
        for (int j = 0; j < 64; ++j) asm volatile("" : "+v"(ei[j]));
        PEER_FILL(V8T, slice);
        if (tg == (s & 15) && s + 1 < 32) PEER_WARM(V8T, slice + 1);
        VM_WAIT(); __syncthreads();
        int o[8];
#pragma unroll
        for (int i = 0; i < 8; ++i) o[i] = 0;
#define PV_LOAD(dst, k0) do { _Pragma("unroll") for (int j_ = 0; j_ < 8; ++j_) { const int k_ = (k0) + j_; const unsigned e_ = (k_ & 1) ? (ei[k_ >> 1] >> 16) : (ei[k_ >> 1] & 0xffffu); dst[j_] = *(const LAS u32x2*)(lds + e_ * 8); } } while (0)
#define PV_Q(w0, w1, w2, w3, ab, ob) do { const unsigned t0_ = __builtin_amdgcn_perm(w1, w0, 0x05010400u), t1_ = __builtin_amdgcn_perm(w1, w0, 0x07030602u), u0_ = __builtin_amdgcn_perm(w3, w2, 0x05010400u), u1_ = __builtin_amdgcn_perm(w3, w2, 0x07030602u); \
            o[ob] = __builtin_amdgcn_sdot4((int)__builtin_amdgcn_perm(u0_, t0_, 0x05040100u), ab, o[ob], false); o[ob + 1] = __builtin_amdgcn_sdot4((int)__builtin_amdgcn_perm(u0_, t0_, 0x07060302u), ab, o[ob + 1], false); \
            o[ob + 2] = __builtin_amdgcn_sdot4((int)__builtin_amdgcn_perm(u1_, t1_, 0x05040100u), ab, o[ob + 2], false); o[ob + 3] = __builtin_amdgcn_sdot4((int)__builtin_amdgcn_perm(u1_, t1_, 0x07060302u), ab, o[ob + 3], false); } while (0)
#define PV_DOT(src, k0) do { const int a0_ = (int)a8[(k0) >> 2], a1_ = (int)a8[((k0) >> 2) + 1]; \
            PV_Q(src[0].x, src[1].x, src[2].x, src[3].x, a0_, 0); PV_Q(src[0].y, src[1].y, src[2].y, src[3].y, a0_, 4); \
            PV_Q(src[4].x, src[5].x, src[6].x, src[7].x, a1_, 0); PV_Q(src[4].y, src[5].y, src[6].y, src[7].y, a1_, 4); } while (0)
        u32x2 wa[8], wb[8];
        PV_LOAD(wa, 0);
#pragma unroll
        for (int k16 = 0; k16 < 128; k16 += 16) {
            PV_LOAD(wb, k16 + 8); PV_DOT(wa, k16); __builtin_amdgcn_sched_barrier(0);
            if (k16 + 16 < 128) PV_LOAD(wa, k16 + 16);
            PV_DOT(wb, k16 + 8); __builtin_amdgcn_sched_barrier(0); }
#undef PV_LOAD
#undef PV_Q
#undef PV_DOT
        u32x4 ow; ow.x = pk2((float)o[0] * os, (float)o[1] * os); ow.y = pk2((float)o[2] * os, (float)o[3] * os); ow.z = pk2((float)o[4] * os, (float)o[5] * os); ow.w = pk2((float)o[6] * os, (float)o[7] * os);
        *(u32x4*)(ft + ((size_t)slice * M + t) * 8) = ow;
    }
    __syncthreads();
}
constexpr int FROWB = D * 2 + 16;
constexpr int FVEC = 8 * FROWB;
__device__ __forceinline__ void final_units(const Ctx& C, int u0, int ustep, LAS unsigned char* lds, int tid, int wave, int lane) {
#define FU_LBAR() do { asm volatile("s_waitcnt lgkmcnt(0)" ::: "memory"); __builtin_amdgcn_s_barrier(); asm volatile("" ::: "memory"); } while (0)
    const bf16* ft = (const bf16*)(C.ws + WS_FT); const bf16* MIX = (const bf16*)(C.ws + WS_Y);
    const float* mod = (const float*)(C.ws + WS_MOD); const float* modf = mod + 2 * 6 * D;
    u32x4 pf[8]; int bcur = -1;
#define FU_GATHER(unit_) do { int tidv_ = tid; asm volatile("" : "+v"(tidv_));   \
        _Pragma("unroll") for (int i = 0; i < 8; ++i) { const int p = i * 512 + tidv_, slice = p >> 3, q = p & 7;                      \
            pf[i] = *(const u32x4*)(ft + ((size_t)slice * M + (unit_) * 8 + q) * 8); } } while (0)
    __syncthreads();
    if (u0 < M / 8) FU_GATHER(u0);
    for (int unit = u0; unit < M / 8; unit += ustep) { const int t0 = unit * 8, b = t0 >> 12;
        if (b != bcur) { bcur = b;
            const float* v0 = mod + (size_t)b * 6 * D + 5 * D; const float* v1 = C.g_f; const float* v2 = modf + (size_t)b * 2 * D; const float* v3 = modf + (size_t)b * 2 * D + D;
#pragma unroll
            for (int i = 0; i < 2; ++i) { const int c4 = tid + 512 * i;
                *(LAS f32x4*)(lds + FVEC + c4 * 16) = ((const f32x4*)v0)[c4]; *(LAS f32x4*)(lds + FVEC + 16384 + c4 * 16) = ((const f32x4*)v1)[c4];
                *(LAS f32x4*)(lds + FVEC + 32768 + c4 * 16) = ((const f32x4*)v2)[c4]; *(LAS f32x4*)(lds + FVEC + 49152 + c4 * 16) = ((const f32x4*)v3)[c4]; } }
        { int tidv = tid; asm volatile("" : "+v"(tidv));
#pragma unroll
          for (int i = 0; i < 8; ++i) { const int p = i * 512 + tidv, slice = p >> 3, q = p & 7; *(LAS u32x4*)(lds + q * FROWB + slice * 16) = pf[i]; } }
        const int m = t0 + wave; f32x4 f[16]; u32x2 aw[16]; float ss = 0.f; int lanev = lane; asm volatile("" : "+v"(lanev));
        const char* mp = (const char*)(MIX + (size_t)m * D); char* op = (char*)(C.out + (size_t)m * D);
#pragma unroll
        for (int j = 0; j < 16; ++j) { const unsigned cb = (unsigned)(64 * j + lanev) * 8u; aw[j] = *(const u32x2*)(mp + cb); }
        FU_LBAR();
        if (unit + ustep < M / 8) FU_GATHER(unit + ustep);
        asm volatile("" : "+v"(lanev));
#pragma unroll
        for (int j = 0; j < 16; ++j) { const unsigned cb = (unsigned)(64 * j + lanev) * 16u;
            const f32x4 gtv = *(const LAS f32x4*)(lds + FVEC + cb); const u32x2 fw = *(const LAS u32x2*)(lds + wave * FROWB + (cb >> 1));
            const f32x4 fv = {bf2f(fw.x & 0xffffu), bf2f(fw.x >> 16), bf2f(fw.y & 0xffffu), bf2f(fw.y >> 16)};
            f[j] = (f32x4){bf2f(aw[j].x & 0xffffu), bf2f(aw[j].x >> 16), bf2f(aw[j].y & 0xffffu), bf2f(aw[j].y >> 16)} + gtv * fv;
            ss += (f[j][0] * f[j][0] + f[j][1] * f[j][1]) + (f[j][2] * f[j][2] + f[j][3] * f[j][3]); if ((j & 3) == 3) __builtin_amdgcn_sched_barrier(0); }
        const float rs = rsqrtf(wave_sum(ss) * (1.0f / D) + EPS);
#pragma unroll
        for (int j = 0; j < 16; ++j) { const unsigned cb = (unsigned)(64 * j + lanev) * 16u;
            const f32x4 gg = *(const LAS f32x4*)(lds + FVEC + 16384 + cb), sh = *(const LAS f32x4*)(lds + FVEC + 32768 + cb), sc = *(const LAS f32x4*)(lds + FVEC + 49152 + cb);
            *(f32x4*)(op + cb) = f[j] * rs * gg * (sc + 1.0f) + sh; if ((j & 3) == 3) __builtin_amdgcn_sched_barrier(0); }
        FU_LBAR();
    }
    __syncthreads();
#undef FU_GATHER
#undef FU_LBAR
}

constexpr int NPHASE = 14;
struct Args { const void* in[25]; float* out; unsigned char* ws; int ph_lo, ph_hi; };
__global__ void __launch_bounds__(NTHR, 2) fwd(Args args) {
    extern __shared__ __attribute__((aligned(16))) unsigned char lds_raw[];
    LAS unsigned char* lds = (LAS unsigned char*)lds_raw;
    int tid = threadIdx.x, lane = tid & 63; const int wave = __builtin_amdgcn_readfirstlane(tid >> 6);
#define REFRESH_IDS() do { lane = (int)__builtin_amdgcn_mbcnt_hi(~0u, __builtin_amdgcn_mbcnt_lo(~0u, 0u)); tid = wave * 64 + lane; } while (0)
    const int G = gridDim.x, bx = blockIdx.x, vcu = (G % 8 == 0) ? (bx % 8) * (G / 8) + bx / 8 : bx;
    const int gw = vcu * NWAVES + wave, NGW = G * NWAVES;
    Ctx C;
    C.x = (const float*)args.in[0]; C.c = (const float*)args.in[1]; C.pos = (const int*)args.in[2]; C.w_ada = (const float*)args.in[3]; C.b_ada = (const float*)args.in[4];
    C.g_mix = (const float*)args.in[5]; C.w_in = (const float*)args.in[6]; C.g_q = (const float*)args.in[7]; C.w_uq = (const float*)args.in[8]; C.g_kv = (const float*)args.in[9];
    C.w_ukv = (const float*)args.in[10]; C.g_sgu = (const float*)args.in[11]; C.w_sgu = (const float*)args.in[12]; C.b_sgu = (const float*)args.in[13]; C.beta_mla = (const float*)args.in[14];
    C.beta_g = (const float*)args.in[15]; C.w_out = (const float*)args.in[16]; C.g_ffn = (const float*)args.in[17]; C.w_pq = (const float*)args.in[18]; C.pkeys = (const float*)args.in[19];
    C.eu = (const float*)args.in[20]; C.ev = (const float*)args.in[21]; C.w_adaf = (const float*)args.in[22]; C.b_adaf = (const float*)args.in[23]; C.g_f = (const float*)args.in[24];
    C.out = args.out; C.ws = args.ws;
    unsigned* ctl = (unsigned*)(C.ws + WS_CTL);
    float* mod = (float*)(C.ws + WS_MOD);
    for (int u = tid; u < (LDS_BYTES - LDSCTL_OFF) / 4; u += NTHR) ((LAS unsigned*)(lds + LDSCTL_OFF))[u] = 0u;
    __syncthreads();
    const int lo = args.ph_lo, hi = args.ph_hi;
    XcdBarrier bar; bar.bar = ctl + CW_BAR; bar.x = 0; bar.st = (volatile LAS unsigned*)(lds + LDSCTL_OFF + 64);
    if (hi - lo > 1) bar = xcd_barrier_post(ctl + CW_BAR, (volatile LAS unsigned*)(lds + LDSCTL_OFF + 64));
#define IN(k) (lo <= (k) && (k) < hi)
#define SEAM(k) do { if (IN(k) && IN((k) + 1)) xcd_barrier(bar); } while (0)

    if (IN(0)) { REFRESH_IDS();
        for (int u = vcu; u < 256; u += G) ada_unit(C, u, (LAS float*)lds, tid, wave, lane);
        LAS float* scr = (LAS float*)(lds + wave * 16384);
        constexpr int I1 = (D / 64) * (INWP / 32), I2 = (QLR / 64) * (NH * QKD / 32), I3 = (KVLR / 64) * (NH * 256 / 32), I4 = (D / 64) * (D / 32), I5 = (D / 64) * (PQW / 32);
        constexpr float QSCALE = 1.4426950408889634f * 0.07216878364870322f;
        for (int it = gw; it < I1 + I2 + I3 + I4 + I5; it += NGW) {
            int q = it;
            if (q < I1) { transpose_item<MAP_W1>(C.w_in, D, INW, INWP, (bf16*)(C.ws + WS_W1T), nullptr, 1.0f, scr, q, lane); continue; } q -= I1;
            if (q < I2) { transpose_item<MAP_UQ>(C.w_uq, QLR, NH * QKD, NH * QKD, (bf16*)(C.ws + WS_WUQT), C.g_q, QSCALE, scr, q, lane); continue; } q -= I2;
            if (q < I3) { transpose_item<MAP_ID>(C.w_ukv, KVLR, NH * 256, NH * 256, (bf16*)(C.ws + WS_WUKVT), C.g_kv, 1.0f, scr, q, lane); continue; } q -= I3;
            if (q < I4) { const int kb = q / (D / 32); const float* ks = (kb < 32) ? C.beta_mla : C.beta_g - GW;
                          transpose_item<MAP_ID>(C.w_out, D, D, D, (bf16*)(C.ws + WS_WOUTT), ks, 1.0f, scr, q, lane); continue; } q -= I4;
            transpose_item<MAP_ID>(C.w_pq, D, PQW, PQW, (bf16*)(C.ws + WS_WPQT), nullptr, 1.0f, scr, q, lane);
        }
        const int gt = vcu * NTHR + tid, NGT = G * NTHR;
        { bf16* kd = (bf16*)(C.ws + WS_KEYS); for (int i = gt; i < PH * 2 * PNK * PHALF; i += NGT) kd[i] = (bf16)f2bf(C.pkeys[i]); }
        { bf16* wd = (bf16*)(C.ws + WS_WSGU); for (int i = gt; i < GH * GC * GC; i += NGT) { const int s = i & 127, t = (i >> 7) & 127; wd[i] = (bf16)(s <= t ? f2bf(C.w_sgu[i]) : 0u); } }
        { float* rp = (float*)(C.ws + WS_ROPE); for (int i = gt; i < M * 32; i += NGT) { const int j = i & 31, tok = i >> 5;
            const float invf = (float)exp(-(double)(2 * j) / 64.0 * 9.210340371976184); const float ang = (float)C.pos[tok] * invf;
            rp[2 * i] = (float)cos((double)ang); rp[2 * i + 1] = (float)sin((double)ang); } }
        __syncthreads();
        for (int e = gw; e < PNE; e += NGW) expert_convert_u(C, e, lane);
        for (int u = vcu; u < 4096; u += G) expert_convert_unit(C, 4096 + u, lds, tid);
    }
    SEAM(0);
    if (IN(1)) { REFRESH_IDS(); __syncthreads();
        if (G == 256) norm_mod_rows<false, true>(C.x, nullptr, C.g_mix, mod, mod + D, (bf16*)(C.ws + WS_H), nullptr, nullptr, nullptr, gw, NGW, lane, lds, tid);
        else norm_mod_rows<false, false>(C.x, nullptr, C.g_mix, mod, mod + D, (bf16*)(C.ws + WS_H), nullptr, nullptr, nullptr, gw, NGW, lane, lds, tid);
        __syncthreads(); }
    SEAM(1);
    if (IN(2)) { REFRESH_IDS();
        pg8::Gemm g{(const bf16*)(C.ws + WS_H), (const bf16*)(C.ws + WS_W1T), M, INWP, D, D, D}; pg8::StaticOrder S; S.init(M, INWP, G, bx);
        EpiZ E{(bf16*)(C.ws + WS_QLAT), (bf16*)(C.ws + WS_KVLAT), (bf16*)(C.ws + WS_KPE), (bf16*)(C.ws + WS_U), (bf16*)(C.ws + WS_VT),
               (float*)(C.ws + WS_STQ), (float*)(C.ws + WS_STKV), (float*)(C.ws + WS_STVS), (float*)(C.ws + WS_STVQ), (const float*)(C.ws + WS_ROPE)};
        pg8::gemm_phase<EpiZ>(lds, g, S, E);
    }
    SEAM(2);
    if (IN(3)) { REFRESH_IDS();
        { pg8::Gemm g{(const bf16*)(C.ws + WS_QLAT), (const bf16*)(C.ws + WS_WUQT), M, NH * QKD, QLR, QLR, QLR}; pg8::StaticOrder S; S.init(M, NH * QKD, G, bx);
          EpiQ E{(bf16*)(C.ws + WS_Q), (const float*)(C.ws + WS_STQ), (const float*)(C.ws + WS_ROPE)};
          pg8::gemm_phase<EpiQ>(lds, g, S, E); }
        { pg8::Gemm g{(const bf16*)(C.ws + WS_KVLAT), (const bf16*)(C.ws + WS_WUKVT), M, NH * 256, KVLR, KVLR, KVLR}; pg8::StaticOrder S; S.init(M, NH * 256, G, bx);
          EpiKV E{(bf16*)(C.ws + WS_KN), (bf16*)(C.ws + WS_VTA), (const float*)(C.ws + WS_STKV)};
          pg8::gemm_phase<EpiKV>(lds, g, S, E); }
        { const int heavy = (G == 256 && bx < 128), lite = (G == 256 && bx >= 128);
          int u = heavy ? bx * 3 : (lite ? 384 + (bx - 128) * 5 : vcu); const int ustep = (G == 256) ? 1 : G, uend = heavy ? bx * 3 + 3 : (lite ? 384 + (bx - 128) * 5 + 5 : NB * 32 * GH);
          sgu_units(C, u, uend, ustep, lds, tid, wave, lane); }
    }
    SEAM(3);
    if (IN(4)) { REFRESH_IDS();
        if (wave >= 4) __builtin_amdgcn_s_setprio(1);
        for (int it = vcu; it < 256; it += G) { const int bh = it >> 3, x = it & 7;
            attn_block(C, bh >> 4, bh & 15, 15 - x, lds, tid, wave, lane);
            attn_block(C, bh >> 4, bh & 15, x, lds, tid, wave, lane); }
        __builtin_amdgcn_s_setprio(0);
    }
    SEAM(4);
    if (IN(6)) { REFRESH_IDS();
        pg8::Gemm g{(const bf16*)(C.ws + WS_Y), (const bf16*)(C.ws + WS_WOUTT), M, D, D, D, D}; pg8::StaticOrder S; S.init(M, D, G, bx);
        LAS f32x2* rsl = (LAS f32x2*)(lds + RING_BYTES);
        pg8::Unit u0, u1; const bool h0 = S.next(0, u0), h1 = S.next(1, u1);
        { const int slot = tid >> 8, pm = slot ? (h1 ? u1.pm : u0.pm) : u0.pm, row = pm * 256 + (tid & 255);
          if (h0) { const float* stm = (const float*)(C.ws + WS_STM); const float* stg = (const float*)(C.ws + WS_STG);
              const float sm = sum_parts(stm + (size_t)row * 16, 4) * (1.0f / GW) + EPS, sg = sum_parts(stg + (size_t)row * 16, 4) * (1.0f / GW) + EPS;
              rsl[slot * 256 + (tid & 255)] = (f32x2){rsqrtf(sm) * sqrtf(sg), rsqrtf(sg)}; } }
        __syncthreads();
        EpiX1 E{mod, (bf16*)(C.ws + WS_X1), rsl, u0.pm};
        pg8::gemm_phase<EpiX1>(lds, g, S, E);
    }
    SEAM(6);
    if (IN(7)) { REFRESH_IDS(); __syncthreads();
        if (G == 256) norm_mod_rows<true, true>(C.x, (const bf16*)(C.ws + WS_X1), C.g_ffn, mod + 3 * D, mod + 4 * D, (bf16*)(C.ws + WS_H), (signed char*)(C.ws + WS_H8), (float*)(C.ws + WS_SH), (bf16*)(C.ws + WS_Y), gw, NGW, lane, lds, tid);
        else norm_mod_rows<true, false>(C.x, (const bf16*)(C.ws + WS_X1), C.g_ffn, mod + 3 * D, mod + 4 * D, (bf16*)(C.ws + WS_H), (signed char*)(C.ws + WS_H8), (float*)(C.ws + WS_SH), (bf16*)(C.ws + WS_Y), gw, NGW, lane, lds, tid);
        __syncthreads(); }
    SEAM(7);
    if (IN(8)) { REFRESH_IDS();
        pg8::Gemm g{(const bf16*)(C.ws + WS_H), (const bf16*)(C.ws + WS_WPQT), M, PQW, D, D, D}; pg8::StaticOrder S; S.init(M, PQW, G, bx);
        EpiQP E{(bf16*)(C.ws + WS_QP)};
        pg8::gemm_phase<EpiQP>(lds, g, S, E);
    }
    SEAM(8);
    if (IN(9)) { REFRESH_IDS(); for (int tb = vcu; tb < M / 32; tb += G) {
            topk_item(C, tb * 8 + wave, (LAS float*)(lds + wave * 12288), (LAS int*)(lds + 98304), (LAS float*)(lds + 98304 + 16384), lane);
            __syncthreads(); { int tidv = tid; asm volatile("" : "+v"(tidv)); order_pairs(C, tb, lds, tidv); } __syncthreads(); } }
    SEAM(9);
    if (IN(10)) { REFRESH_IDS(); for (int it = vcu; it < 256; it += G) peer_u_item(C, it & 15, it >> 4, lds, tid, wave, lane); }
    SEAM(10);
    if (IN(11)) { REFRESH_IDS(); peer_gates(C, vcu * NTHR + tid, G * NTHR); }
    SEAM(11);
    if (IN(12)) { REFRESH_IDS(); for (int it = vcu; it < 256; it += G) peer_v_item(C, it & 15, it >> 4, lds, tid, wave, lane); }
    SEAM(12);
    if (IN(13)) { REFRESH_IDS(); final_units(C, vcu, G, lds, tid, wave, lane); }
#undef IN
#undef SEAM
#undef REFRESH_IDS
}

extern "C" void kernel_launch(void* const* d_in, const int* in_sizes, int n_in, void* d_out, int out_size, void* d_ws, size_t ws_size, hipStream_t stream) {
    static int grid = 0;
    if (grid == 0) {
        if (n_in != 25 || out_size != M * D || ws_size < WS_END) { fprintf(stderr, "kernel_launch: unexpected problem (n_in %d, out %d, ws %zu)\n", n_in, out_size, ws_size); grid = -1; return; }
        int dev = 0, cus = 0, per_cu = 0;
        if (hipGetDevice(&dev) != hipSuccess || hipDeviceGetAttribute(&cus, hipDeviceAttributeMultiprocessorCount, dev) != hipSuccess) { grid = -1; return; }
        if (hipFuncSetAttribute((const void*)fwd, hipFuncAttributeMaxDynamicSharedMemorySize, LDS_BYTES) != hipSuccess) { fprintf(stderr, "kernel_launch: hipFuncSetAttribute failed\n"); grid = -1; return; }
        if (hipOccupancyMaxActiveBlocksPerMultiprocessor(&per_cu, (const void*)fwd, NTHR, LDS_BYTES) != hipSuccess || per_cu < 1) { fprintf(stderr, "kernel_launch: occupancy query says %d blocks per CU\n", per_cu); }
        (void)hipGetLastError();
        grid = cus;
    }
    if (grid < 0) return;
    if (hipMemsetAsync((char*)d_ws + WS_CTL, 0, CTL_ZERO_BYTES, stream) != hipSuccess) return;
    Args a{};
    for (int i = 0; i < 25; ++i) a.in[i] = d_in[i];
    a.out = (float*)d_out; a.ws = (unsigned char*)d_ws;
#if MK_ONE_LAUNCH
    a.ph_lo = 0; a.ph_hi = NPHASE;
    hipLaunchKernelGGL(fwd, dim3(grid), dim3(NTHR), LDS_BYTES, stream, a);
#else
    for (int p = 0; p < NPHASE; ++p) { a.ph_lo = p; a.ph_hi = p + 1; hipLaunchKernelGGL(fwd, dim3(grid), dim3(NTHR), LDS_BYTES, stream, a); }
#endif
    const hipError_t le = hipPeekAtLastError();
    if (le != hipSuccess) fprintf(stderr, "kernel_launch: launch failed: %s\n", hipGetErrorName(le));
}
```

```cpp
#include <hip/hip_runtime.h>
#include <cstdio>
#include <cstdint>

#ifndef MK_ONE_LAUNCH
#define MK_ONE_LAUNCH 1
#endif

#define LAS __attribute__((address_space(3)))
#define GAS __attribute__((address_space(1)))
typedef unsigned short bf16;
typedef short bf16x8 __attribute__((ext_vector_type(8)));
typedef float f32x4 __attribute__((ext_vector_type(4)));
typedef float f32x2 __attribute__((ext_vector_type(2)));
typedef float f32x16 __attribute__((ext_vector_type(16)));
typedef unsigned u32x4 __attribute__((ext_vector_type(4)));
typedef unsigned u32x2 __attribute__((ext_vector_type(2)));

constexpr int D = 4096, SEQ = 4096, NB = 2, M = NB * SEQ;
constexpr int QLR = 1024, KVLR = 512, ROPE = 64, NOPE = 128, QKD = 192, VD = 128, NH = 16;
constexpr int GW = 2048, GH = 16, GC = 128;
constexpr int INW = QLR + KVLR + ROPE + 2 * GW;
constexpr int INWP = 5888;
constexpr int PH = 8, PNK = 128, PQD = 256, PHALF = 128, PK = 16, PNE = PNK * PNK;
constexpr int PQW = PH * PQD;
constexpr float EPS = 1e-6f;
constexpr int NWAVES = 8, NTHR = 512;

constexpr size_t MiB = 1u << 20;
constexpr size_t WS_CTL = 0, CTL_ZERO_BYTES = 1 * MiB;
constexpr size_t WS_MOD = 1 * MiB;
constexpr size_t WS_ROPE = 2 * MiB;
constexpr size_t WS_KEYS = 4 * MiB;
constexpr size_t WS_WSGU = 5 * MiB;
constexpr size_t WS_STQ = 6 * MiB;
constexpr size_t WS_STKV = 7 * MiB;
constexpr size_t WS_STVS = 8 * MiB;
constexpr size_t WS_STVQ = 9 * MiB;
constexpr size_t WS_STM = 10 * MiB;
constexpr size_t WS_STG = 11 * MiB;
constexpr size_t WS_LIDX = 13 * MiB;
constexpr size_t WS_LG = 17 * MiB;
constexpr size_t WS_NA = 21 * MiB;
constexpr size_t WS_W1T = 32 * MiB;
constexpr size_t WS_WUQT = 80 * MiB;
constexpr size_t WS_WUKVT = 88 * MiB;
constexpr size_t WS_WOUTT = 96 * MiB;
constexpr size_t WS_WPQT = 128 * MiB;
constexpr size_t WS_H = 160 * MiB;
constexpr size_t WS_QLAT = 224 * MiB;
constexpr size_t WS_KVLAT = 240 * MiB;
constexpr size_t WS_KPE = 248 * MiB;
constexpr size_t WS_U = 256 * MiB;
constexpr size_t WS_VT = 288 * MiB;
constexpr size_t WS_Q = 320 * MiB;
constexpr size_t WS_KN = 368 * MiB;
constexpr size_t WS_VTA = 400 * MiB;
constexpr size_t WS_Y = 432 * MiB;
constexpr size_t WS_X1 = 496 * MiB;
constexpr size_t WS_QP = 624 * MiB;
constexpr size_t WS_E8 = 704 * MiB;
constexpr size_t WS_ESC = 832 * MiB;
constexpr size_t WS_PART = 840 * MiB;
constexpr size_t WS_ATR = 844 * MiB;
constexpr size_t WS_AT = 904 * MiB;
constexpr size_t WS_FT = 912 * MiB;
constexpr size_t WS_H8 = 1040 * MiB;
constexpr size_t WS_SH = 1072 * MiB;
constexpr size_t WS_END = 1073 * MiB;
constexpr int CW_BAR = 4096;

constexpr int RING_BYTES = 131072;
constexpr int LDS_BYTES = 147456;
constexpr int LDSCTL_OFF = LDS_BYTES - 1024;

#define RLX_AGENT __ATOMIC_RELAXED, __HIP_MEMORY_SCOPE_AGENT
#define LDS_WAIT() asm volatile("s_waitcnt lgkmcnt(0)" ::: "memory")
#define LDS_BARRIER() do { asm volatile("s_waitcnt lgkmcnt(0)" ::: "memory"); __builtin_amdgcn_s_barrier(); asm volatile("" ::: "memory"); } while (0)
#define VM_WAIT() asm volatile("s_waitcnt vmcnt(0)" ::: "memory")

__device__ __forceinline__ unsigned f2bf(float f) { unsigned u = __builtin_bit_cast(unsigned, f); return (u + 0x7fffu + ((u >> 16) & 1u)) >> 16; }
__device__ __forceinline__ unsigned pk2(float lo, float hi) { unsigned r; asm("v_cvt_pk_bf16_f32 %0, %1, %2" : "=v"(r) : "v"(lo), "v"(hi)); return r; }
__device__ __forceinline__ float bf2f(unsigned b) { return __builtin_bit_cast(float, b << 16); }
__device__ __forceinline__ float wave_sum(float v) {
    v += __builtin_bit_cast(float, __builtin_amdgcn_update_dpp(0, __builtin_bit_cast(int, v), 0xB1, 0xF, 0xF, true));
    v += __builtin_bit_cast(float, __builtin_amdgcn_update_dpp(0, __builtin_bit_cast(int, v), 0x4E, 0xF, 0xF, true));
    v += __builtin_bit_cast(float, __builtin_amdgcn_update_dpp(0, __builtin_bit_cast(int, v), 0x141, 0xF, 0xF, true));
    v += __builtin_bit_cast(float, __builtin_amdgcn_update_dpp(0, __builtin_bit_cast(int, v), 0x140, 0xF, 0xF, true));
    v += __builtin_bit_cast(float, __builtin_amdgcn_update_dpp(0, __builtin_bit_cast(int, v), 0x142, 0xA, 0xF, true));
    v += __builtin_bit_cast(float, __builtin_amdgcn_update_dpp(0, __builtin_bit_cast(int, v), 0x143, 0xC, 0xF, true));
    return __builtin_bit_cast(float, __builtin_amdgcn_readlane(__builtin_bit_cast(int, v), 63));
}
__device__ __forceinline__ float gelu_f(float v) {
    const float av = fabsf(v), t = __builtin_amdgcn_rcpf(av * 0.2316418882f + 1.0f);
    float q = t * 0.5307027145f + (-0.7265760135f); q = q * t + 0.7107068705f; q = q * t + (-0.142248368f); q = q * t + 0.127414796f; q = q * t;
    const float e = __builtin_amdgcn_exp2f((v * v) * (-0.72134752044f));
    const float m = v * (q * e);
    return v < 0.f ? m : v - m;
}

#define XB_TMO      128
#define XB_XCNT(j)  (256  + 64 * (j))
#define XB_XSUB(j)  (1280 + 64 * (j))
#define XB_XGEN(j)  (2304 + 64 * (j))
#define XB_TOP      3328
#define XB_TOPGEN   3392
#define XCD_BAR_WORDS 3456
#define XB_SPIN_CAP (1u << 20)

__device__ __forceinline__ unsigned xb_ld(unsigned* p)              { return __hip_atomic_load(p, __ATOMIC_RELAXED, __HIP_MEMORY_SCOPE_AGENT); }
__device__ __forceinline__ unsigned xb_add(unsigned* p, unsigned v) { return __hip_atomic_fetch_add(p, v, __ATOMIC_RELAXED, __HIP_MEMORY_SCOPE_AGENT); }
__device__ __forceinline__ unsigned xb_xcc_id() { return (unsigned)__builtin_amdgcn_s_getreg((3 << 11) | 20) & 0xFu; }
#define XB_SPIN(cond, bar) do { unsigned _sp = 0; while (cond) { __builtin_amdgcn_s_sleep(1); \
    if ((++_sp & 255u) == 0u) { if (xb_ld(&(bar)[XB_TMO])) break; if (_sp > XB_SPIN_CAP) { atomicAdd(&(bar)[XB_TMO], 1u); break; } } } } while (0)

struct XcdBarrier { unsigned* bar; unsigned x; volatile LAS unsigned* st; };

__device__ __forceinline__ XcdBarrier xcd_barrier_post(unsigned* bar, volatile LAS unsigned* st) {
    XcdBarrier b; b.bar = bar; b.x = xb_xcc_id(); b.st = st;
    if (threadIdx.x == 0) (void)xb_add(&bar[XB_XCNT(b.x)], 1u);
    return b;
}
__device__ __forceinline__ void xcd_barrier_complete(unsigned* bar, unsigned x, unsigned& nloc, unsigned& nx) {
    const unsigned G = gridDim.x * gridDim.y * gridDim.z;
    unsigned sum, cnt, mine, sp = 0u;
    for (;;) {
        sum = 0u; cnt = 0u; mine = 0u;
#pragma unroll
        for (unsigned j = 0; j < 16; ++j) { const unsigned c = xb_ld(&bar[XB_XCNT(j)]); sum += c; cnt += (c > 0u) ? 1u : 0u; mine = (j == x) ? c : mine; }
        if (sum == G) break;
        __builtin_amdgcn_s_sleep(1);
        if ((++sp & 255u) == 0u) { if (xb_ld(&bar[XB_TMO])) break; if (sp > XB_SPIN_CAP) { atomicAdd(&bar[XB_TMO], 1u); break; } }
    }
    nloc = mine > 0u ? mine : 1u; nx = cnt > 0u ? cnt : 1u;
}
__device__ __forceinline__ void xcd_barrier(const XcdBarrier& b) {
    asm volatile("s_waitcnt vmcnt(0)" ::: "memory");
    __syncthreads();
    if (threadIdx.x == 0) {
        unsigned* bar = b.bar;
        __builtin_amdgcn_s_waitcnt(0);
        unsigned nloc = b.st[0], nx = b.st[1];
        if (nloc == 0u) { xcd_barrier_complete(bar, b.x, nloc, nx); b.st[0] = nloc; b.st[1] = nx; }
        const unsigned old = xb_add(&bar[XB_XSUB(b.x)], 1u);
        const unsigned gen = old / nloc;
        if (old + 1u == (gen + 1u) * nloc) {
            __builtin_amdgcn_fence(__ATOMIC_RELEASE, "agent");
            asm volatile("s_waitcnt vmcnt(0)" ::: "memory");
            const unsigned og = xb_add(&bar[XB_TOP], 1u);
            const unsigned tg = og / nx;
            if (og + 1u == (tg + 1u) * nx) xb_add(&bar[XB_TOPGEN], 1u);
            else XB_SPIN(xb_ld(&bar[XB_TOPGEN]) == tg, bar);
            __builtin_amdgcn_fence(__ATOMIC_ACQUIRE, "agent");
            xb_add(&bar[XB_XGEN(b.x)], 1u);
            asm volatile("s_waitcnt vmcnt(0)" ::: "memory");
        } else {
            XB_SPIN(xb_ld(&bar[XB_XGEN(b.x)]) == gen, bar);
            __builtin_amdgcn_fence(__ATOMIC_ACQUIRE, "agent");
            asm volatile("s_waitcnt vmcnt(0)" ::: "memory");
        }
    }
    __syncthreads();
}

namespace pg8 {
constexpr int BM = 256, BK = 64, HALF = 128, HTB = HALF * BK * 2, STAGE_BYTES = 8 * HTB, NXCD = 8, WGM = 8;
__host__ __device__ __forceinline__ int lds_byte(int r, int c) { const int st = (r >> 4) * 2 + (c >> 5), rr = r & 15, cc = c & 31, ob = rr * 64 + cc * 2; return st * 1024 + (ob ^ (((ob >> 9) & 1) << 5)); }
__host__ __device__ __forceinline__ void stage_rc(int b, int& R, int& C) { const int st = b / 1024, sb = b % 1024, swz = sb ^ (((sb >> 9) & 1) << 5); R = (st >> 1) * 16 + swz / 64; C = (st & 1) * 32 + (swz % 64) / 2; }
struct Unit { int pm, pn; };
struct Gemm { const bf16* A; const bf16* Bt; int M, N, K, lda, ldb; };
struct StaticOrder {
    int nM, nN, nwg, G, c;
    __device__ __forceinline__ void init(int M_, int N_, int G_, int c_) { nM = M_ / BM; nN = N_ / BM; nwg = nM * nN; G = G_; c = c_; }
    __device__ __forceinline__ bool next(int i, Unit& u) const {
        const long L = (long)i * G + c; if (L >= nwg) return false;
        int wgid = (int)L; { const int q = nwg / NXCD, r = nwg % NXCD, xcd = wgid % NXCD, off = wgid / NXCD; wgid = (xcd < r ? xcd * (q + 1) : r * (q + 1) + (xcd - r) * q) + off; }
        const int nig = WGM * nN, gid = wgid / nig, fm = gid * WGM, gsz = (nM - fm) < WGM ? (nM - fm) : WGM;
        u.pm = fm + ((wgid % nig) % gsz); u.pn = (wgid % nig) / gsz; return true;
    }
};
template <class Epi>
__device__ __forceinline__ void gemm_phase(LAS unsigned char* lds, const Gemm g, const StaticOrder& S, const Epi& E) {
    const int tid = threadIdx.x, wid = __builtin_amdgcn_readfirstlane(tid >> 6), lane = tid & 63, wr = wid >> 2, wc = wid & 3, fr = lane & 15, fq = lane >> 4;
    const int K = g.K, nt = K / BK;
    unsigned voffA[2], voffB[2];
#pragma unroll
    for (int i = 0; i < 2; ++i) { int R, C; stage_rc(tid * 16 + i * 8192, R, C);
        voffA[i] = (unsigned)(R * g.lda + C) * 2u; voffB[i] = (unsigned)(R * g.ldb + C) * 2u; }
    const size_t kstep = (size_t)(BK * 2);
    const size_t hstepA = (size_t)HALF * g.lda * 2, hstepB = (size_t)HALF * g.ldb * 2;
    const size_t tstepA = 2 * hstepA, tstepB = 2 * hstepB;
    const unsigned ldsw = (unsigned)wid * 1024u;
    const int aoff = lds_byte(wr * 64 + fr, fq * 8), boff = lds_byte(wc * 32 + fr, fq * 8);
#define PG8_SA(b, h) (((b) * 2 + (h)) * HTB)
#define PG8_SB(b, h) ((4 + (b) * 2 + (h)) * HTB)
#define PG8_STAGE(bufoff, gbase, voff) do { _Pragma("unroll") for (int _i = 0; _i < 2; ++_i) \
        __builtin_amdgcn_global_load_lds((const unsigned*)((const char*)(gbase) + (voff)[_i]), (LAS unsigned*)(lds + (bufoff) + ldsw + _i * 8192), 16, 0, 0); } while (0)
#define PG8_LDA(dst, b, h) do { _Pragma("unroll") for (int m = 0; m < 4; ++m) _Pragma("unroll") for (int k = 0; k < 2; ++k) dst[m][k] = *(const LAS bf16x8*)(lds + PG8_SA(b, h) + aoff + m * 2048 + k * 1024); } while (0)
#define PG8_LDB(dst, b, h) do { _Pragma("unroll") for (int n = 0; n < 2; ++n) _Pragma("unroll") for (int k = 0; k < 2; ++k) dst[n][k] = *(const LAS bf16x8*)(lds + PG8_SB(b, h) + boff + n * 2048 + k * 1024); } while (0)
#define PG8_MMA(ai, bj, At, Bt) do { __builtin_amdgcn_s_setprio(1); _Pragma("unroll") for (int m = 0; m < 4; ++m) _Pragma("unroll") for (int n = 0; n < 2; ++n) _Pragma("unroll") for (int k = 0; k < 2; ++k) \
        acc[ai][bj][m][n] = __builtin_amdgcn_mfma_f32_16x16x32_bf16(Bt[n][k], At[m][k], acc[ai][bj][m][n], 0, 0, 0); __builtin_amdgcn_s_setprio(0); } while (0)
#define PG8_WAIT_V(n) asm volatile("s_waitcnt vmcnt(" #n ")" ::: "memory")
#define PG8_WAIT_L(n) asm volatile("s_waitcnt lgkmcnt(" #n ")" ::: "memory")
#define PG8_BAR __builtin_amdgcn_s_barrier()
#define PG8_SCHED __builtin_amdgcn_sched_barrier(0)
    Unit cur, nxt; int ui = 0;
    if (!S.next(0, cur)) return;
    f32x4 acc[2][2][4][2];
#pragma unroll
    for (int a = 0; a < 2; ++a)
#pragma unroll
        for (int b = 0; b < 2; ++b)
#pragma unroll
            for (int m = 0; m < 4; ++m)
#pragma unroll
                for (int n = 0; n < 2; ++n) acc[a][b][m][n] = (f32x4){0.f, 0.f, 0.f, 0.f};
    bf16x8 At[4][2], B0[2][2], B1[2][2];
    const char* cA = (const char*)g.A + (size_t)cur.pm * tstepA; const char* cB = (const char*)g.Bt + (size_t)cur.pn * tstepB;
    PG8_STAGE(PG8_SB(0, 0), cB, voffB); PG8_STAGE(PG8_SB(0, 1), cB + hstepB, voffB); PG8_STAGE(PG8_SA(0, 0), cA, voffA); PG8_STAGE(PG8_SA(0, 1), cA + hstepA, voffA);
    if (wr == 1) PG8_BAR;
    PG8_WAIT_V(2); PG8_BAR;
    PG8_STAGE(PG8_SB(1, 0), cB + kstep, voffB); PG8_STAGE(PG8_SA(1, 0), cA + kstep, voffA); PG8_STAGE(PG8_SB(1, 1), cB + hstepB + kstep, voffB);
    PG8_WAIT_V(6); PG8_BAR;
    for (;;) {
        const bool has_next = S.next(ui + 1, nxt);
        const char* nA = has_next ? (const char*)g.A + (size_t)nxt.pm * tstepA : cA; const char* nB = has_next ? (const char*)g.Bt + (size_t)nxt.pn * tstepB : cB;
        for (int t = 0; t < nt; t += 2) {
            const bool last = (t == nt - 2);
            const char* a1 = cA + (size_t)(t + 1) * kstep;
            const char* a2 = last ? nA : cA + (size_t)(t + 2) * kstep; const char* b2 = last ? nB : cB + (size_t)(t + 2) * kstep;
            const char* a3 = a2 + kstep; const char* b3 = b2 + kstep;
            if constexpr (Epi::MID) { if (t == nt / 2) E.mid(acc, cur, wr, wc, fr, fq); }
            PG8_LDB(B0, 0, 0); PG8_LDB(B1, 0, 1); PG8_SCHED; PG8_LDA(At, 0, 0); PG8_STAGE(PG8_SA(1, 1), a1 + hstepA, voffA);
            PG8_WAIT_V(8); PG8_WAIT_L(0); PG8_BAR; PG8_MMA(0, 0, At, B0); PG8_MMA(0, 1, At, B1); PG8_BAR; PG8_SCHED;
            PG8_LDA(At, 0, 1); PG8_STAGE(PG8_SB(0, 0), b2, voffB); PG8_STAGE(PG8_SB(0, 1), b2 + hstepB, voffB); PG8_STAGE(PG8_SA(0, 0), a2, voffA);
            PG8_WAIT_V(8); PG8_WAIT_L(0); PG8_BAR; PG8_MMA(1, 0, At, B0); PG8_MMA(1, 1, At, B1); PG8_BAR; PG8_SCHED;
            PG8_LDB(B0, 1, 0); PG8_LDB(B1, 1, 1); PG8_SCHED; PG8_LDA(At, 1, 0); PG8_STAGE(PG8_SA(0, 1), a2 + hstepA, voffA);
            PG8_WAIT_V(8); PG8_WAIT_L(0); PG8_BAR; PG8_MMA(0, 0, At, B0); PG8_MMA(0, 1, At, B1); PG8_BAR; PG8_SCHED;
            PG8_LDA(At, 1, 1); PG8_STAGE(PG8_SB(1, 0), b3, voffB); PG8_STAGE(PG8_SB(1, 1), b3 + hstepB, voffB); PG8_STAGE(PG8_SA(1, 0), a3, voffA);
            PG8_WAIT_V(8); PG8_WAIT_L(0); PG8_BAR; PG8_MMA(1, 0, At, B0); PG8_MMA(1, 1, At, B1); PG8_BAR; PG8_SCHED;
        }
        if (wr == 0) PG8_BAR;
        E(acc, cur, wr, wc, fr, fq);
        if (!has_next) break;
#pragma unroll
        for (int a = 0; a < 2; ++a)
#pragma unroll
            for (int b = 0; b < 2; ++b)
#pragma unroll
                for (int m = 0; m < 4; ++m)
#pragma unroll
                    for (int n = 0; n < 2; ++n) acc[a][b][m][n] = (f32x4){0.f, 0.f, 0.f, 0.f};
        cur = nxt; cA = nA; cB = nB; ++ui;
        if (wr == 1) PG8_BAR;
    }
    PG8_WAIT_V(0);
    PG8_BAR;
#undef PG8_SA
#undef PG8_SB
#undef PG8_STAGE
#undef PG8_LDA
#undef PG8_LDB
#undef PG8_MMA
#undef PG8_WAIT_V
#undef PG8_WAIT_L
#undef PG8_BAR
#undef PG8_SCHED
}
}

__device__ __forceinline__ void st_bf16x4(bf16* p, f32x4 v) { u32x2 w; w.x = pk2(v[0], v[1]); w.y = pk2(v[2], v[3]); *(u32x2*)p = w; }
__device__ __forceinline__ float sum_parts(const float* p, int n4) { f32x4 s = {0.f, 0.f, 0.f, 0.f}; for (int i = 0; i < n4; ++i) s += ((const f32x4*)p)[i]; return (s[0] + s[1]) + (s[2] + s[3]); }
__device__ __forceinline__ int sperm16(int s) { const int c = s & 15; return (s & ~15) | (8 * ((c >> 2) & 1) + 4 * (c >> 3) + (c & 3)); }

struct EpiZ {
    static constexpr bool MID = false;
    bf16 *qlat, *kvlat, *kpe, *u, *vt; float *stq, *stkv, *stvs, *stvq; const float* rope;
    __device__ __forceinline__ void operator()(const f32x4 (&acc)[2][2][4][2], const pg8::Unit& un, int wr, int wc, int fr, int fq) const {
        const int pn = un.pn, row0 = un.pm * 256 + wr * 64 + fr, cl0 = wc * 32 + 4 * fq;
        if (pn < 6) {
            const bool isq = pn < 4; bf16* dst = isq ? qlat : kvlat; const int ld = isq ? QLR : KVLR, ct = isq ? pn : pn - 4;
#pragma unroll
            for (int ai = 0; ai < 2; ++ai)
#pragma unroll
                for (int m = 0; m < 4; ++m) { const int row = row0 + ai * 128 + m * 16; float ss = 0.f;
#pragma unroll
                    for (int bj = 0; bj < 2; ++bj)
#pragma unroll
                        for (int n = 0; n < 2; ++n) { const f32x4 v = acc[ai][bj][m][n]; ss += (v[0] * v[0] + v[1] * v[1]) + (v[2] * v[2] + v[3] * v[3]);
                            st_bf16x4(dst + (size_t)row * ld + ct * 256 + bj * 128 + cl0 + n * 16, v); }
                    ss += __shfl_xor(ss, 16); ss += __shfl_xor(ss, 32);
                    if (fq == 0) { if (isq) stq[row * 16 + ct * 4 + wc] = ss; else stkv[row * 8 + ct * 4 + wc] = ss; } }
        } else if (pn == 6) {
            if (wc < 2) {
#pragma unroll
                for (int ai = 0; ai < 2; ++ai)
#pragma unroll
                    for (int m = 0; m < 4; ++m) { const int row = row0 + ai * 128 + m * 16, j0 = 16 * wc + 4 * fq;
                        const f32x4 x1 = acc[ai][0][m][0], x2 = acc[ai][0][m][1];
                        const f32x4 c0 = *(const f32x4*)(rope + (size_t)row * 64 + 2 * j0), c1 = *(const f32x4*)(rope + (size_t)row * 64 + 2 * j0 + 4);
                        const float cs[4] = {c0[0], c0[2], c1[0], c1[2]}, sn[4] = {c0[1], c0[3], c1[1], c1[3]};
                        f32x4 o1, o2;
#pragma unroll
                        for (int e = 0; e < 4; ++e) { o1[e] = x1[e] * cs[e] - x2[e] * sn[e]; o2[e] = x2[e] * cs[e] + x1[e] * sn[e]; }
                        st_bf16x4(kpe + (size_t)row * 64 + j0, o1); st_bf16x4(kpe + (size_t)row * 64 + 32 + j0, o2); }
            }
        } else if (pn < 15) {
#pragma unroll
            for (int ai = 0; ai < 2; ++ai)
#pragma unroll
                for (int m = 0; m < 4; ++m) { const int row = row0 + ai * 128 + m * 16;
#pragma unroll
                    for (int bj = 0; bj < 2; ++bj)
#pragma unroll
                        for (int n = 0; n < 2; ++n) { f32x4 v = acc[ai][bj][m][n];
#pragma unroll
                            for (int e = 0; e < 4; ++e) v[e] = gelu_f(v[e]);
                            st_bf16x4(u + (size_t)row * GW + (pn - 7) * 256 + bj * 128 + cl0 + n * 16, v); } }
        } else {
            const int ct = pn - 15;
#pragma unroll
            for (int ai = 0; ai < 2; ++ai)
#pragma unroll
                for (int m = 0; m < 4; ++m) { const int row = row0 + ai * 128 + m * 16, b = row >> 12, s = row & 4095; float s1 = 0.f, s2 = 0.f;
#pragma unroll
                    for (int bj = 0; bj < 2; ++bj)
#pragma unroll
                        for (int n = 0; n < 2; ++n) { const f32x4 v = acc[ai][bj][m][n]; const int col = ct * 256 + bj * 128 + cl0 + n * 16;
#pragma unroll
                            for (int e = 0; e < 4; ++e) { const float g = gelu_f(v[e]); s1 += g; s2 += g * g; vt[((size_t)b * GW + col + e) * SEQ + s] = (bf16)f2bf(g); } }
                    s1 += __shfl_xor(s1, 16); s1 += __shfl_xor(s1, 32); s2 += __shfl_xor(s2, 16); s2 += __shfl_xor(s2, 32);
                    if (fq == 0) { stvs[row * 32 + ct * 4 + wc] = s1; stvq[row * 32 + ct * 4 + wc] = s2; } }
        }
    }
};

struct EpiQ {
    static constexpr bool MID = false;
    bf16* q; const float* stq; const float* rope;
    __device__ __forceinline__ void operator()(const f32x4 (&acc)[2][2][4][2], const pg8::Unit& un, int wr, int wc, int fr, int fq) const {
        const int pn = un.pn, row0 = un.pm * 256 + wr * 64 + fr;
#pragma unroll
        for (int ai = 0; ai < 2; ++ai)
#pragma unroll
            for (int m = 0; m < 4; ++m) { const int row = row0 + ai * 128 + m * 16;
                const float rs = rsqrtf(sum_parts(stq + row * 16, 4) * (1.0f / QLR) + EPS);
#pragma unroll
                for (int bj = 0; bj < 2; ++bj) { const int blk = 4 * pn + 2 * bj + (wc >> 1), head = blk / 3, part = blk - 3 * head;
                    if (part != 2) {
#pragma unroll
                        for (int n = 0; n < 2; ++n) st_bf16x4(q + (size_t)row * (NH * QKD) + pn * 256 + bj * 128 + wc * 32 + n * 16 + 4 * fq, acc[ai][bj][m][n] * rs);
                    } else {
                        const int j0 = 16 * (wc & 1) + 4 * fq; const f32x4 x1 = acc[ai][bj][m][0] * rs, x2 = acc[ai][bj][m][1] * rs;
                        const f32x4 c0 = *(const f32x4*)(rope + (size_t)row * 64 + 2 * j0), c1 = *(const f32x4*)(rope + (size_t)row * 64 + 2 * j0 + 4);
                        const float cs[4] = {c0[0], c0[2], c1[0], c1[2]}, sn[4] = {c0[1], c0[3], c1[1], c1[3]};
                        f32x4 o1, o2;
#pragma unroll
                        for (int e = 0; e < 4; ++e) { o1[e] = x1[e] * cs[e] - x2[e] * sn[e]; o2[e] = x2[e] * cs[e] + x1[e] * sn[e]; }
                        bf16* base = q + (size_t)row * (NH * QKD) + head * QKD + NOPE;
                        st_bf16x4(base + j0, o1); st_bf16x4(base + 32 + j0, o2);
                    } } }
    }
};

struct EpiKV {
    static constexpr bool MID = false;
    bf16 *kn, *vta; const float* stkv;
    __device__ __forceinline__ void operator()(const f32x4 (&acc)[2][2][4][2], const pg8::Unit& un, int wr, int wc, int fr, int fq) const {
        const int pn = un.pn, row0 = un.pm * 256 + wr * 64 + fr;
#pragma unroll
        for (int ai = 0; ai < 2; ++ai)
#pragma unroll
            for (int m = 0; m < 4; ++m) { const int row = row0 + ai * 128 + m * 16, b = row >> 12, sp = sperm16(row & 4095);
                const float rs = rsqrtf(sum_parts(stkv + row * 8, 2) * (1.0f / KVLR) + EPS);
#pragma unroll
                for (int n = 0; n < 2; ++n) { const int d0 = wc * 32 + n * 16 + 4 * fq;
                    st_bf16x4(kn + (size_t)row * (NH * NOPE) + pn * NOPE + d0, acc[ai][0][m][n] * rs);
                    const f32x4 v = acc[ai][1][m][n] * rs;
#pragma unroll
                    for (int e = 0; e < 4; ++e) vta[(((size_t)b * NH + pn) * VD + d0 + e) * SEQ + sp] = (bf16)f2bf(v[e]); } }
    }
};

struct EpiX1 {
    static constexpr bool MID = true;
    const float* mod; bf16* mix; const LAS f32x2* rs; int pm0;
    __device__ __forceinline__ void mid(f32x4 (&acc)[2][2][4][2], const pg8::Unit& un, int wr, int wc, int fr, int fq) const {
        const LAS f32x2* p = rs + (un.pm == pm0 ? 0 : 256) + wr * 64 + fr;
#pragma unroll
        for (int ai = 0; ai < 2; ++ai)
#pragma unroll
            for (int m = 0; m < 4; ++m) { const float ratio = p[ai * 128 + m * 16].x;
#pragma unroll
                for (int bj = 0; bj < 2; ++bj)
#pragma unroll
                    for (int n = 0; n < 2; ++n) acc[ai][bj][m][n] *= ratio; }
    }
    __device__ __forceinline__ void operator()(const f32x4 (&acc)[2][2][4][2], const pg8::Unit& un, int wr, int wc, int fr_, int fq_) const {
        int fr = fr_, fq = fq_; asm volatile("" : "+v"(fr), "+v"(fq));
        const int pn = un.pn, row0 = un.pm * 256 + wr * 64 + fr, b = (un.pm * 256) >> 12;
        const LAS f32x2* p = rs + (un.pm == pm0 ? 0 : 256) + wr * 64 + fr;
        f32x4 gt[2][2];
#pragma unroll
        for (int bj = 0; bj < 2; ++bj)
#pragma unroll
            for (int n = 0; n < 2; ++n) gt[bj][n] = *(const f32x4*)(mod + (size_t)b * 6 * D + 2 * D + pn * 256 + bj * 128 + wc * 32 + n * 16 + 4 * fq);
#pragma unroll
        for (int ai = 0; ai < 2; ++ai)
#pragma unroll
            for (int m = 0; m < 4; ++m) { const int row = row0 + ai * 128 + m * 16; const size_t ro = (size_t)row * D;
                const float rg = p[ai * 128 + m * 16].y;
#pragma unroll
                for (int bj = 0; bj < 2; ++bj)
#pragma unroll
                    for (int n = 0; n < 2; ++n) { const int col = pn * 256 + bj * 128 + wc * 32 + n * 16 + 4 * fq;
                        st_bf16x4(mix + ro + col, gt[bj][n] * (acc[ai][bj][m][n] * rg)); } }
    }
};

struct EpiQP {
    static constexpr bool MID = false;
    bf16* qp;
    __device__ __forceinline__ void operator()(const f32x4 (&acc)[2][2][4][2], const pg8::Unit& un, int wr, int wc, int fr, int fq) const {
        const int pn = un.pn, row0 = un.pm * 256 + wr * 64 + fr;
#pragma unroll
        for (int ai = 0; ai < 2; ++ai)
#pragma unroll
            for (int m = 0; m < 4; ++m) { const size_t ro = (size_t)(row0 + ai * 128 + m * 16) * PQW;
#pragma unroll
                for (int bj = 0; bj < 2; ++bj)
#pragma unroll
                    for (int n = 0; n < 2; ++n) st_bf16x4(qp + ro + pn * 256 + bj * 128 + wc * 32 + n * 16 + 4 * fq, acc[ai][bj][m][n]); }
    }
};

struct Ctx {
    const float *x, *c; const int* pos; const float *w_ada, *b_ada, *g_mix, *w_in, *g_q, *w_uq, *g_kv, *w_ukv, *g_sgu, *w_sgu, *b_sgu, *beta_mla, *beta_g, *w_out, *g_ffn, *w_pq, *pkeys, *eu, *ev, *w_adaf, *b_adaf, *g_f;
    float* out; unsigned char* ws;
};

__device__ __forceinline__ void ada_unit(const Ctx& C, int unit, LAS float* red, int tid, int wave, int lane) {
    const bool fin = unit >= 192; const float* W = fin ? C.w_adaf : C.w_ada; const int N = fin ? 2 * D : 6 * D, n0 = (fin ? unit - 192 : unit) * 128;
    const int half = lane >> 5, l32 = lane & 31;
    f32x4 a0 = {0.f, 0.f, 0.f, 0.f}, a1 = {0.f, 0.f, 0.f, 0.f};
    const int kbeg = wave * 512;
    LAS float* sil = red + 2048;
#pragma unroll
    for (int j = 0; j < 16; ++j) { const float cv = C.c[tid + 512 * j]; sil[tid + 512 * j] = cv / (1.0f + __expf(-cv)); }
    __syncthreads();
    const char* wp = (const char*)(W + (size_t)(kbeg + half) * N + n0 + 4 * l32); const unsigned rstep = 2u * (unsigned)N * 4u;
    f32x4 w[12];
#pragma unroll
    for (int p = 0; p < 12; ++p) w[p] = *(const f32x4*)(wp + (size_t)p * rstep);
#pragma unroll 1
    for (int i = 0; i < 252; i += 12) {
#pragma unroll
        for (int p = 0; p < 12; ++p) { const int k = kbeg + 2 * (i + p) + half; const f32x4 cur = w[p];
            if (i + 12 + p < 256) w[p] = *(const f32x4*)(wp + (size_t)(i + 12 + p) * rstep);
            const float s0 = sil[k], s1 = sil[D + k];
            a0 += cur * s0; a1 += cur * s1; } }
#pragma unroll
    for (int p = 0; p < 4; ++p) { const int k = kbeg + 2 * (252 + p) + half; const float s0 = sil[k], s1 = sil[D + k]; a0 += w[p] * s0; a1 += w[p] * s1; }
#pragma unroll
    for (int e = 0; e < 4; ++e) { a0[e] += __shfl_xor(a0[e], 32); a1[e] += __shfl_xor(a1[e], 32); }
    if (half == 0) { *(LAS f32x4*)(red + (wave * 32 + l32) * 8) = a0; *(LAS f32x4*)(red + (wave * 32 + l32) * 8 + 4) = a1; }
    __syncthreads();
    if (tid < 256) { const int b = tid >> 7, col = tid & 127; float s = 0.f;
#pragma unroll
        for (int w = 0; w < 8; ++w) s += red[(w * 32 + (col >> 2)) * 8 + b * 4 + (col & 3)];
        const float* bias = fin ? C.b_adaf : C.b_ada;
        float* o = (float*)(C.ws + WS_MOD) + (fin ? 2 * 6 * D : 0) + (size_t)b * N + n0 + col;
        *o = s + bias[n0 + col]; }
    __syncthreads();
}

enum { MAP_ID = 0, MAP_W1 = 1, MAP_UQ = 2 };
__device__ __forceinline__ int ropeperm(int p) { return ((p >> 4) & 1) * 32 + 16 * (p >> 5) + (p & 15); }
template <int MAP> __device__ __forceinline__ int colmap(int n) {
    if (MAP == MAP_W1) { if (n < 1536) return n; if (n < 1600) return 1536 + ropeperm(n - 1536); if (n < 1792) return -1; return n - 192; }
    if (MAP == MAP_UQ) { const int blk = n >> 6; if (blk % 3 == 2) return (n & ~63) + ropeperm(n & 63); return n; }
    return n;
}
template <int MAP> __device__ __forceinline__ void transpose_item(const float* W, int K, int N, int NP, bf16* WT, const float* ks, float mul, LAS float* scr, int item, int lane) {
    const int nblk = NP / 32, kb = item / nblk, nb = item % nblk, k0 = 64 * kb, n0 = 32 * nb;
    const int q4 = lane & 7, src = colmap<MAP>(n0 + 4 * q4);
    f32x4 ld[8];
#pragma unroll
    for (int i = 0; i < 8; ++i) { const int kk = (lane >> 3) + 8 * i; ld[i] = (src >= 0) ? *(const f32x4*)(W + (size_t)(k0 + kk) * N + src) : (f32x4){0.f, 0.f, 0.f, 0.f}; }
#pragma unroll
    for (int i = 0; i < 8; ++i) { const int kk = (lane >> 3) + 8 * i;
#pragma unroll
        for (int e = 0; e < 4; ++e) scr[kk * 33 + 4 * q4 + e] = ld[i][e]; }
    LDS_WAIT(); asm volatile("" ::: "memory");
    const int c = lane & 7;
    float sc[8];
#pragma unroll
    for (int e = 0; e < 8; ++e) sc[e] = (ks ? ks[k0 + 8 * c + e] : 1.0f) * mul;
#pragma unroll
    for (int j = 0; j < 4; ++j) { const int n = (lane >> 3) + 8 * j; const LAS float* s = scr + (8 * c) * 33 + n;
        u32x4 o; o.x = pk2(s[0 * 33] * sc[0], s[1 * 33] * sc[1]); o.y = pk2(s[2 * 33] * sc[2], s[3 * 33] * sc[3]); o.z = pk2(s[4 * 33] * sc[4], s[5 * 33] * sc[5]); o.w = pk2(s[6 * 33] * sc[6], s[7 * 33] * sc[7]);
        *(u32x4*)(WT + (size_t)(n0 + n) * K + k0 + 8 * c) = o; }
    LDS_WAIT(); asm volatile("" ::: "memory");
}

__device__ __forceinline__ float wave_max_nonneg(float v) {
    v = fmaxf(v, __builtin_bit_cast(float, __builtin_amdgcn_update_dpp(0, __builtin_bit_cast(int, v), 0xB1, 0xF, 0xF, true)));
    v = fmaxf(v, __builtin_bit_cast(float, __builtin_amdgcn_update_dpp(0, __builtin_bit_cast(int, v), 0x4E, 0xF, 0xF, true)));
    v = fmaxf(v, __builtin_bit_cast(float, __builtin_amdgcn_update_dpp(0, __builtin_bit_cast(int, v), 0x141, 0xF, 0xF, true)));
    v = fmaxf(v, __builtin_bit_cast(float, __builtin_amdgcn_update_dpp(0, __builtin_bit_cast(int, v), 0x140, 0xF, 0xF, true)));
    v = fmaxf(v, __builtin_bit_cast(float, __builtin_amdgcn_update_dpp(0, __builtin_bit_cast(int, v), 0x142, 0xA, 0xF, true)));
    v = fmaxf(v, __builtin_bit_cast(float, __builtin_amdgcn_update_dpp(0, __builtin_bit_cast(int, v), 0x143, 0xC, 0xF, true)));
    return __builtin_bit_cast(float, __builtin_amdgcn_readlane(__builtin_bit_cast(int, v), 63));
}
template <bool Q8, bool VL> __device__ __forceinline__ void norm_mod_rows(const float* X, const bf16* ADD, const float* g, const float* sh, const float* sc, bf16* O, signed char* O8, float* S8, bf16* X1O, int gw, int NGW, int lane, LAS unsigned char* lds, int tid) {
    f32x4 vn[16]; u32x2 an[16]; int bcur = -1;
    if (gw < M) {
#pragma unroll
        for (int j = 0; j < 16; ++j) { vn[j] = ((const f32x4*)(X + (size_t)gw * D))[64 * j + lane]; if (Q8) an[j] = ((const u32x2*)(ADD + (size_t)gw * D))[64 * j + lane]; } }
    for (int m = gw; m < M; m += NGW) { const int b = m >> 12;
        if (VL && b != bcur) { bcur = b; LDS_BARRIER();
#pragma unroll
            for (int i = 0; i < 2; ++i) { const int c4 = tid + 512 * i;
                *(LAS f32x4*)(lds + c4 * 16) = ((const f32x4*)g)[c4]; *(LAS f32x4*)(lds + 16384 + c4 * 16) = ((const f32x4*)(sc + (size_t)b * 6 * D))[c4]; *(LAS f32x4*)(lds + 32768 + c4 * 16) = ((const f32x4*)(sh + (size_t)b * 6 * D))[c4]; }
            LDS_BARRIER(); }
        f32x4 v[16]; float ss = 0.f;
#pragma unroll
        for (int j = 0; j < 16; ++j) { v[j] = vn[j];
            if (Q8) v[j] += (f32x4){bf2f(an[j].x & 0xffffu), bf2f(an[j].x >> 16), bf2f(an[j].y & 0xffffu), bf2f(an[j].y >> 16)};
            ss += (v[j][0] * v[j][0] + v[j][1] * v[j][1]) + (v[j][2] * v[j][2] + v[j][3] * v[j][3]); }
        if (m + NGW < M) {
#pragma unroll
            for (int j = 0; j < 16; ++j) { vn[j] = ((const f32x4*)(X + (size_t)(m + NGW) * D))[64 * j + lane]; if (Q8) an[j] = ((const u32x2*)(ADD + (size_t)(m + NGW) * D))[64 * j + lane]; } }
        const float rs = rsqrtf(wave_sum(ss) * (1.0f / D) + EPS);
        const char* gp = (const char*)g; const char* scp = (const char*)(sc + (size_t)b * 6 * D); const char* shp = (const char*)(sh + (size_t)b * 6 * D);
        char* op = (char*)(O + (size_t)m * D); char* o8p = (char*)(O8 + (size_t)m * D); char* x1p = (char*)(X1O + (size_t)m * D);
        int lanev = lane; asm volatile("" : "+v"(lanev));
        float amx = 0.f;
#pragma unroll
        for (int j = 0; j < 16; ++j) { const unsigned cb = (unsigned)(64 * j + lanev) * 16u;
            f32x4 gg, s1, s0;
            if (VL) { gg = *(const LAS f32x4*)(lds + cb); s1 = *(const LAS f32x4*)(lds + 16384 + cb); s0 = *(const LAS f32x4*)(lds + 32768 + cb); }
            else { gg = *(const f32x4*)(gp + cb); s1 = *(const f32x4*)(scp + cb); s0 = *(const f32x4*)(shp + cb); }
            const f32x4 y = v[j] * rs * gg * (s1 + 1.0f) + s0;
            u32x2 w; w.x = pk2(y[0], y[1]); w.y = pk2(y[2], y[3]); *(u32x2*)(op + (cb >> 1)) = w;
            if (Q8) { u32x2 w1; w1.x = pk2(v[j][0], v[j][1]); w1.y = pk2(v[j][2], v[j][3]); *(u32x2*)(x1p + (cb >> 1)) = w1;
                v[j] = y; amx = fmaxf(amx, fmaxf(fmaxf(fabsf(y[0]), fabsf(y[1])), fmaxf(fabsf(y[2]), fabsf(y[3])))); }
            if ((j & 1) == 1) __builtin_amdgcn_sched_barrier(0); }
        if (Q8) {
            const float am = wave_max_nonneg(amx), q = am > 0.f ? 127.0f / am : 0.f;
            asm volatile("" : "+v"(lanev));
#pragma unroll
            for (int j = 0; j < 16; ++j) { const unsigned cb = (unsigned)(64 * j + lanev) * 4u;
                const int q0 = (int)rintf(v[j][0] * q), q1 = (int)rintf(v[j][1] * q), q2 = (int)rintf(v[j][2] * q), q3 = (int)rintf(v[j][3] * q);
                *(unsigned*)(o8p + cb) = (unsigned)(q0 & 255) | ((unsigned)(q1 & 255) << 8) | ((unsigned)(q2 & 255) << 16) | ((unsigned)(q3 & 255) << 24); }
            if (lane == 0) S8[m] = am * (1.0f / 127.0f); } }
}

constexpr int SG_ROW = 272;
__device__ __forceinline__ void sgu_units(const Ctx& C, int u0, int uend, int ustep, LAS unsigned char* lds, int tid, int wave, int lane) {
#define SG_LBAR() do { asm volatile("s_waitcnt lgkmcnt(0)" ::: "memory"); __builtin_amdgcn_s_barrier(); asm volatile("" ::: "memory"); } while (0)
    const bf16* VT = (const bf16*)(C.ws + WS_VT); const bf16* U = (const bf16*)(C.ws + WS_U); bf16* Y = (bf16*)(C.ws + WS_Y);
    const float* stvs = (const float*)(C.ws + WS_STVS); const float* stvq = (const float*)(C.ws + WS_STVQ); float* stg = (float*)(C.ws + WS_STG);
    const bf16* WS = (const bf16*)(C.ws + WS_WSGU);
    LAS float* mu = (LAS float*)(lds + 128 * SG_ROW); LAS float* rstd = mu + 128;
    const int r = lane & 31, hi = lane >> 5, db = wave >> 1;
    u32x4 raw[4]; float gq[4]; float ps1 = 0.f, ps2 = 0.f;
#define SG_FETCH(unit_) do { const int hh_ = (unit_) & 15, n_ = ((unit_) >> 4) & 31, b_ = (unit_) >> 9, tok0_ = b_ * SEQ + n_ * GC; int tidv_ = tid; asm volatile("" : "+v"(tidv_)); \
        if (tidv_ < 128) { ps1 = sum_parts(stvs + (size_t)(tok0_ + tidv_) * 32, 8); ps2 = sum_parts(stvq + (size_t)(tok0_ + tidv_) * 32, 8); } \
        _Pragma("unroll") for (int i = 0; i < 4; ++i) { const int idx = tidv_ + 512 * i, d = idx >> 4, ch = idx & 15; \
            raw[i] = *(const u32x4*)(VT + ((size_t)b_ * GW + hh_ * 128 + d) * SEQ + n_ * GC + ch * 8); gq[i] = C.g_sgu[hh_ * 128 + d]; } } while (0)
    __syncthreads();
    if (u0 < uend) SG_FETCH(u0);
    for (int unit = u0; unit < uend; unit += ustep) {
        const int hh = unit & 15, n = (unit >> 4) & 31, b = unit >> 9, tok0 = b * SEQ + n * GC;
        if (tid < 128) { const float mean = ps1 * (1.0f / GW), var = fmaxf(ps2 * (1.0f / GW) - mean * mean, 0.f); mu[tid] = mean; rstd[tid] = rsqrtf(var + EPS); }
        bf16x8 wv[2][8]; u32x2 uu[2][4]; float bias[2];
#pragma unroll
        for (int tt = 0; tt < 2; ++tt) { const int t = 32 * (2 * (wave & 1) + tt) + r;
#pragma unroll
            for (int ks = 0; ks < 8; ++ks) wv[tt][ks] = *(const bf16x8*)(WS + ((size_t)hh * 128 + t) * 128 + 16 * ks + 8 * hi);
#pragma unroll
            for (int g4 = 0; g4 < 4; ++g4) uu[tt][g4] = *(const u32x2*)(U + (size_t)(tok0 + t) * GW + hh * 128 + 32 * db + 8 * g4 + 4 * hi);
            bias[tt] = C.b_sgu[hh * 128 + t]; }
        SG_LBAR();
#pragma unroll
        for (int i = 0; i < 4; ++i) { const int idx = tid + 512 * i, d = idx >> 4, ch = idx & 15;
            const float g = gq[i];
            float f[8];
#pragma unroll
            for (int e = 0; e < 4; ++e) { f[2 * e] = bf2f(raw[i][e] & 0xffffu); f[2 * e + 1] = bf2f(raw[i][e] >> 16); }
#pragma unroll
            for (int e = 0; e < 8; ++e) f[e] = (f[e] - mu[ch * 8 + e]) * rstd[ch * 8 + e] * g;
            u32x4 o; o.x = pk2(f[0], f[1]); o.y = pk2(f[2], f[3]); o.z = pk2(f[4], f[5]); o.w = pk2(f[6], f[7]);
            *(LAS u32x4*)(lds + d * SG_ROW + ch * 16) = o; }
        SG_LBAR();
        if (unit + ustep < uend) SG_FETCH(unit + ustep);
#pragma unroll
        for (int tt = 0; tt < 2; ++tt) { const int tb = 2 * (wave & 1) + tt;
            f32x16 acc; for (int i = 0; i < 16; ++i) acc[i] = 0.f;
#pragma unroll
            for (int ks = 0; ks < 8; ++ks) { if (ks <= 2 * tb + 1) {
                const bf16x8 a = *(const LAS bf16x8*)(lds + (32 * db + r) * SG_ROW + ks * 32 + hi * 16);
                acc = __builtin_amdgcn_mfma_f32_32x32x16_bf16(a, wv[tt][ks], acc, 0, 0, 0); } }
            const int t = 32 * tb + r, tok = tok0 + t; float ss = 0.f;
#pragma unroll
            for (int g4 = 0; g4 < 4; ++g4) { const int d0 = 32 * db + 8 * g4 + 4 * hi; const u32x2 u2 = uu[tt][g4];
                f32x4 y; y[0] = bf2f(u2.x & 0xffffu) * (acc[4 * g4 + 0] + bias[tt]); y[1] = bf2f(u2.x >> 16) * (acc[4 * g4 + 1] + bias[tt]);
                y[2] = bf2f(u2.y & 0xffffu) * (acc[4 * g4 + 2] + bias[tt]); y[3] = bf2f(u2.y >> 16) * (acc[4 * g4 + 3] + bias[tt]);
                ss += (y[0] * y[0] + y[1] * y[1]) + (y[2] * y[2] + y[3] * y[3]);
                st_bf16x4(Y + (size_t)tok * D + GW + hh * 128 + d0, y); }
            ss += __shfl_xor(ss, 32);
            if (hi == 0) ((LAS float*)(lds + 128 * SG_ROW + 1024))[t * 4 + db] = ss; }
        SG_LBAR();
        if (tid < 128) { const f32x4 p4 = *(const LAS f32x4*)(lds + 128 * SG_ROW + 1024 + tid * 16); stg[(size_t)(tok0 + tid) * 16 + hh] = (p4[0] + p4[1]) + (p4[2] + p4[3]); }
    }
    __syncthreads();
#undef SG_FETCH
#undef SG_LBAR
}

constexpr int AK_ROW = 400, AV_ROW = 144, AK_BYTES = 64 * AK_ROW, AV_BYTES = 128 * AV_ROW, ABUF = AK_BYTES + AV_BYTES;
__device__ __forceinline__ void attn_block(const Ctx& C, int b, int h, int qb, LAS unsigned char* lds, int tid, int wave, int lane) {
    const bf16* Q = (const bf16*)(C.ws + WS_Q); const bf16* KN = (const bf16*)(C.ws + WS_KN); const bf16* KPE = (const bf16*)(C.ws + WS_KPE);
    const bf16* VTA = (const bf16*)(C.ws + WS_VTA); bf16* Y = (bf16*)(C.ws + WS_Y); float* stm = (float*)(C.ws + WS_STM);
    const int r = lane & 31, hi = lane >> 5, q0 = qb * 256, q0w = q0 + 32 * wave; const size_t tokq = (size_t)b * SEQ + q0w + r;
    bf16x8 qf[12];
#pragma unroll
    for (int ks = 0; ks < 12; ++ks) qf[ks] = *(const bf16x8*)(Q + tokq * (NH * QKD) + h * QKD + 16 * ks + 8 * hi);
    f32x16 o[4];
#pragma unroll
    for (int db = 0; db < 4; ++db) for (int i = 0; i < 16; ++i) o[db][i] = 0.f;
    float mrun = -1e30f, lrun = 0.f;
    const int ntiles = (q0 + 256) / 64;
    const int kr0 = tid >> 4, kc0 = tid & 15, pr = tid >> 3, pc = tid & 7;
    const unsigned ok0 = (((unsigned)b * SEQ + kr0) * (NH * NOPE) + h * NOPE + kc0 * 8) * 2u;
    const unsigned op0 = (((unsigned)b * SEQ + pr) * ROPE + pc * 8) * 2u;
    const unsigned ov0 = ((((unsigned)b * NH + h) * VD + pr) * SEQ + pc * 8) * 2u;
    const unsigned lk0 = kr0 * AK_ROW + kc0 * 16, lk1 = (kr0 + 32) * AK_ROW + kc0 * 16, lp = pr * AK_ROW + 256 + pc * 16;
    const unsigned lv0 = AK_BYTES + pr * AV_ROW + pc * 16, lv1 = AK_BYTES + (pr + 64) * AV_ROW + pc * 16;
    u32x4 st[5];
#define ATT_GLOAD(j) do { const unsigned j_ = (unsigned)(j); \
        st[0] = *(const u32x4*)((const char*)KN + (ok0 + j_ * (64u * NH * NOPE * 2u))); st[1] = *(const u32x4*)((const char*)KN + (ok0 + j_ * (64u * NH * NOPE * 2u) + 32u * NH * NOPE * 2u)); \
        st[2] = *(const u32x4*)((const char*)KPE + (op0 + j_ * (64u * ROPE * 2u))); \
        st[3] = *(const u32x4*)((const char*)VTA + (ov0 + j_ * 128u)); st[4] = *(const u32x4*)((const char*)VTA + (ov0 + j_ * 128u + 64u * SEQ * 2u)); } while (0)
    ATT_GLOAD(0);
    for (int j = 0; j < ntiles; ++j) {
        LAS unsigned char* buf = lds + (j & 1) * ABUF;
        *(LAS u32x4*)(buf + lk0) = st[0]; *(LAS u32x4*)(buf + lk1) = st[1]; *(LAS u32x4*)(buf + lp) = st[2]; *(LAS u32x4*)(buf + lv0) = st[3]; *(LAS u32x4*)(buf + lv1) = st[4];
        if (j + 1 < ntiles) ATT_GLOAD(j + 1);
        __syncthreads();
        const int kbase = 64 * j;
        if (kbase <= q0w + 31) {
            f32x16 s0, s1;
#pragma unroll
            for (int i = 0; i < 16; ++i) { s0[i] = 0.f; s1[i] = 0.f; }
#pragma unroll
            for (int ks = 0; ks < 12; ++ks) {
                const bf16x8 k0 = *(const LAS bf16x8*)(buf + r * AK_ROW + ks * 32 + hi * 16);
                const bf16x8 k1 = *(const LAS bf16x8*)(buf + (32 + r) * AK_ROW + ks * 32 + hi * 16);
                s0 = __builtin_amdgcn_mfma_f32_32x32x16_bf16(k0, qf[ks], s0, 0, 0, 0);
                s1 = __builtin_amdgcn_mfma_f32_32x32x16_bf16(k1, qf[ks], s1, 0, 0, 0);
                if ((ks & 3) == 3) __builtin_amdgcn_sched_barrier(0); }
            if (kbase + 63 > q0w) {
                const int qrow = q0w + r;
#pragma unroll
                for (int i = 0; i < 16; ++i) { const int key = kbase + (i & 3) + 8 * (i >> 2) + 4 * hi;
                    s0[i] = key > qrow ? -INFINITY : s0[i]; s1[i] = key + 32 > qrow ? -INFINITY : s1[i]; }
            }
            float mx = fmaxf(s0[0], s1[0]);
#pragma unroll
            for (int i = 1; i < 16; ++i) mx = fmaxf(mx, fmaxf(s0[i], s1[i]));
            mx = fmaxf(mx, __shfl_xor(mx, 32));
            if (!__all(mx - mrun <= 8.0f)) { const float mn = fmaxf(mrun, mx), alpha = __builtin_amdgcn_exp2f(mrun - mn); mrun = mn; lrun *= alpha;
#pragma unroll
                for (int db = 0; db < 4; ++db)
#pragma unroll
                    for (int i = 0; i < 16; ++i) o[db][i] *= alpha; }
            float rsum = 0.f;
#pragma unroll
            for (int i = 0; i < 16; ++i) { s0[i] = __builtin_amdgcn_exp2f(s0[i] - mrun); s1[i] = __builtin_amdgcn_exp2f(s1[i] - mrun); rsum += s0[i] + s1[i]; }
            lrun += rsum;
            bf16x8 pf[4];
#pragma unroll
            for (int t = 0; t < 2; ++t) {
                u32x4 w0, w1;
#pragma unroll
                for (int e = 0; e < 4; ++e) { w0[e] = pk2(s0[8 * t + 2 * e], s0[8 * t + 2 * e + 1]); w1[e] = pk2(s1[8 * t + 2 * e], s1[8 * t + 2 * e + 1]); }
                pf[t] = __builtin_bit_cast(bf16x8, w0); pf[2 + t] = __builtin_bit_cast(bf16x8, w1); }
#pragma unroll
            for (int s4 = 0; s4 < 4; ++s4)
#pragma unroll
                for (int db = 0; db < 4; ++db) {
                    const bf16x8 v = *(const LAS bf16x8*)(buf + AK_BYTES + (32 * db + r) * AV_ROW + s4 * 32 + hi * 16);
                    o[db] = __builtin_amdgcn_mfma_f32_32x32x16_bf16(v, pf[s4], o[db], 0, 0, 0); }
        }
    }
#undef ATT_GLOAD
    const float lt = lrun + __shfl_xor(lrun, 32), inv = 1.0f / lt; float ss = 0.f;
#pragma unroll
    for (int db = 0; db < 4; ++db)
#pragma unroll
        for (int g4 = 0; g4 < 4; ++g4) { const int d0 = 32 * db + 8 * g4 + 4 * hi;
            f32x4 y; y[0] = o[db][4 * g4] * inv; y[1] = o[db][4 * g4 + 1] * inv; y[2] = o[db][4 * g4 + 2] * inv; y[3] = o[db][4 * g4 + 3] * inv;
            ss += (y[0] * y[0] + y[1] * y[1]) + (y[2] * y[2] + y[3] * y[3]);
            st_bf16x4(Y + tokq * D + h * VD + d0, y); }
    ss += __shfl_xor(ss, 32);
    if (hi == 0) stm[tokq * 16 + h] = ss;
}

#define CE_DESC(a, b) do { const float hi_ = fmaxf(a, b), lo_ = fminf(a, b); a = hi_; b = lo_; } while (0)
#define CE_ASC(a, b) do { const float hi_ = fmaxf(a, b), lo_ = fminf(a, b); a = lo_; b = hi_; } while (0)
__device__ __forceinline__ void bitonic_merge16_desc(float (&v)[64], const int base) {
#pragma unroll
    for (int j = 8; j > 0; j >>= 1)
#pragma unroll
        for (int i = 0; i < 16; ++i) { const int l = i ^ j; if (l > i) CE_DESC(v[base + i], v[base + l]); }
}
__device__ __forceinline__ void bitonic_sort16_desc(float (&v)[64], const int base) {
#pragma unroll
    for (int k = 2; k <= 16; k <<= 1)
#pragma unroll
        for (int j = k >> 1; j > 0; j >>= 1)
#pragma unroll
            for (int i = 0; i < 16; ++i) { const int l = i ^ j; if (l > i) { if ((i & k) == 0) CE_DESC(v[base + i], v[base + l]); else CE_ASC(v[base + i], v[base + l]); } }
}
__device__ __forceinline__ void merge_top16(float (&v)[64], const int a0, const int b0) {
#pragma unroll
    for (int i = 0; i < 16; ++i) v[a0 + i] = fmaxf(v[a0 + i], v[b0 + 15 - i]);
    bitonic_merge16_desc(v, a0);
}
__device__ __forceinline__ void top16_of_64(float (&v)[64]) {
    bitonic_sort16_desc(v, 0); bitonic_sort16_desc(v, 16); bitonic_sort16_desc(v, 32); bitonic_sort16_desc(v, 48);
    merge_top16(v, 0, 16); merge_top16(v, 32, 48); merge_top16(v, 0, 32);
}
__device__ __forceinline__ void topk_item(const Ctx& C, int item, LAS float* top  , LAS int* pe, LAS float* pg, int lane) {
    const bf16* QP = (const bf16*)(C.ws + WS_QP); const bf16* KEYS = (const bf16*)(C.ws + WS_KEYS);
    const int tb = item >> 3, hh = item & 7, r = lane & 31, hi = lane >> 5; const size_t tok = (size_t)tb * 32 + r;
#pragma unroll 1
    for (int p = 0; p < 2; ++p) {
        f32x16 sc[4];
#pragma unroll
        for (int nb = 0; nb < 4; ++nb) for (int i = 0; i < 16; ++i) sc[nb][i] = 0.f;
#pragma unroll
        for (int ks = 0; ks < 8; ++ks) {
            const bf16x8 bq = *(const bf16x8*)(QP + tok * PQW + hh * PQD + p * PHALF + 16 * ks + 8 * hi);
#pragma unroll
            for (int nb = 0; nb < 4; ++nb) {
                const bf16x8 ak = *(const bf16x8*)(KEYS + ((size_t)(hh * 2 + p) * PNK + 32 * nb + r) * PHALF + 16 * ks + 8 * hi);
                sc[nb] = __builtin_amdgcn_mfma_f32_32x32x16_bf16(ak, bq, sc[nb], 0, 0, 0); } }
        float v[64];
#pragma unroll
        for (int nb = 0; nb < 4; ++nb)
#pragma unroll
            for (int i = 0; i < 16; ++i) { const unsigned n = 32 * nb + (i & 3) + 8 * (i >> 2) + 4 * hi;
                const float scv = sc[nb][i]; v[nb * 16 + i] = __uint_as_float((__float_as_uint(scv) & 0xffffff80u) | n); }
        top16_of_64(v);
#pragma unroll
        for (int i = 0; i < 16; ++i) v[16 + i] = __shfl_xor(v[i], 32);
        merge_top16(v, 0, 16);
#pragma unroll
        for (int k = 0; k < 16; ++k) top[(p * 16 + k) * 64 + lane] = v[k];
    }
    LDS_WAIT();
    float sv0[16], sv1[16];
#pragma unroll
    for (int a = 0; a < 16; ++a) { sv0[a] = top[a * 64 + lane]; sv1[a] = top[(16 + a) * 64 + lane]; }
    float cd[64];
    { int c = 0;
#pragma unroll
      for (int a = 0; a < 16; ++a)
#pragma unroll
        for (int b = 0; b < 16; ++b) if ((a + 1) * (b + 1) <= 16) { cd[c] = __builtin_bit_cast(float, (__builtin_bit_cast(unsigned, sv0[a] + sv1[b]) & ~255u) | (unsigned)(a * 16 + b)); ++c; }
#pragma unroll
      for (int i = 50; i < 64; ++i) cd[i] = -INFINITY; }
    top16_of_64(cd);
#pragma unroll
    for (int k = 0; k < 16; ++k) top[(32 + k) * 64 + lane] = cd[k];
    LDS_WAIT();
    if (hi == 0) {
        const float s0 = top[32 * 64 + lane]; float ev[16]; int ei[16]; float sum = 0.f;
#pragma unroll
        for (int k = 0; k < 16; ++k) { const float s = top[(32 + k) * 64 + lane]; const unsigned code = __builtin_bit_cast(unsigned, s) & 255u, a = code >> 4, b = code & 15u;
            const unsigned i0 = __builtin_bit_cast(unsigned, top[a * 64 + lane]) & 127u, i1 = __builtin_bit_cast(unsigned, top[(16 + b) * 64 + lane]) & 127u;
            ei[k] = (int)(i0 * PNK + i1); ev[k] = __expf(s - s0); sum += ev[k]; }
        const float inv = 1.0f / sum;
        int rv = r; asm volatile("" : "+v"(rv));
#pragma unroll
        for (int k = 0; k < 16; ++k) { pe[rv * 128 + hh * 16 + k] = ei[k]; pg[rv * 128 + hh * 16 + k] = ev[k] * inv; }
    }
    LDS_WAIT();
}

__device__ __forceinline__ void order_pairs(const Ctx& C, int tb, LAS unsigned char* lds, int tid) {
    LAS int* pe = (LAS int*)(lds + 98304); LAS float* pg = (LAS float*)(lds + 98304 + 16384);
    LAS int* pe2 = (LAS int*)lds; LAS float* pg2 = (LAS float*)(lds + 32 * 129 * 4);
    int* lidx = (int*)(C.ws + WS_LIDX); float* lg = (float*)(C.ws + WS_LG); int* na = (int*)(C.ws + WS_NA);
    const int tk = tid >> 4, sub = tid & 15;
    int e[8]; float g[8]; int cnt = 0;
#pragma unroll
    for (int i = 0; i < 8; ++i) { e[i] = pe[tk * 128 + sub * 8 + i]; g[i] = pg[tk * 128 + sub * 8 + i]; cnt += (e[i] < PNE / 2) ? 1 : 0; }
    int inc = cnt;
#pragma unroll
    for (int o = 1; o < 16; o <<= 1) { const int v = __shfl_up(inc, o, 16); if (sub >= o) inc += v; }
    const int total = __shfl(inc, 15, 16); int pa = inc - cnt, pb = total + (sub * 8 - (inc - cnt));
#pragma unroll
    for (int i = 0; i < 8; ++i) { const bool isa = e[i] < PNE / 2; const int pos = isa ? pa : pb; pa += isa ? 1 : 0; pb += isa ? 0 : 1; pe2[tk * 129 + pos] = e[i]; pg2[tk * 129 + pos] = g[i]; }
    if (sub == 0) na[tb * 32 + tk] = total;
    __syncthreads();
#pragma unroll
    for (int i = 0; i < 8; ++i) { const int idx = i * 512 + tid, pos = idx >> 5, t2 = idx & 31;
        lidx[(size_t)pos * M + tb * 32 + t2] = pe2[t2 * 129 + pos]; lg[(size_t)pos * M + tb * 32 + t2] = pg2[t2 * 129 + pos]; }
}

__device__ __forceinline__ void expert_convert_unit(const Ctx& C, int u, LAS unsigned char* lds, int tid) {
    const int tbl = u >> 12, eb = (u >> 4) & 255, r = u & 15, row = tid >> 3, cq = tid & 7;
    const float* src = (tbl ? C.ev : C.eu) + (size_t)(eb * 64 + row) * D + r * 256 + cq * 32;
    f32x4 v[8]; float am = 0.f;
#pragma unroll
    for (int j = 0; j < 8; ++j) { v[j] = ((const f32x4*)src)[j]; am = fmaxf(am, fmaxf(fmaxf(fabsf(v[j][0]), fabsf(v[j][1])), fmaxf(fabsf(v[j][2]), fabsf(v[j][3])))); }
    am = fmaxf(am, __shfl_xor(am, 1)); am = fmaxf(am, __shfl_xor(am, 2)); am = fmaxf(am, __shfl_xor(am, 4));
    const float sc = am > 0.f ? 127.0f / am : 0.f, inv = am * (1.0f / 127.0f);
#pragma unroll
    for (int i = 0; i < 4; ++i) { unsigned w[2];
#pragma unroll
        for (int h = 0; h < 2; ++h) { const f32x4 x = v[2 * i + h] * sc;
            w[h] = (unsigned)((int)rintf(x[0]) & 255) | ((unsigned)((int)rintf(x[1]) & 255) << 8) | ((unsigned)((int)rintf(x[2]) & 255) << 16) | ((unsigned)((int)rintf(x[3]) & 255) << 24); }
        *(LAS u32x2*)(lds + (cq * 4 + i) * 512 + row * 8) = (u32x2){w[0], w[1]}; }
    if (cq == 0) ((float*)(C.ws + WS_ESC))[(size_t)PNE * 16 + (size_t)r * PNE + eb * 64 + row] = inv;
    __syncthreads();
    unsigned char* dst = C.ws + WS_E8 + (size_t)tbl * (64 * MiB);
#pragma unroll
    for (int i = 0; i < 2; ++i) { const int p = tid + 512 * i, ls = p >> 5, off = (p & 31) * 16;
        *(u32x4*)(dst + ((size_t)(r * 32 + ls) * PNE + eb * 64) * 8 + off) = *(const LAS u32x4*)(lds + ls * 512 + off); }
    __syncthreads();
}
__device__ __forceinline__ void expert_convert_u(const Ctx& C, int e, int lane) {
    const f32x4* src = (const f32x4*)(C.eu + (size_t)e * D) + lane;
    f32x4 v[16]; float am = 0.f;
#pragma unroll
    for (int j = 0; j < 16; ++j) v[j] = src[j * 64];
#pragma unroll
    for (int j = 0; j < 16; ++j) am = fmaxf(am, fmaxf(fmaxf(fabsf(v[j][0]), fabsf(v[j][1])), fmaxf(fabsf(v[j][2]), fabsf(v[j][3]))));
    am = wave_max_nonneg(am);
    const float sc = am > 0.f ? 127.0f / am : 0.f;
    const int el = e >> 4, et = (e ^ (e >> 7)) & 15, sw = (el >> 1) & 7;
    unsigned char* dst = C.ws + WS_E8 + ((size_t)(et * 32 + (lane >> 5)) * 1024 + el) * 128 + (((((lane & 31) >> 2) ^ sw) << 4) | ((lane & 3) << 2));
#pragma unroll
    for (int j = 0; j < 16; ++j) { const f32x4 x = v[j] * sc;
        *(unsigned*)(dst + (size_t)j * 262144) = (unsigned)((int)rintf(x[0]) & 255) | ((unsigned)((int)rintf(x[1]) & 255) << 8) | ((unsigned)((int)rintf(x[2]) & 255) << 16) | ((unsigned)((int)rintf(x[3]) & 255) << 24); }
    if (lane == 0) ((float*)(C.ws + WS_ESC))[e] = am * (1.0f / 127.0f);
}
#define PEER_FILL(tblbase, slice) do { const unsigned char* g_ = (tblbase) + (size_t)(slice) * (PNE * 8) + lane * 16; \
    _Pragma("unroll") for (int i_ = 0; i_ < 16; ++i_) { const int c_ = wave * 16 + i_; \
        __builtin_amdgcn_global_load_lds((const unsigned*)(g_ + c_ * 1024), (LAS unsigned*)(lds + c_ * 1024), 16, 0, 0); } } while (0)
#define PEER_WARM(tblbase, slice) do { const unsigned char* g_ = (tblbase) + (size_t)(slice) * (PNE * 8) + lane * 16; \
    _Pragma("unroll") for (int i_ = 0; i_ < 16; ++i_) { const int c_ = wave * 16 + i_; \
        __builtin_amdgcn_global_load_lds((const unsigned*)(g_ + c_ * 1024), (LAS unsigned*)(lds + 131072 + wave * 1024), 16, 0, 0); } } while (0)
typedef int i32x4 __attribute__((ext_vector_type(4)));
constexpr int UNG = 12;
__device__ __forceinline__ void peer_u_item(const Ctx& C, int tg, int et, LAS unsigned char* lds, int tid, int wave, int lane) {
    const int* lidx = (const int*)(C.ws + WS_LIDX); const signed char* H8 = (const signed char*)(C.ws + WS_H8); float* S = (float*)(C.ws + WS_PART); const float* sh = (const float*)(C.ws + WS_SH);
    const unsigned char* U8M = C.ws + WS_E8;
    const int tokw = tg * 512 + wave * 64;
    LAS int* Wa = (LAS int*)(lds + wave * 16384); LAS int* Wcn = Wa + 1280; LAS int* Wt = Wa + 1344; LAS int* Wo = Wa + 2048;
    __syncthreads();
#pragma unroll
    for (int i = 0; i < 20; ++i) Wa[i * 64 + lane] = -1;
    Wcn[lane] = 0;
    LDS_WAIT();
#define UCOL(q_) (((q_) & 1) ? 4 + ((q_) >> 1) : ((((q_) >> 1) < 4) ? ((q_) >> 1) : ((q_) >> 1) + 8))
#define PU_SLOW(tokl_, k2_, el_) do { const int tok_ = tokw + (tokl_), sw_ = ((el_) >> 1) & 7; int dsum_ = 0; \
        const unsigned char* trow_ = U8M + ((size_t)(et * 32 + (lane >> 1)) * 1024 + (el_)) * 128; \
        _Pragma("unroll") for (int q_ = 0; q_ < 4; ++q_) { const i32x4 hv_ = *(const i32x4*)(H8 + (size_t)tok_ * D + lane * 64 + q_ * 16), tv_ = *(const i32x4*)(trow_ + ((((lane & 1) * 4 + q_) ^ sw_) << 4)); \
            dsum_ = __builtin_amdgcn_sdot4(hv_[0], tv_[0], dsum_, false); dsum_ = __builtin_amdgcn_sdot4(hv_[1], tv_[1], dsum_, false); dsum_ = __builtin_amdgcn_sdot4(hv_[2], tv_[2], dsum_, false); dsum_ = __builtin_amdgcn_sdot4(hv_[3], tv_[3], dsum_, false); } \
        _Pragma("unroll") for (int o_ = 32; o_ >= 1; o_ >>= 1) dsum_ += __shfl_xor(dsum_, o_); \
        if (lane == 0) S[(size_t)(k2_) * M + tok_] = (float)dsum_ * sh[tok_]; } while (0)
    const int sgl = lane >> 4, tl = lane & 15;
    {
      int oc = 0;
      unsigned loff = (unsigned)(tokw + lane) * 4u;
#pragma unroll 1
      for (int kb = 0; kb < 2; ++kb) { int ev[64];
#pragma unroll
          for (int j = 0; j < 64; ++j) { ev[j] = *(const int*)((const char*)lidx + loff); loff += (unsigned)M * 4u; asm volatile("" : "+v"(loff)); }
#pragma unroll
          for (int j0 = 0; j0 < 64; j0 += 8) { int rk[8]; int oc = 0;
#pragma unroll
              for (int i = 0; i < 8; ++i) { const int e = ev[j0 + i], q = (e >> 4) & 15; rk[i] = 0;
                  if (((e ^ (e >> 7)) & 15) == et) rk[i] = __hip_atomic_fetch_add(&Wcn[sgl * 16 + q], 1, __ATOMIC_RELAXED, __HIP_MEMORY_SCOPE_WORKGROUP); }
#pragma unroll
              for (int i = 0; i < 8; ++i) { const int e = ev[j0 + i], k = kb * 64 + j0 + i, el = e >> 4, q = el & 15; const bool match = ((e ^ (e >> 7)) & 15) == et;
                  if (match && rk[i] < 20) Wa[sgl * 320 + rk[i] * 16 + UCOL(q)] = el | (tl << 10) | (k << 14);
                  const bool ov = match && rk[i] >= 20;
                  const unsigned long long ovm = __builtin_amdgcn_ballot_w64(ov);
                  if (ov) Wo[oc + (int)__builtin_amdgcn_mbcnt_hi((unsigned)(ovm >> 32), __builtin_amdgcn_mbcnt_lo((unsigned)ovm, 0u))] = (lane << 17) | (k << 10) | el;
                  oc += __builtin_popcountll(ovm); }
              if (oc != 0) { LDS_WAIT();
#pragma unroll 1
                  for (int u = 0; u < oc; ++u) { const int ent = __builtin_amdgcn_readfirstlane(Wo[u]); PU_SLOW(ent >> 17, (ent >> 10) & 127, ent & 1023); } } } }
    }
    LDS_WAIT();
    int NGs;
    {
      const int cq = min(Wcn[lane], 20); int N = cq;
#pragma unroll
      for (int o = 1; o < 16; o <<= 1) N += __shfl_xor(N, o, 16);
      NGs = (N > 160) ? 12 : 10;
      const int exc = max(cq - NGs, 0), fre = max(NGs - cq, 0); int ie = exc, ifr = fre;
#pragma unroll
      for (int o = 1; o < 16; o <<= 1) { const int v0 = __shfl_up(ie, o, 16), v1 = __shfl_up(ifr, o, 16); if (tl >= o) { ie += v0; ifr += v1; } }
      const int E = __shfl(ie, 15, 16), F = __shfl(ifr, 15, 16), exoff = ie - exc, froff = ifr - fre, nq = UCOL(tl);
#pragma unroll
      for (int i = 0; i < 10; ++i) if (i < exc) Wt[sgl * 128 + exoff + i] = Wa[sgl * 320 + (NGs + i) * 16 + nq];
      LDS_WAIT();
#pragma unroll
      for (int j = 0; j < 12; ++j) if (j < fre && froff + j < E) Wa[sgl * 320 + (cq + j) * 16 + nq] = Wt[sgl * 128 + froff + j];
      LDS_WAIT();
#pragma unroll
      for (int s4 = 0; s4 < 4; ++s4) { const int Es = __builtin_amdgcn_readlane(E, s4 * 16), Fs = __builtin_amdgcn_readlane(F, s4 * 16);
#pragma unroll 1
          for (int i = Fs; i < Es; ++i) { const int ent = __builtin_amdgcn_readfirstlane(Wt[s4 * 128 + i]); PU_SLOW(s4 * 16 + ((ent >> 10) & 15), (ent >> 14) & 127, ent & 1023); } }
    }
#undef PU_SLOW
    const int n = lane & 15, g = lane >> 4;
    unsigned ci[4][UNG]; int acc[4][UNG]; int NP[4];
    { const int qn = (n >= 4 && n < 12) ? (n - 4) * 2 + 1 : ((n < 4) ? n : n - 8) * 2;
#pragma unroll
      for (int s4 = 0; s4 < 4; ++s4) { NP[s4] = __builtin_amdgcn_readlane(NGs, s4 * 16) >> 1;
#pragma unroll
        for (int m = 0; m < UNG; ++m) { const int raw = Wa[s4 * 320 + m * 16 + n]; const bool valid = raw >= 0;
            const int row = valid ? (raw & 1023) : qn, tl2 = valid ? ((raw >> 10) & 15) : 0, k = valid ? ((raw >> 14) & 127) : 0;
            ci[s4][m] = (unsigned)(row * 128 + ((g ^ ((row >> 1) & 7)) << 4)) | ((unsigned)k << 17) | ((unsigned)(tl2 >> 2) << 24) | ((unsigned)(valid ? 1 : 0) << 26) | ((unsigned)((tl2 >> 1) & 1) << 30) | ((unsigned)(tl2 & 1) << 31);
            acc[s4][m] = 0; } } }
#undef UCOL
    const char* H8c = (const char*)H8; const unsigned aoff = (unsigned)(tokw + n) * (unsigned)D + (unsigned)g * 16u;
    i32x4 a[4][2];
#define PU_ALOAD(s_, ks_) do { _Pragma("unroll") for (int h_ = 0; h_ < 2; ++h_) a[s_][h_] = *(const i32x4*)(H8c + (aoff + (unsigned)((ks_) * 128 + (s_) * 16 * D + h_ * 64))); } while (0)
#define PU_LOAD2(dst, s_, m_) do { const unsigned a0_ = ci[s_][m_] & 0x1ffffu, a1_ = ci[s_][(m_) + 1] & 0x1ffffu; \
        dst[0][0] = *(const LAS i32x4*)(lds + a0_); dst[1][0] = *(const LAS i32x4*)(lds + a1_); dst[0][1] = *(const LAS i32x4*)(lds + (a0_ ^ 64u)); dst[1][1] = *(const LAS i32x4*)(lds + (a1_ ^ 64u)); } while (0)
#define PU_SEL(d_, c_, ac_) do { const int m0_ = (int)(c_) >> 31, m1_ = __builtin_amdgcn_sbfe((int)(c_), 30u, 1u); \
        const int lo_ = (d_[1] & m0_) | (d_[0] & ~m0_), hi_ = (d_[3] & m0_) | (d_[2] & ~m0_); ac_ += (hi_ & m1_) | (lo_ & ~m1_); } while (0)
#define PU_PAIR(src, s_, m_) do { i32x4 d0_ = {0, 0, 0, 0}, d1_ = {0, 0, 0, 0}; \
        d0_ = __builtin_amdgcn_mfma_i32_16x16x64_i8(a[s_][0], src[0][0], d0_, 0, 0, 0); d1_ = __builtin_amdgcn_mfma_i32_16x16x64_i8(a[s_][0], src[1][0], d1_, 0, 0, 0); \
        d0_ = __builtin_amdgcn_mfma_i32_16x16x64_i8(a[s_][1], src[0][1], d0_, 0, 0, 0); d1_ = __builtin_amdgcn_mfma_i32_16x16x64_i8(a[s_][1], src[1][1], d1_, 0, 0, 0); \
        PU_SEL(d0_, ci[s_][m_], acc[s_][m_]); PU_SEL(d1_, ci[s_][(m_) + 1], acc[s_][(m_) + 1]); asm volatile("" : "+v"(acc[s_][m_]), "+v"(acc[s_][(m_) + 1])); } while (0)
#pragma unroll
    for (int s4 = 0; s4 < 4; ++s4) PU_ALOAD(s4, 0);
#pragma unroll 1
    for (int ks = 0; ks < 32; ++ks) {
        __syncthreads();
#pragma unroll
        for (int s4 = 0; s4 < 4; ++s4)
#pragma unroll
            for (int m = 0; m < UNG; ++m) asm volatile("" : "+v"(ci[s4][m]));
        PEER_FILL(U8M, et * 32 + ks);
        if (tg == (ks & 15) && ks + 1 < 32) PEER_WARM(U8M, et * 32 + ks + 1);
        VM_WAIT(); __syncthreads();
        {
          i32x4 bA[2][2], bB[2][2], bC[2][2];
          PU_LOAD2(bA, 0, 0); PU_LOAD2(bB, 0, 2); PU_LOAD2(bC, 0, 4);
#pragma unroll
          for (int blk = 0; blk < 24; ++blk) { const int s4 = blk / 6, p = blk % 6, nb = blk + 3, ns = nb / 6, np = nb % 6;
              if (blk % 3 == 0)      { if (p < 5 || NP[s4] > 5) PU_PAIR(bA, s4, 2 * p); if (nb < 24 && (np < 5 || NP[ns] > 5)) PU_LOAD2(bA, ns, 2 * np); }
              else if (blk % 3 == 1) { if (p < 5 || NP[s4] > 5) PU_PAIR(bB, s4, 2 * p); if (nb < 24 && (np < 5 || NP[ns] > 5)) PU_LOAD2(bB, ns, 2 * np); }
              else                   { if (p < 5 || NP[s4] > 5) PU_PAIR(bC, s4, 2 * p); if (nb < 24 && (np < 5 || NP[ns] > 5)) PU_LOAD2(bC, ns, 2 * np); }
              __builtin_amdgcn_sched_barrier(0);
              if (p == 5) { if (ks + 1 < 32) PU_ALOAD(s4, ks + 1);
                  __builtin_amdgcn_sched_barrier(0); } } }
    }
#undef PU_ALOAD
#undef PU_LOAD2
#undef PU_SEL
#undef PU_PAIR
#pragma unroll
    for (int s4 = 0; s4 < 4; ++s4)
#pragma unroll
        for (int m = 0; m < UNG; ++m) { if ((m >> 1) < NP[s4]) { const unsigned c = ci[s4][m];
            if (((c >> 26) & 1u) != 0u && (int)((c >> 24) & 3u) == g) { const int tok = tokw + s4 * 16 + g * 4 + (int)(c >> 31) + 2 * (int)((c >> 30) & 1u), k = (int)((c >> 17) & 127u);
                S[(size_t)k * M + tok] = (float)acc[s4][m] * sh[tok]; } } }
    __syncthreads();
}
__device__ __forceinline__ void peer_gates(const Ctx& C, int gt, int NGT) {
    const int* lidx = (const int*)(C.ws + WS_LIDX); const float* lg = (const float*)(C.ws + WS_LG); const float* part = (const float*)(C.ws + WS_PART);
    const float* usc = (const float*)(C.ws + WS_ESC); float* at = (float*)(C.ws + WS_AT);
#pragma unroll 4
    for (int idx = gt; idx < 128 * M; idx += NGT) { const int e = lidx[idx]; const float s = part[idx] * usc[e];
        at[idx] = 0.5f * s * (1.0f + erff(s * 0.70710678f)) * lg[idx]; }
}
__device__ __forceinline__ void peer_v_item(const Ctx& C, int tg, int r, LAS unsigned char* lds, int tid, int wave, int lane) {
    const int* lidx = (const int*)(C.ws + WS_LIDX); const float* sdot = (const float*)(C.ws + WS_PART); const float* lg = (const float*)(C.ws + WS_LG);
    const unsigned char* vscr = (const unsigned char*)((const float*)(C.ws + WS_ESC) + (size_t)PNE * 16 + (size_t)r * PNE); const unsigned char* uscr = (const unsigned char*)(C.ws + WS_ESC);
    const unsigned char* V8T = C.ws + WS_E8 + 64 * MiB; bf16* ft = (bf16*)(C.ws + WS_FT);
    const int t = tg * 512 + tid;
    unsigned ei[64], a8[32]; float os;
    { float af[128]; float am = 0.f;
      __syncthreads();
#pragma unroll
      for (int i = 0; i < 8; ++i) { const int c = wave * 8 + i; __builtin_amdgcn_global_load_lds((const unsigned*)(vscr + c * 1024 + lane * 16), (LAS unsigned*)(lds + c * 1024), 16, 0, 0);
          __builtin_amdgcn_global_load_lds((const unsigned*)(uscr + c * 1024 + lane * 16), (LAS unsigned*)(lds + 65536 + c * 1024), 16, 0, 0); }
      VM_WAIT(); __syncthreads();
      unsigned loff = (unsigned)t * 4u;
#pragma unroll
      for (int j = 0; j < 64; ++j) { const unsigned e0 = *(const unsigned*)((const char*)lidx + loff), e1 = *(const unsigned*)((const char*)lidx + (loff + (unsigned)M * 4u)); ei[j] = e0 | (e1 << 16);
          const float s0 = *(const float*)((const char*)sdot + loff) * *(const LAS float*)(lds + 65536 + e0 * 4u), s1 = *(const float*)((const char*)sdot + (loff + (unsigned)M * 4u)) * *(const LAS float*)(lds + 65536 + e1 * 4u);
          af[2 * j] = gelu_f(s0) * *(const float*)((const char*)lg + loff) * *(const LAS float*)(lds + e0 * 4u); af[2 * j + 1] = gelu_f(s1) * *(const float*)((const char*)lg + (loff + (unsigned)M * 4u)) * *(const LAS float*)(lds + e1 * 4u);
          loff += 2u * M * 4u; asm volatile("" : "+v"(loff));
          if ((j & 7) == 7) __builtin_amdgcn_sched_barrier(0); }
#pragma unroll
      for (int k = 0; k < 128; ++k) am = fmaxf(am, fabsf(af[k]));
      const float q = am > 0.f ? 127.0f / am : 0.f; os = am * (1.0f / 127.0f);
#pragma unroll
      for (int j = 0; j < 32; ++j) a8[j] = (unsigned)((int)rintf(af[4 * j] * q) & 255) | ((unsigned)((int)rintf(af[4 * j + 1] * q) & 255) << 8) | ((unsigned)((int)rintf(af[4 * j + 2] * q) & 255) << 16) | ((unsigned)((int)rintf(af[4 * j + 3] * q) & 255) << 24); }
#pragma unroll 1
    for (int s = 0; s < 32; ++s) { const int slice = r * 32 + s;
        __syncthreads();
#pragma unroll
        for (int j = 0; j < 64; ++j) asm volatile("" : "+v"(ei[j]));
        PEER_FILL(V8T, slice);
        if (tg == (s & 15) && s + 1 < 32) PEER_WARM(V8T, slice + 1);
        VM_WAIT(); __syncthreads();
        int o[8];
#pragma unroll
        for (int i = 0; i < 8; ++i) o[i] = 0;
#define PV_LOAD(dst, k0) do { _Pragma("unroll") for (int j_ = 0; j_ < 8; ++j_) { const int k_ = (k0) + j_; const unsigned e_ = (k_ & 1) ? (ei[k_ >> 1] >> 16) : (ei[k_ >> 1] & 0xffffu); dst[j_] = *(const LAS u32x2*)(lds + e_ * 8); } } while (0)
#define PV_Q(w0, w1, w2, w3, ab, ob) do { const unsigned t0_ = __builtin_amdgcn_perm(w1, w0, 0x05010400u), t1_ = __builtin_amdgcn_perm(w1, w0, 0x07030602u), u0_ = __builtin_amdgcn_perm(w3, w2, 0x05010400u), u1_ = __builtin_amdgcn_perm(w3, w2, 0x07030602u); \
            o[ob] = __builtin_amdgcn_sdot4((int)__builtin_amdgcn_perm(u0_, t0_, 0x05040100u), ab, o[ob], false); o[ob + 1] = __builtin_amdgcn_sdot4((int)__builtin_amdgcn_perm(u0_, t0_, 0x07060302u), ab, o[ob + 1], false); \
            o[ob + 2] = __builtin_amdgcn_sdot4((int)__builtin_amdgcn_perm(u1_, t1_, 0x05040100u), ab, o[ob + 2], false); o[ob + 3] = __builtin_amdgcn_sdot4((int)__builtin_amdgcn_perm(u1_, t1_, 0x07060302u), ab, o[ob + 3], false); } while (0)
#define PV_DOT(src, k0) do { const int a0_ = (int)a8[(k0) >> 2], a1_ = (int)a8[((k0) >> 2) + 1]; \
            PV_Q(src[0].x, src[1].x, src[2].x, src[3].x, a0_, 0); PV_Q(src[0].y, src[1].y, src[2].y, src[3].y, a0_, 4); \
            PV_Q(src[4].x, src[5].x, src[6].x, src[7].x, a1_, 0); PV_Q(src[4].y, src[5].y, src[6].y, src[7].y, a1_, 4); } while (0)
        u32x2 wa[8], wb[8];
        PV_LOAD(wa, 0);
#pragma unroll
        for (int k16 = 0; k16 < 128; k16 += 16) {
            PV_LOAD(wb, k16 + 8); PV_DOT(wa, k16); __builtin_amdgcn_sched_barrier(0);
            if (k16 + 16 < 128) PV_LOAD(wa, k16 + 16);
            PV_DOT(wb, k16 + 8); __builtin_amdgcn_sched_barrier(0); }
#undef PV_LOAD
#undef PV_Q
#undef PV_DOT
        u32x4 ow; ow.x = pk2((float)o[0] * os, (float)o[1] * os); ow.y = pk2((float)o[2] * os, (float)o[3] * os); ow.z = pk2((float)o[4] * os, (float)o[5] * os); ow.w = pk2((float)o[6] * os, (float)o[7] * os);
        *(u32x4*)(ft + ((size_t)slice * M + t) * 8) = ow;
    }
    __syncthreads();
}
constexpr int FROWB = D * 2 + 16;
constexpr int FVEC = 8 * FROWB;
__device__ __forceinline__ void final_units(const Ctx& C, int u0, int ustep, LAS unsigned char* lds, int tid, int wave, int lane) {
#define FU_LBAR() do { asm volatile("s_waitcnt lgkmcnt(0)" ::: "memory"); __builtin_amdgcn_s_barrier(); asm volatile("" ::: "memory"); } while (0)
    const bf16* ft = (const bf16*)(C.ws + WS_FT); const bf16* MIX = (const bf16*)(C.ws + WS_Y);
    const float* mod = (const float*)(C.ws + WS_MOD); const float* modf = mod + 2 * 6 * D;
    u32x4 pf[8]; int bcur = -1;
#define FU_GATHER(unit_) do { int tidv_ = tid; asm volatile("" : "+v"(tidv_));   \
        _Pragma("unroll") for (int i = 0; i < 8; ++i) { const int p = i * 512 + tidv_, slice = p >> 3, q = p & 7;                      \
            pf[i] = *(const u32x4*)(ft + ((size_t)slice * M + (unit_) * 8 + q) * 8); } } while (0)
    __syncthreads();
    if (u0 < M / 8) FU_GATHER(u0);
    for (int unit = u0; unit < M / 8; unit += ustep) { const int t0 = unit * 8, b = t0 >> 12;
        if (b != bcur) { bcur = b;
            const float* v0 = mod + (size_t)b * 6 * D + 5 * D; const float* v1 = C.g_f; const float* v2 = modf + (size_t)b * 2 * D; const float* v3 = modf + (size_t)b * 2 * D + D;
#pragma unroll
            for (int i = 0; i < 2; ++i) { const int c4 = tid + 512 * i;
                *(LAS f32x4*)(lds + FVEC + c4 * 16) = ((const f32x4*)v0)[c4]; *(LAS f32x4*)(lds + FVEC + 16384 + c4 * 16) = ((const f32x4*)v1)[c4];
                *(LAS f32x4*)(lds + FVEC + 32768 + c4 * 16) = ((const f32x4*)v2)[c4]; *(LAS f32x4*)(lds + FVEC + 49152 + c4 * 16) = ((const f32x4*)v3)[c4]; } }
        { int tidv = tid; asm volatile("" : "+v"(tidv));
#pragma unroll
          for (int i = 0; i < 8; ++i) { const int p = i * 512 + tidv, slice = p >> 3, q = p & 7; *(LAS u32x4*)(lds + q * FROWB + slice * 16) = pf[i]; } }
        const int m = t0 + wave; f32x4 f[16]; u32x2 aw[16]; float ss = 0.f; int lanev = lane; asm volatile("" : "+v"(lanev));
        const char* mp = (const char*)(MIX + (size_t)m * D); char* op = (char*)(C.out + (size_t)m * D);
#pragma unroll
        for (int j = 0; j < 16; ++j) { const unsigned cb = (unsigned)(64 * j + lanev) * 8u; aw[j] = *(const u32x2*)(mp + cb); }
        FU_LBAR();
        if (unit + ustep < M / 8) FU_GATHER(unit + ustep);
        asm volatile("" : "+v"(lanev));
#pragma unroll
        for (int j = 0; j < 16; ++j) { const unsigned cb = (unsigned)(64 * j + lanev) * 16u;
            const f32x4 gtv = *(const LAS f32x4*)(lds + FVEC + cb); const u32x2 fw = *(const LAS u32x2*)(lds + wave * FROWB + (cb >> 1));
            const f32x4 fv = {bf2f(fw.x & 0xffffu), bf2f(fw.x >> 16), bf2f(fw.y & 0xffffu), bf2f(fw.y >> 16)};
            f[j] = (f32x4){bf2f(aw[j].x & 0xffffu), bf2f(aw[j].x >> 16), bf2f(aw[j].y & 0xffffu), bf2f(aw[j].y >> 16)} + gtv * fv;
            ss += (f[j][0] * f[j][0] + f[j][1] * f[j][1]) + (f[j][2] * f[j][2] + f[j][3] * f[j][3]); if ((j & 3) == 3) __builtin_amdgcn_sched_barrier(0); }
        const float rs = rsqrtf(wave_sum(ss) * (1.0f / D) + EPS);
#pragma unroll
        for (int j = 0; j < 16; ++j) { const unsigned cb = (unsigned)(64 * j + lanev) * 16u;
            const f32x4 gg = *(const LAS f32x4*)(lds + FVEC + 16384 + cb), sh = *(const LAS f32x4*)(lds + FVEC + 32768 + cb), sc = *(const LAS f32x4*)(lds + FVEC + 49152 + cb);
            *(f32x4*)(op + cb) = f[j] * rs * gg * (sc + 1.0f) + sh; if ((j & 3) == 3) __builtin_amdgcn_sched_barrier(0); }
        FU_LBAR();
    }
    __syncthreads();
#undef FU_GATHER
#undef FU_LBAR
}

constexpr int NPHASE = 14;
struct Args { const void* in[25]; float* out; unsigned char* ws; int ph_lo, ph_hi; };
__global__ void __launch_bounds__(NTHR, 2) fwd(Args args) {
    extern __shared__ __attribute__((aligned(16))) unsigned char lds_raw[];
    LAS unsigned char* lds = (LAS unsigned char*)lds_raw;
    int tid = threadIdx.x, lane = tid & 63; const int wave = __builtin_amdgcn_readfirstlane(tid >> 6);
#define REFRESH_IDS() do { lane = (int)__builtin_amdgcn_mbcnt_hi(~0u, __builtin_amdgcn_mbcnt_lo(~0u, 0u)); tid = wave * 64 + lane; } while (0)
    const int G = gridDim.x, bx = blockIdx.x, vcu = (G % 8 == 0) ? (bx % 8) * (G / 8) + bx / 8 : bx;
    const int gw = vcu * NWAVES + wave, NGW = G * NWAVES;
    Ctx C;
    C.x = (const float*)args.in[0]; C.c = (const float*)args.in[1]; C.pos = (const int*)args.in[2]; C.w_ada = (const float*)args.in[3]; C.b_ada = (const float*)args.in[4];
    C.g_mix = (const float*)args.in[5]; C.w_in = (const float*)args.in[6]; C.g_q = (const float*)args.in[7]; C.w_uq = (const float*)args.in[8]; C.g_kv = (const float*)args.in[9];
    C.w_ukv = (const float*)args.in[10]; C.g_sgu = (const float*)args.in[11]; C.w_sgu = (const float*)args.in[12]; C.b_sgu = (const float*)args.in[13]; C.beta_mla = (const float*)args.in[14];
    C.beta_g = (const float*)args.in[15]; C.w_out = (const float*)args.in[16]; C.g_ffn = (const float*)args.in[17]; C.w_pq = (const float*)args.in[18]; C.pkeys = (const float*)args.in[19];
    C.eu = (const float*)args.in[20]; C.ev = (const float*)args.in[21]; C.w_adaf = (const float*)args.in[22]; C.b_adaf = (const float*)args.in[23]; C.g_f = (const float*)args.in[24];
    C.out = args.out; C.ws = args.ws;
    unsigned* ctl = (unsigned*)(C.ws + WS_CTL);
    float* mod = (float*)(C.ws + WS_MOD);
    for (int u = tid; u < (LDS_BYTES - LDSCTL_OFF) / 4; u += NTHR) ((LAS unsigned*)(lds + LDSCTL_OFF))[u] = 0u;
    __syncthreads();
    const int lo = args.ph_lo, hi = args.ph_hi;
    XcdBarrier bar; bar.bar = ctl + CW_BAR; bar.x = 0; bar.st = (volatile LAS unsigned*)(lds + LDSCTL_OFF + 64);
    if (hi - lo > 1) bar = xcd_barrier_post(ctl + CW_BAR, (volatile LAS unsigned*)(lds + LDSCTL_OFF + 64));
#define IN(k) (lo <= (k) && (k) < hi)
#define SEAM(k) do { if (IN(k) && IN((k) + 1)) xcd_barrier(bar); } while (0)

    if (IN(0)) { REFRESH_IDS();
        for (int u = vcu; u < 256; u += G) ada_unit(C, u, (LAS float*)lds, tid, wave, lane);
        LAS float* scr = (LAS float*)(lds + wave * 16384);
        constexpr int I1 = (D / 64) * (INWP / 32), I2 = (QLR / 64) * (NH * QKD / 32), I3 = (KVLR / 64) * (NH * 256 / 32), I4 = (D / 64) * (D / 32), I5 = (D / 64) * (PQW / 32);
        constexpr float QSCALE = 1.4426950408889634f * 0.07216878364870322f;
        for (int it = gw; it < I1 + I2 + I3 + I4 + I5; it += NGW) {
            int q = it;
            if (q < I1) { transpose_item<MAP_W1>(C.w_in, D, INW, INWP, (bf16*)(C.ws + WS_W1T), nullptr, 1.0f, scr, q, lane); continue; } q -= I1;
            if (q < I2) { transpose_item<MAP_UQ>(C.w_uq, QLR, NH * QKD, NH * QKD, (bf16*)(C.ws + WS_WUQT), C.g_q, QSCALE, scr, q, lane); continue; } q -= I2;
            if (q < I3) { transpose_item<MAP_ID>(C.w_ukv, KVLR, NH * 256, NH * 256, (bf16*)(C.ws + WS_WUKVT), C.g_kv, 1.0f, scr, q, lane); continue; } q -= I3;
            if (q < I4) { const int kb = q / (D / 32); const float* ks = (kb < 32) ? C.beta_mla : C.beta_g - GW;
                          transpose_item<MAP_ID>(C.w_out, D, D, D, (bf16*)(C.ws + WS_WOUTT), ks, 1.0f, scr, q, lane); continue; } q -= I4;
            transpose_item<MAP_ID>(C.w_pq, D, PQW, PQW, (bf16*)(C.ws + WS_WPQT), nullptr, 1.0f, scr, q, lane);
        }
        const int gt = vcu * NTHR + tid, NGT = G * NTHR;
        { bf16* kd = (bf16*)(C.ws + WS_KEYS); for (int i = gt; i < PH * 2 * PNK * PHALF; i += NGT) kd[i] = (bf16)f2bf(C.pkeys[i]); }
        { bf16* wd = (bf16*)(C.ws + WS_WSGU); for (int i = gt; i < GH * GC * GC; i += NGT) { const int s = i & 127, t = (i >> 7) & 127; wd[i] = (bf16)(s <= t ? f2bf(C.w_sgu[i]) : 0u); } }
        { float* rp = (float*)(C.ws + WS_ROPE); for (int i = gt; i < M * 32; i += NGT) { const int j = i & 31, tok = i >> 5;
            const float invf = (float)exp(-(double)(2 * j) / 64.0 * 9.210340371976184); const float ang = (float)C.pos[tok] * invf;
            rp[2 * i] = (float)cos((double)ang); rp[2 * i + 1] = (float)sin((double)ang); } }
        __syncthreads();
        for (int e = gw; e < PNE; e += NGW) expert_convert_u(C, e, lane);
        for (int u = vcu; u < 4096; u += G) expert_convert_unit(C, 4096 + u, lds, tid);
    }
    SEAM(0);
    if (IN(1)) { REFRESH_IDS(); __syncthreads();
        if (G == 256) norm_mod_rows<false, true>(C.x, nullptr, C.g_mix, mod, mod + D, (bf16*)(C.ws + WS_H), nullptr, nullptr, nullptr, gw, NGW, lane, lds, tid);
        else norm_mod_rows<false, false>(C.x, nullptr, C.g_mix, mod, mod + D, (bf16*)(C.ws + WS_H), nullptr, nullptr, nullptr, gw, NGW, lane, lds, tid);
        __syncthreads(); }
    SEAM(1);
    if (IN(2)) { REFRESH_IDS();
        pg8::Gemm g{(const bf16*)(C.ws + WS_H), (const bf16*)(C.ws + WS_W1T), M, INWP, D, D, D}; pg8::StaticOrder S; S.init(M, INWP, G, bx);
        EpiZ E{(bf16*)(C.ws + WS_QLAT), (bf16*)(C.ws + WS_KVLAT), (bf16*)(C.ws + WS_KPE), (bf16*)(C.ws + WS_U), (bf16*)(C.ws + WS_VT),
               (float*)(C.ws + WS_STQ), (float*)(C.ws + WS_STKV), (float*)(C.ws + WS_STVS), (float*)(C.ws + WS_STVQ), (const float*)(C.ws + WS_ROPE)};
        pg8::gemm_phase<EpiZ>(lds, g, S, E);
    }
    SEAM(2);
    if (IN(3)) { REFRESH_IDS();
        { pg8::Gemm g{(const bf16*)(C.ws + WS_QLAT), (const bf16*)(C.ws + WS_WUQT), M, NH * QKD, QLR, QLR, QLR}; pg8::StaticOrder S; S.init(M, NH * QKD, G, bx);
          EpiQ E{(bf16*)(C.ws + WS_Q), (const float*)(C.ws + WS_STQ), (const float*)(C.ws + WS_ROPE)};
          pg8::gemm_phase<EpiQ>(lds, g, S, E); }
        { pg8::Gemm g{(const bf16*)(C.ws + WS_KVLAT), (const bf16*)(C.ws + WS_WUKVT), M, NH * 256, KVLR, KVLR, KVLR}; pg8::StaticOrder S; S.init(M, NH * 256, G, bx);
          EpiKV E{(bf16*)(C.ws + WS_KN), (bf16*)(C.ws + WS_VTA), (const float*)(C.ws + WS_STKV)};
          pg8::gemm_phase<EpiKV>(lds, g, S, E); }
        { const int heavy = (G == 256 && bx < 128), lite = (G == 256 && bx >= 128);
          int u = heavy ? bx * 3 : (lite ? 384 + (bx - 128) * 5 : vcu); const int ustep = (G == 256) ? 1 : G, uend = heavy ? bx * 3 + 3 : (lite ? 384 + (bx - 128) * 5 + 5 : NB * 32 * GH);
          sgu_units(C, u, uend, ustep, lds, tid, wave, lane); }
    }
    SEAM(3);
    if (IN(4)) { REFRESH_IDS();
        if (wave >= 4) __builtin_amdgcn_s_setprio(1);
        for (int it = vcu; it < 256; it += G) { const int bh = it >> 3, x = it & 7;
            attn_block(C, bh >> 4, bh & 15, 15 - x, lds, tid, wave, lane);
            attn_block(C, bh >> 4, bh & 15, x, lds, tid, wave, lane); }
        __builtin_amdgcn_s_setprio(0);
    }
    SEAM(4);
    if (IN(6)) { REFRESH_IDS();
        pg8::Gemm g{(const bf16*)(C.ws + WS_Y), (const bf16*)(C.ws + WS_WOUTT), M, D, D, D, D}; pg8::StaticOrder S; S.init(M, D, G, bx);
        LAS f32x2* rsl = (LAS f32x2*)(lds + RING_BYTES);
        pg8::Unit u0, u1; const bool h0 = S.next(0, u0), h1 = S.next(1, u1);
        { const int slot = tid >> 8, pm = slot ? (h1 ? u1.pm : u0.pm) : u0.pm, row = pm * 256 + (tid & 255);
          if (h0) { const float* stm = (const float*)(C.ws + WS_STM); const float* stg = (const float*)(C.ws + WS_STG);
              const float sm = sum_parts(stm + (size_t)row * 16, 4) * (1.0f / GW) + EPS, sg = sum_parts(stg + (size_t)row * 16, 4) * (1.0f / GW) + EPS;
              rsl[slot * 256 + (tid & 255)] = (f32x2){rsqrtf(sm) * sqrtf(sg), rsqrtf(sg)}; } }
        __syncthreads();
        EpiX1 E{mod, (bf16*)(C.ws + WS_X1), rsl, u0.pm};
        pg8::gemm_phase<EpiX1>(lds, g, S, E);
    }
    SEAM(6);
    if (IN(7)) { REFRESH_IDS(); __syncthreads();
        if (G == 256) norm_mod_rows<true, true>(C.x, (const bf16*)(C.ws + WS_X1), C.g_ffn, mod + 3 * D, mod + 4 * D, (bf16*)(C.ws + WS_H), (signed char*)(C.ws + WS_H8), (float*)(C.ws + WS_SH), (bf16*)(C.ws + WS_Y), gw, NGW, lane, lds, tid);
        else norm_mod_rows<true, false>(C.x, (const bf16*)(C.ws + WS_X1), C.g_ffn, mod + 3 * D, mod + 4 * D, (bf16*)(C.ws + WS_H), (signed char*)(C.ws + WS_H8), (float*)(C.ws + WS_SH), (bf16*)(C.ws + WS_Y), gw, NGW, lane, lds, tid);
        __syncthreads(); }
    SEAM(7);
    if (IN(8)) { REFRESH_IDS();
        pg8::Gemm g{(const bf16*)(C.ws + WS_H), (const bf16*)(C.ws + WS_WPQT), M, PQW, D, D, D}; pg8::StaticOrder S; S.init(M, PQW, G, bx);
        EpiQP E{(bf16*)(C.ws + WS_QP)};
        pg8::gemm_phase<EpiQP>(lds, g, S, E);
    }
    SEAM(8);
    if (IN(9)) { REFRESH_IDS(); for (int tb = vcu; tb < M / 32; tb += G) {
            topk_item(C, tb * 8 + wave, (LAS float*)(lds + wave * 12288), (LAS int*)(lds + 98304), (LAS float*)(lds + 98304 + 16384), lane);
            __syncthreads(); { int tidv = tid; asm volatile("" : "+v"(tidv)); order_pairs(C, tb, lds, tidv); } __syncthreads(); } }
    SEAM(9);
    if (IN(10)) { REFRESH_IDS(); for (int it = vcu; it < 256; it += G) peer_u_item(C, it & 15, it >> 4, lds, tid, wave, lane); }
    SEAM(10);
    if (IN(12)) { REFRESH_IDS(); for (int it = vcu; it < 256; it += G) peer_v_item(C, it & 15, it >> 4, lds, tid, wave, lane); }
    SEAM(12);
    if (IN(13)) { REFRESH_IDS(); final_units(C, vcu, G, lds, tid, wave, lane); }
#undef IN
#undef SEAM
#undef REFRESH_IDS
}

extern "C" void kernel_launch(void* const* d_in, const int* in_sizes, int n_in, void* d_out, int out_size, void* d_ws, size_t ws_size, hipStream_t stream) {
    static int grid = 0;
    if (grid == 0) {
        if (n_in != 25 || out_size != M * D || ws_size < WS_END) { fprintf(stderr, "kernel_launch: unexpected problem (n_in %d, out %d, ws %zu)\n", n_in, out_size, ws_size); grid = -1; return; }
        int dev = 0, cus = 0, per_cu = 0;
        if (hipGetDevice(&dev) != hipSuccess || hipDeviceGetAttribute(&cus, hipDeviceAttributeMultiprocessorCount, dev) != hipSuccess) { grid = -1; return; }
        if (hipFuncSetAttribute((const void*)fwd, hipFuncAttributeMaxDynamicSharedMemorySize, LDS_BYTES) != hipSuccess) { fprintf(stderr, "kernel_launch: hipFuncSetAttribute failed\n"); grid = -1; return; }
        if (hipOccupancyMaxActiveBlocksPerMultiprocessor(&per_cu, (const void*)fwd, NTHR, LDS_BYTES) != hipSuccess || per_cu < 1) { fprintf(stderr, "kernel_launch: occupancy query says %d blocks per CU\n", per_cu); }
        (void)hipGetLastError();
        grid = cus;
    }
    if (grid < 0) return;
    if (hipMemsetAsync((char*)d_ws + WS_CTL, 0, CTL_ZERO_BYTES, stream) != hipSuccess) return;
    Args a{};
    for (int i = 0; i < 25; ++i) a.in[i] = d_in[i];
    a.out = (float*)d_out; a.ws = (unsigned char*)d_ws;
#if MK_ONE_LAUNCH
    a.ph_lo = 0; a.ph_hi = NPHASE;
    hipLaunchKernelGGL(fwd, dim3(grid), dim3(NTHR), LDS_BYTES, stream, a);
#else
    for (int p = 0; p < NPHASE; ++p) { a.ph_lo = p; a.ph_hi = p + 1; hipLaunchKernelGGL(fwd, dim3(grid), dim3(NTHR), LDS_BYTES, stream, a); }
#endif
    const hipError_t le = hipPeekAtLastError();
    if (le != hipSuccess) fprintf(stderr, "kernel_launch: launch failed: %s\n", hipGetErrorName(le));
}
```
